# Optimizing an MI355X kernel written in HIP

```python
import jax, jax.numpy as jnp
from jax import lax
import numpy as np

D_MODEL = 1024
BATCH = 4
SEQ = 4096
DEPTH = 4

GRID_W = 64
CTX_LEN = 256
EPS = 1e-6

RNN_WIDTH = D_MODEL
RNN_BLOCKS = 16
RNN_BLOCK = RNN_WIDTH // RNN_BLOCKS
CONV_W = 4
CONV_PAD_L = 2
LRU_C = 8.0

SGU_WIDTH = D_MODEL
SGU_CHUNK = 128
SGU_GROUPS = 8
SGU_GROUP_CH = SGU_WIDTH // SGU_GROUPS

N_HEADS = 16
N_KV_HEADS = 4
Q_PER_KV = N_HEADS // N_KV_HEADS
HEAD_DIM = 64
D_ATTN = N_HEADS * HEAD_DIM
WINDOW = 128
ATT_BLOCK = 128
BAND = ATT_BLOCK + 2 * WINDOW
ATT_SCALE = HEAD_DIM ** -0.5
ROPE_BASE = 10000.0
ROPE_FREQS = HEAD_DIM // 4

N_BRANCH = 3
D_FF = 4 * D_MODEL

OFF_A = 0
OFF_B = OFF_A + RNN_WIDTH
OFF_Q = OFF_B + 2 * SGU_WIDTH
OFF_K = OFF_Q + D_ATTN
OFF_V = OFF_K + N_KV_HEADS * HEAD_DIM
OFF_G = OFF_V + N_KV_HEADS * HEAD_DIM
IN_WIDTH = OFF_G + N_BRANCH * D_MODEL

kernel_name = 'hybrid_prefix_diffusion_block'


def rms_norm(t, g):
    tf = t.astype(jnp.float32)
    y = tf * lax.rsqrt(jnp.mean(tf * tf, axis=-1, keepdims=True) + EPS)
    return (y * g.astype(jnp.float32)).astype(t.dtype)


def layer_norm(t, g, b):
    tf = t.astype(jnp.float32)
    mu = jnp.mean(tf, axis=-1, keepdims=True)
    var = jnp.mean(jnp.square(tf - mu), axis=-1, keepdims=True)
    y = (tf - mu) * lax.rsqrt(var + EPS) * g.astype(jnp.float32) + b.astype(jnp.float32)
    return y.astype(t.dtype)


def modulate(h, shift, scale):
    return h * (1 + scale) + shift


def short_conv(t, w, b):
    L = t.shape[1]
    tp = jnp.pad(t, ((0, 0), (CONV_PAD_L, CONV_W - 1 - CONV_PAD_L), (0, 0)))
    out = b
    for k in range(CONV_W):
        out = out + w[k] * tp[:, k:k + L]
    return out


def lru_coeffs(t, wa, ba, wx, bx, lam):
    nb, L, C = t.shape
    tb = t.reshape(nb, L, RNN_BLOCKS, RNN_BLOCK)
    r = jax.nn.sigmoid(jnp.einsum('blhi,hij->blhj', tb, wa).reshape(nb, L, C) + ba)
    i = jax.nn.sigmoid(jnp.einsum('blhi,hij->blhj', tb, wx).reshape(nb, L, C) + bx)
    log_a = -LRU_C * r * jax.nn.softplus(-lam)
    a = jnp.exp(log_a)
    u = t * i * jnp.sqrt(-jnp.expm1(2 * log_a))
    return a, u


def linear_scan(a, u, h0):
    u = u.at[:, 0].add(a[:, 0] * h0)

    def combine(left, right):
        al, ul = left
        ar, ur = right
        return al * ar, ar * ul + ur

    _, h = lax.associative_scan(combine, (a, u), axis=1)
    return h


def rglru_bidir(xa, h0_f, h0_b, conv_w, conv_b, wa, ba, wx, bx, lam):
    xc = short_conv(xa, conv_w, conv_b)
    a_f, u_f = lru_coeffs(xc, wa[0], ba[0], wx[0], bx[0], lam[0])
    a_b, u_b = lru_coeffs(xc, wa[1], ba[1], wx[1], bx[1], lam[1])
    h_f = linear_scan(a_f, u_f, h0_f)
    h_b = jnp.flip(linear_scan(jnp.flip(a_b, 1), jnp.flip(u_b, 1), h0_b), 1)
    return h_f + h_b, h_f[:, -1], h_b[:, 0]


def spatial_gating(z, ln_g, ln_b, w_s, b_s):
    nb, L, _ = z.shape
    u, v = jnp.split(z, 2, axis=-1)
    v = layer_norm(v, ln_g, ln_b)
    nc = L // SGU_CHUNK
    vb = v.reshape(nb, nc, SGU_CHUNK, SGU_GROUPS, SGU_GROUP_CH)
    mixed = jnp.einsum('gpq,bnqgc->bnpgc', w_s, vb) + b_s.T[None, None, :, :, None]
    return u * mixed.reshape(nb, L, SGU_WIDTH)


def axial_rope_tables(rows, dtype):
    row = jnp.repeat(jnp.arange(rows), GRID_W).astype(jnp.float32)
    col = jnp.tile(jnp.arange(GRID_W), rows).astype(jnp.float32)
    inv = jnp.power(ROPE_BASE, -jnp.arange(ROPE_FREQS, dtype=jnp.float32) / ROPE_FREQS)
    ang = jnp.concatenate([row[:, None] * inv, col[:, None] * inv], axis=-1)
    return jnp.cos(ang).astype(dtype), jnp.sin(ang).astype(dtype)


def apply_axial_rope(t, cos, sin):
    shp = t.shape
    tr = t.reshape(*shp[:-1], 2, 2, ROPE_FREQS)
    t1, t2 = tr[..., 0, :], tr[..., 1, :]
    cs = cos.reshape(shp[1], 2, ROPE_FREQS)[None, :, None]
    sn = sin.reshape(shp[1], 2, ROPE_FREQS)[None, :, None]
    return jnp.stack([t1 * cs - t2 * sn, t2 * cs + t1 * sn], axis=-2).reshape(shp)


def sink_attend(q, ks, vs, sink, mask=None):
    logits = [jnp.einsum('bqkgd,bjkd->bkgqj', q, k).astype(jnp.float32) for k in ks]
    if mask is not None:
        logits[0] = jnp.where(mask, logits[0], -jnp.inf)
    sink_col = jnp.broadcast_to(sink.reshape(N_KV_HEADS, Q_PER_KV, 1, 1).astype(jnp.float32),
                                logits[0].shape[:-1] + (1,))
    p = jax.nn.softmax(jnp.concatenate(logits + [sink_col], axis=-1), axis=-1)
    out = None
    start = 0
    for k, v in zip(ks, vs):
        n_k = k.shape[1]
        part = jnp.einsum('bkgqj,bjkd->bqkgd', p[..., start:start + n_k].astype(v.dtype), v)
        out = part if out is None else out + part
        start += n_k
    return out


def windowed_attention(q, k, v, k_ctx, v_ctx, sink):
    nb, S, _, _ = q.shape
    n_blk = S // ATT_BLOCK
    qb = jnp.moveaxis(q.reshape(nb, n_blk, ATT_BLOCK, N_KV_HEADS, Q_PER_KV, HEAD_DIM), 1, 0)
    pad = ((0, 0), (WINDOW, WINDOW), (0, 0), (0, 0))
    kp = jnp.pad(k, pad)
    vp = jnp.pad(v, pad)
    i = jnp.arange(ATT_BLOCK)[:, None]
    j = jnp.arange(BAND)[None, :]
    in_window = jnp.abs(j - WINDOW - i) <= WINDOW

    def block(args):
        n, q_n = args
        k_n = lax.dynamic_slice_in_dim(kp, n * ATT_BLOCK, BAND, axis=1)
        v_n = lax.dynamic_slice_in_dim(vp, n * ATT_BLOCK, BAND, axis=1)
        tok = n * ATT_BLOCK - WINDOW + j
        mask = in_window & (tok >= 0) & (tok < S)
        return sink_attend(q_n, [k_n, k_ctx], [v_n, v_ctx], sink, mask)

    out = lax.map(block, (jnp.arange(n_blk), qb))
    return jnp.moveaxis(out, 0, 1).reshape(nb, S, D_ATTN)


def merge_branches(gate_logits, ya, yb, yc, w_branch, w_out):
    ga, gb, gc = jnp.split(jax.nn.sigmoid(gate_logits), N_BRANCH, axis=-1)
    m = ga * (ya @ w_branch[0]) + gb * (yb @ w_branch[1]) + gc * (yc @ w_branch[2])
    return m @ w_out


def sq_relu_mlp(h, w1, w2):
    return jnp.square(jax.nn.relu(h @ w1)) @ w2


def setup_inputs(seed: int = 0) -> dict:
    key = jax.random.key(seed)
    ks = jax.random.split(key, 27)

    def nrm(k, shape, scale):
        return jax.random.normal(k, shape, jnp.float32) * scale

    u = jax.random.uniform(ks[14], (DEPTH, 2, RNN_WIDTH), jnp.float32, 0.9, 0.999)
    s = u ** (1.0 / LRU_C)
    lru_lambda = jnp.log(s) - jnp.log1p(-s)
    return {
        'x': nrm(ks[0], (BATCH, SEQ, D_MODEL), 1.0),
        'c': nrm(ks[1], (BATCH, D_MODEL), 1.0),
        'ctx': nrm(ks[2], (BATCH, CTX_LEN, D_MODEL), 1.0),
        'c_ctx': nrm(ks[3], (D_MODEL,), 1.0),
        'w_mod': nrm(ks[4], (DEPTH, D_MODEL, 6 * D_MODEL), 0.5 * D_MODEL ** -0.5),
        'b_mod': nrm(ks[5], (DEPTH, 6 * D_MODEL), 0.01),
        'g_norm1': 1.0 + nrm(ks[6], (DEPTH, D_MODEL), 0.01),
        'w_in': nrm(ks[7], (DEPTH, D_MODEL, IN_WIDTH), D_MODEL ** -0.5),
        'conv_w': nrm(ks[8], (DEPTH, CONV_W, RNN_WIDTH), CONV_W ** -0.5),
        'conv_b': nrm(ks[9], (DEPTH, RNN_WIDTH), 0.01),
        'lru_wa': nrm(ks[10], (DEPTH, 2, RNN_BLOCKS, RNN_BLOCK, RNN_BLOCK), RNN_BLOCK ** -0.5),
        'lru_ba': nrm(ks[11], (DEPTH, 2, RNN_WIDTH), 0.01),
        'lru_wx': nrm(ks[12], (DEPTH, 2, RNN_BLOCKS, RNN_BLOCK, RNN_BLOCK), RNN_BLOCK ** -0.5),
        'lru_bx': nrm(ks[13], (DEPTH, 2, RNN_WIDTH), 0.01),
        'lru_lambda': lru_lambda,
        'sgu_ln_g': 1.0 + nrm(ks[15], (DEPTH, SGU_WIDTH), 0.01),
        'sgu_ln_b': nrm(ks[16], (DEPTH, SGU_WIDTH), 0.01),
        'sgu_w': nrm(ks[17], (DEPTH, SGU_GROUPS, SGU_CHUNK, SGU_CHUNK), SGU_CHUNK ** -0.5),
        'sgu_b': 1.0 + nrm(ks[18], (DEPTH, SGU_GROUPS, SGU_CHUNK), 0.01),
        'q_norm_g': 1.0 + nrm(ks[19], (DEPTH, HEAD_DIM), 0.01),
        'k_norm_g': 1.0 + nrm(ks[20], (DEPTH, HEAD_DIM), 0.01),
        'sink': nrm(ks[21], (DEPTH, N_HEADS), 1.0),
        'w_branch': nrm(ks[22], (DEPTH, N_BRANCH, D_MODEL, D_MODEL), D_MODEL ** -0.5),
        'w_out': nrm(ks[23], (DEPTH, D_MODEL, D_MODEL), D_MODEL ** -0.5),
        'g_norm2': 1.0 + nrm(ks[24], (DEPTH, D_MODEL), 0.01),
        'w_ff1': nrm(ks[25], (DEPTH, D_MODEL, D_FF), D_MODEL ** -0.5),
        'w_ff2': nrm(ks[26], (DEPTH, D_FF, D_MODEL), D_FF ** -0.5),
    }


def reference(x, c, ctx, c_ctx, w_mod, b_mod, g_norm1, w_in, conv_w, conv_b, lru_wa, lru_ba,
              lru_wx, lru_bx, lru_lambda, sgu_ln_g, sgu_ln_b, sgu_w, sgu_b, q_norm_g, k_norm_g,
              sink, w_branch, w_out, g_norm2, w_ff1, w_ff2):
    n_batch, n_tok, _ = x.shape
    n_ctx = ctx.shape[1]
    ROWS = n_tok // GRID_W
    cos, sin = axial_rope_tables(ROWS, x.dtype)
    cond_x = jax.nn.silu(c)
    cond_c = jax.nn.silu(c_ctx)
    cx = ctx
    for l in range(DEPTH):
        last = l == DEPTH - 1
        mod_x = (cond_x @ w_mod[l] + b_mod[l])[:, None, :]
        mod_c = cond_c @ w_mod[l] + b_mod[l]
        sh1x, sc1x, ga1x, sh2x, sc2x, ga2x = jnp.split(mod_x, 6, axis=-1)
        sh1c, sc1c, ga1c, sh2c, sc2c, ga2c = jnp.split(mod_c, 6, axis=-1)
        lru_p = (conv_w[l], conv_b[l], lru_wa[l], lru_ba[l], lru_wx[l], lru_bx[l], lru_lambda[l])
        sgu_p = (sgu_ln_g[l], sgu_ln_b[l], sgu_w[l], sgu_b[l])

        zc = modulate(rms_norm(cx, g_norm1[l]), sh1c, sc1c) @ w_in[l]
        kc = rms_norm(zc[..., OFF_K:OFF_V].reshape(n_batch, n_ctx, N_KV_HEADS, HEAD_DIM), k_norm_g[l])
        vc = zc[..., OFF_V:OFF_G].reshape(n_batch, n_ctx, N_KV_HEADS, HEAD_DIM)
        h0 = jnp.zeros((n_batch, RNN_WIDTH), zc.dtype)
        ya_c, hf_c, hb_c = rglru_bidir(zc[..., OFF_A:OFF_B], h0, h0, *lru_p)

        zx = modulate(rms_norm(x, g_norm1[l]), sh1x, sc1x) @ w_in[l]
        ya_x, _, _ = rglru_bidir(zx[..., OFF_A:OFF_B], hf_c, hb_c, *lru_p)
        yb_x = spatial_gating(jax.nn.gelu(zx[..., OFF_B:OFF_Q]), *sgu_p)
        q = rms_norm(zx[..., OFF_Q:OFF_K].reshape(n_batch, n_tok, N_HEADS, HEAD_DIM), q_norm_g[l])
        k = rms_norm(zx[..., OFF_K:OFF_V].reshape(n_batch, n_tok, N_KV_HEADS, HEAD_DIM), k_norm_g[l])
        v = zx[..., OFF_V:OFF_G].reshape(n_batch, n_tok, N_KV_HEADS, HEAD_DIM)
        q = apply_axial_rope(q, cos, sin) * ATT_SCALE
        k = apply_axial_rope(k, cos, sin)
        yc_x = windowed_attention(q, k, v, kc, vc, sink[l])
        x = x + ga1x * merge_branches(zx[..., OFF_G:], ya_x, yb_x, yc_x, w_branch[l], w_out[l])
        x = x + ga2x * sq_relu_mlp(modulate(rms_norm(x, g_norm2[l]), sh2x, sc2x), w_ff1[l], w_ff2[l])

        if not last:
            yb_c = spatial_gating(jax.nn.gelu(zc[..., OFF_B:OFF_Q]), *sgu_p)
            qc = rms_norm(zc[..., OFF_Q:OFF_K].reshape(n_batch, n_ctx, N_KV_HEADS, Q_PER_KV, HEAD_DIM),
                          q_norm_g[l]) * ATT_SCALE
            yc_c = sink_attend(qc, [kc], [vc], sink[l]).reshape(n_batch, n_ctx, D_ATTN)
            cx = cx + ga1c * merge_branches(zc[..., OFF_G:], ya_c, yb_c, yc_c, w_branch[l], w_out[l])
            cx = cx + ga2c * sq_relu_mlp(modulate(rms_norm(cx, g_norm2[l]), sh2c, sc2c), w_ff1[l], w_ff2[l])
    return x
```

```cpp
#define DBG_NOADD 0
#include <hip/hip_runtime.h>
#include <hip/hip_cooperative_groups.h>
#include <cstdio>
#include <cstdint>
namespace cg = cooperative_groups;

#define LAS __attribute__((address_space(3)))
#define DI __device__ __forceinline__
typedef unsigned short bf16_t;
typedef short bf16x8 __attribute__((ext_vector_type(8)));
typedef short s16x4 __attribute__((ext_vector_type(4)));
typedef float f32x2 __attribute__((ext_vector_type(2)));
typedef float f32x4 __attribute__((ext_vector_type(4)));
typedef float f32x16 __attribute__((ext_vector_type(16)));
typedef unsigned u32x2 __attribute__((ext_vector_type(2)));
typedef unsigned u32x4 __attribute__((ext_vector_type(4)));
typedef __bf16 bf16x2_t __attribute__((ext_vector_type(2)));

constexpr int D = 1024, NB = 4, SEQ = 4096, CTX = 256, DEPTH = 4, DFF = 4096;
constexpr int TC = NB * CTX;
constexpr int TL = NB * SEQ;
constexpr int T = TC + TL;
constexpr int INW = 7680;
constexpr float EPS = 1e-6f;
constexpr float LOG2E = 1.4426950408889634f;

constexpr size_t WS_CTL = 0;
constexpr size_t WS_ROPE = 4096;
constexpr size_t WS_MOD = 65536;
constexpr size_t WS_XC = 1u << 20;
constexpr size_t WS_WIN = 5u << 20;
constexpr size_t WS_WBR = WS_WIN + (size_t)INW * D * 2;
constexpr size_t WS_WOUT = WS_WBR + (size_t)3 * D * D * 2;
constexpr size_t WS_WFF1 = WS_WOUT + (size_t)D * D * 2;
constexpr size_t WS_WFF2 = WS_WFF1 + (size_t)DFF * D * 2;
constexpr size_t WS_H = WS_WFF2 + (size_t)DFF * D * 2;
constexpr size_t WS_MG = WS_H + (size_t)T * D * 2;
constexpr size_t WS_ZA = WS_MG + (size_t)T * D * 2;
constexpr size_t WS_ZU = WS_ZA + (size_t)T * D * 2;
constexpr size_t WS_ZV = WS_ZU + (size_t)T * D * 2;
constexpr size_t WS_ZQ = WS_ZV + (size_t)T * D * 2;
constexpr size_t WS_ZK = WS_ZQ + (size_t)T * D * 2;
constexpr size_t WS_ZVV = WS_ZK + (size_t)T * 256 * 2;
constexpr size_t WS_ZG = WS_ZVV + (size_t)T * 256 * 2;
constexpr size_t WS_END = WS_ZG + (size_t)T * 3072 * 2;
constexpr size_t WS_HID = WS_ZA;

constexpr int LDS_BYTES = 147456;
constexpr int LDS_MISC = 143360;

struct Args { const float* in[27]; float* out; unsigned char* ws; };


template <int OFF> DI const void* kargp() { const unsigned long long k = (unsigned long long)__builtin_amdgcn_kernarg_segment_ptr(); const void* p;
    asm volatile("s_load_dwordx2 %0, %1, %2\n\ts_waitcnt lgkmcnt(0)" : "=s"(p) : "s"(k), "n"(OFF) : "memory"); return p; }
template <int I> DI const float* inp() { return (const float*)kargp<I * 8>(); }
DI float* outp() { return (float*)kargp<27 * 8>(); }
DI unsigned char* wsp() { return (unsigned char*)kargp<28 * 8>(); }
DI int tidx() { int t = threadIdx.x; asm volatile("" : "+v"(t)); return t; }
DI int bidx() { int b = blockIdx.x; asm volatile("" : "+s"(b)); return b; }

DI unsigned pk2(float lo, float hi) { f32x2 v = {lo, hi}; bf16x2_t b = __builtin_convertvector(v, bf16x2_t); return __builtin_bit_cast(unsigned, b); }
DI float bflo(unsigned w) { return __uint_as_float(w << 16); }
DI float bfhi(unsigned w) { return __uint_as_float(w & 0xffff0000u); }
DI float bf1(bf16_t h) { return __uint_as_float(((unsigned)h) << 16); }
DI bf16_t f2bf(float f) { return (bf16_t)(pk2(f, 0.f) & 0xffffu); }
DI float fexp2(float x) { return __builtin_amdgcn_exp2f(x); }
DI float frcp(float x) { return __builtin_amdgcn_rcpf(x); }
DI float sigmoidf_(float x) { return frcp(1.0f + fexp2(-x * LOG2E)); }
DI float gelu_tanh(float x) { const float u = x + 0.044715f * x * x * x; return x * frcp(1.0f + fexp2(-1.5957691216f * LOG2E * u)); }
DI float wave_sum(float v) {
#pragma unroll
    for (int o = 1; o < 64; o <<= 1) v += __shfl_xor(v, o);
    return v;
}
DI void unpack8(const u32x4 w, float (&v)[8]) { v[0] = bflo(w.x); v[1] = bfhi(w.x); v[2] = bflo(w.y); v[3] = bfhi(w.y); v[4] = bflo(w.z); v[5] = bfhi(w.z); v[6] = bflo(w.w); v[7] = bfhi(w.w); }
DI u32x4 pack8(const float (&v)[8]) { u32x4 w; w.x = pk2(v[0], v[1]); w.y = pk2(v[2], v[3]); w.z = pk2(v[4], v[5]); w.w = pk2(v[6], v[7]); return w; }
#define MFMA32(a, b, c) __builtin_amdgcn_mfma_f32_32x32x16_bf16((a), (b), (c), 0, 0, 0)

namespace pg8 {
constexpr int BM = 256, BK = 64, HALF = 128, HTB = HALF * BK * 2, STAGE_BYTES = 8 * HTB, NXCD = 8, WGM = 8;
DI int lds_byte(int r, int c) { const int st = (r >> 4) * 2 + (c >> 5), rr = r & 15, cc = c & 31, ob = rr * 64 + cc * 2; return st * 1024 + (ob ^ (((ob >> 9) & 1) << 5)); }
DI void stage_rc(int b, int& R, int& C) { const int st = b / 1024, sb = b % 1024, swz = sb ^ (((sb >> 9) & 1) << 5); R = (st >> 1) * 16 + swz / 64; C = (st & 1) * 32 + (swz % 64) / 2; }
DI int perm32(int rho) { const int n = rho >> 4, i = rho & 15; return 8 * (i >> 2) + 4 * n + (i & 3); }

struct Unit { int pm, pn, seg; const char* A; const char* B; };

struct Sched {
    int nM, nN, nwg, G, c, nseg, pm0;
    const char *A0, *B0; size_t d1, d2, bseg, tstep;
    DI bool next(int i, Unit& u) const {
        int ti = i, seg = 0;
        if (nseg == 3) { ti = i / 3; seg = i - 3 * ti; }
        const long L = (long)ti * G + c; if (L >= nwg) return false;
        int wgid = (int)L; { const int q = nwg / NXCD, r = nwg % NXCD, xcd = wgid % NXCD, off = wgid / NXCD; wgid = (xcd < r ? xcd * (q + 1) : r * (q + 1) + (xcd - r) * q) + off; }
        const int nig = WGM * nN, gid = wgid / nig, fm = gid * WGM, gsz = (nM - fm) < WGM ? (nM - fm) : WGM;
        u.pm = pm0 + fm + ((wgid % nig) % gsz); u.pn = (wgid % nig) / gsz; u.seg = seg;
        const size_t ao = (seg >= 1 ? d1 : (size_t)0) + (seg >= 2 ? d2 : (size_t)0);
        u.A = A0 + ao + (size_t)u.pm * tstep; u.B = B0 + (size_t)seg * bseg + (size_t)u.pn * tstep;
        return true;
    }
};

template <class Epi>
DI void gemm_phase(LAS unsigned char* lds, const int K, const Sched& S, const Epi& E) {
    const int tid = tidx(), wid = __builtin_amdgcn_readfirstlane(tid >> 6), lane = tid & 63, wr = wid >> 2, wc = wid & 3, fr = lane & 15, fq = lane >> 4;
    const int nt = K / BK;
    unsigned voffA[2], voffB[2];
#pragma unroll
    for (int i = 0; i < 2; ++i) { int R, C; stage_rc(tid * 16 + i * 8192, R, C); const int Rb = Epi::PERM ? ((R & ~31) + perm32(R & 31)) : R;
        voffA[i] = (unsigned)(R * K + C) * 2u; voffB[i] = (unsigned)(Rb * K + C) * 2u; }
    const size_t kstep = (size_t)(BK * 2);
    const size_t hstep = (size_t)HALF * K * 2;
    const unsigned ldsw = (unsigned)wid * 1024u;
    const int aoff = lds_byte(wr * 64 + fr, fq * 8), boff = lds_byte(wc * 32 + fr, fq * 8);
#define PG8_SA(b, h) (((b) * 2 + (h)) * HTB)
#define PG8_SB(b, h) ((4 + (b) * 2 + (h)) * HTB)
#define PG8_STAGE(bufoff, gbase, voff) do { _Pragma("unroll") for (int _i = 0; _i < 2; ++_i) \
        __builtin_amdgcn_global_load_lds((const unsigned*)((const char*)(gbase) + (voff)[_i]), (LAS unsigned*)(lds + (bufoff) + ldsw + _i * 8192), 16, 0, 0); } while (0)
#define PG8_LDA(dst, b, h) do { _Pragma("unroll") for (int m = 0; m < 4; ++m) _Pragma("unroll") for (int k = 0; k < 2; ++k) dst[m][k] = *(const LAS bf16x8*)(lds + PG8_SA(b, h) + aoff + m * 2048 + k * 1024); } while (0)
#define PG8_LDB(dst, b, h) do { _Pragma("unroll") for (int n = 0; n < 2; ++n) _Pragma("unroll") for (int k = 0; k < 2; ++k) dst[n][k] = *(const LAS bf16x8*)(lds + PG8_SB(b, h) + boff + n * 2048 + k * 1024); } while (0)
#define PG8_MMA(ai, bj, At, Bt) do { __builtin_amdgcn_s_setprio(1); _Pragma("unroll") for (int m = 0; m < 4; ++m) _Pragma("unroll") for (int n = 0; n < 2; ++n) _Pragma("unroll") for (int k = 0; k < 2; ++k) \
        acc[ai][bj][m][n] = __builtin_amdgcn_mfma_f32_16x16x32_bf16(Bt[n][k], At[m][k], acc[ai][bj][m][n], 0, 0, 0); __builtin_amdgcn_s_setprio(0); } while (0)
#define PG8_WAIT_V(n) asm volatile("s_waitcnt vmcnt(" #n ")" ::: "memory")
#define PG8_WAIT_L(n) asm volatile("s_waitcnt lgkmcnt(" #n ")" ::: "memory")
#define PG8_BAR __builtin_amdgcn_s_barrier()
#define PG8_SCHED __builtin_amdgcn_sched_barrier(0)
    Unit cur, nxt; int ui = 0;
    if (!S.next(0, cur)) return;
    f32x4 acc[2][2][4][2];
#pragma unroll
    for (int a = 0; a < 2; ++a)
#pragma unroll
        for (int b = 0; b < 2; ++b)
#pragma unroll
            for (int m = 0; m < 4; ++m)
#pragma unroll
                for (int n = 0; n < 2; ++n) acc[a][b][m][n] = (f32x4){0.f, 0.f, 0.f, 0.f};
    bf16x8 At[4][2], B0[2][2], B1[2][2];
    const char* cA = cur.A; const char* cB = cur.B;
    PG8_STAGE(PG8_SB(0, 0), cB, voffB); PG8_STAGE(PG8_SA(0, 0), cA, voffA); PG8_STAGE(PG8_SB(0, 1), cB + hstep, voffB); PG8_STAGE(PG8_SA(0, 1), cA + hstep, voffA);
    if (wr == 1) PG8_BAR;
    PG8_WAIT_V(4); PG8_BAR;
    PG8_STAGE(PG8_SB(1, 0), cB + kstep, voffB); PG8_STAGE(PG8_SA(1, 0), cA + kstep, voffA); PG8_STAGE(PG8_SB(1, 1), cB + hstep + kstep, voffB);
    PG8_WAIT_V(6); PG8_BAR;
    for (;;) {
        const bool has_next = S.next(ui + 1, nxt);
        const char* nA = has_next ? nxt.A : cA; const char* nB = has_next ? nxt.B : cB;
        for (int t = 0; t < nt; t += 2) {
            const bool last = (t == nt - 2);
            const char* a1 = cA + (size_t)(t + 1) * kstep;
            const char* a2 = last ? nA : cA + (size_t)(t + 2) * kstep; const char* b2 = last ? nB : cB + (size_t)(t + 2) * kstep;
            const char* a3 = a2 + kstep; const char* b3 = b2 + kstep;
            PG8_LDB(B0, 0, 0); PG8_SCHED; PG8_LDA(At, 0, 0); PG8_STAGE(PG8_SA(1, 1), a1 + hstep, voffA);
            PG8_WAIT_L(8); PG8_BAR; PG8_WAIT_L(0); PG8_MMA(0, 0, At, B0); PG8_BAR; PG8_SCHED;
            PG8_LDB(B1, 0, 1); PG8_STAGE(PG8_SB(0, 0), b2, voffB);
            PG8_BAR; PG8_WAIT_L(0); PG8_MMA(0, 1, At, B1); PG8_BAR;
            PG8_LDA(At, 0, 1); PG8_STAGE(PG8_SA(0, 0), a2, voffA);
            PG8_BAR; PG8_WAIT_L(0); PG8_MMA(1, 0, At, B0); PG8_BAR; PG8_SCHED;
            PG8_STAGE(PG8_SB(0, 1), b2 + hstep, voffB);
            PG8_WAIT_V(6); PG8_BAR; PG8_MMA(1, 1, At, B1); PG8_BAR;
            PG8_LDB(B0, 1, 0); PG8_SCHED; PG8_LDA(At, 1, 0); PG8_STAGE(PG8_SA(0, 1), a2 + hstep, voffA);
            PG8_WAIT_L(8); PG8_BAR; PG8_WAIT_L(0); PG8_MMA(0, 0, At, B0); PG8_BAR; PG8_SCHED;
            PG8_LDB(B1, 1, 1); PG8_STAGE(PG8_SB(1, 0), b3, voffB);
            PG8_BAR; PG8_WAIT_L(0); PG8_MMA(0, 1, At, B1); PG8_BAR;
            PG8_LDA(At, 1, 1); PG8_STAGE(PG8_SA(1, 0), a3, voffA);
            PG8_BAR; PG8_WAIT_L(0); PG8_MMA(1, 0, At, B0); PG8_BAR; PG8_SCHED;
            PG8_STAGE(PG8_SB(1, 1), b3 + hstep, voffB);
            PG8_WAIT_V(6); PG8_BAR; PG8_MMA(1, 1, At, B1); PG8_BAR;
        }
        E(acc, cur, wr, wc, fr, fq);
        if (!has_next) break;
#pragma unroll
        for (int a = 0; a < 2; ++a)
#pragma unroll
            for (int b = 0; b < 2; ++b)
#pragma unroll
                for (int m = 0; m < 4; ++m)
#pragma unroll
                    for (int n = 0; n < 2; ++n) acc[a][b][m][n] = (f32x4){0.f, 0.f, 0.f, 0.f};
        cur = nxt; cA = nA; cB = nB; ++ui;
    }
    PG8_WAIT_V(0);
    if (wr == 0) PG8_BAR;
    PG8_BAR;
#undef PG8_SA
#undef PG8_SB
#undef PG8_STAGE
#undef PG8_LDA
#undef PG8_LDB
#undef PG8_MMA
#undef PG8_WAIT_V
#undef PG8_WAIT_L
#undef PG8_BAR
#undef PG8_SCHED
}

struct EpiIn {
    static constexpr bool PERM = true;
    unsigned char* ws;
    DI void operator()(const f32x4 (&acc)[2][2][4][2], const Unit& u, int wr, int wc, int fr, int fq) const {
        const int pn = u.pn; bf16_t* base; int ldc, colt, mode;
        if (pn < 4) { base = (bf16_t*)(ws + WS_ZA); ldc = 1024; colt = pn * 256; mode = 0; }
        else if (pn < 8) { base = (bf16_t*)(ws + WS_ZU); ldc = 1024; colt = (pn - 4) * 256; mode = 1; }
        else if (pn < 12) { base = (bf16_t*)(ws + WS_ZV); ldc = 1024; colt = (pn - 8) * 256; mode = 1; }
        else if (pn < 16) { base = (bf16_t*)(ws + WS_ZQ); ldc = 1024; colt = (pn - 12) * 256; mode = 0; }
        else if (pn == 16) { base = (bf16_t*)(ws + WS_ZK); ldc = 256; colt = 0; mode = 0; }
        else if (pn == 17) { base = (bf16_t*)(ws + WS_ZVV); ldc = 256; colt = 0; mode = 0; }
        else { base = (bf16_t*)(ws + WS_ZG); ldc = 3072; colt = (pn - 18) * 256; mode = 2; }
        const int row0 = u.pm * BM + wr * 64 + fr, col0 = colt + wc * 32 + 8 * fq;
#pragma unroll
        for (int ai = 0; ai < 2; ++ai)
#pragma unroll
            for (int m = 0; m < 4; ++m) { bf16_t* rowp = base + (size_t)(row0 + ai * HALF + m * 16) * ldc + col0;
#pragma unroll
                for (int bj = 0; bj < 2; ++bj) { f32x4 v0 = acc[ai][bj][m][0], v1 = acc[ai][bj][m][1];
                    if (mode == 1) {
#pragma unroll
                        for (int j = 0; j < 4; ++j) { v0[j] = gelu_tanh(v0[j]); v1[j] = gelu_tanh(v1[j]); } }
                    else if (mode == 2) {
#pragma unroll
                        for (int j = 0; j < 4; ++j) { v0[j] = sigmoidf_(v0[j]); v1[j] = sigmoidf_(v1[j]); } }
                    u32x4 w; w.x = pk2(v0[0], v0[1]); w.y = pk2(v0[2], v0[3]); w.z = pk2(v1[0], v1[1]); w.w = pk2(v1[2], v1[3]);
                    *(u32x4*)(rowp + bj * HALF) = w; } }
    }
};
struct EpiMerge {
    static constexpr bool PERM = true;
    bf16_t* Mg; const bf16_t* ZG;
    DI void operator()(const f32x4 (&acc)[2][2][4][2], const Unit& u, int wr, int wc, int fr, int fq) const {
        const int row0 = u.pm * BM + wr * 64 + fr, col0 = u.pn * BM + wc * 32 + 8 * fq, seg = u.seg;
#pragma unroll
        for (int ai = 0; ai < 2; ++ai)
#pragma unroll
            for (int m = 0; m < 4; ++m) { const size_t r = (size_t)(row0 + ai * HALF + m * 16);
#pragma unroll
                for (int bj = 0; bj < 2; ++bj) {
                    const u32x4 gw = *(const u32x4*)(ZG + r * 3072 + seg * 1024 + col0 + bj * HALF);
                    float g[8]; unpack8(gw, g);
                    const f32x4 v0 = acc[ai][bj][m][0], v1 = acc[ai][bj][m][1];
                    float o[8] = {g[0] * v0[0], g[1] * v0[1], g[2] * v0[2], g[3] * v0[3], g[4] * v1[0], g[5] * v1[1], g[6] * v1[2], g[7] * v1[3]};
                    u32x4* mp = (u32x4*)(Mg + r * 1024 + col0 + bj * HALF);
                    if (seg != 0) { float p[8]; unpack8(*mp, p);
#pragma unroll
                        for (int j = 0; j < 8; ++j) o[j] += p[j]; }
                    *mp = pack8(o); } }
    }
};
struct EpiRes {
    static constexpr bool PERM = false;
    const float* src_c; const float* src_l; float* dst_c; float* dst_l; const float* gate;
    DI void operator()(const f32x4 (&acc)[2][2][4][2], const Unit& u, int wr, int wc, int fr, int fq) const {
        const int rowt = u.pm * BM; const int grp = rowt < TC ? 4 : ((rowt - TC) >> 12);
        const float* src = rowt < TC ? src_c + (size_t)rowt * D : src_l + (size_t)(rowt - TC) * D;
        float* dst = rowt < TC ? dst_c + (size_t)rowt * D : dst_l + (size_t)(rowt - TC) * D;
        const int row0 = wr * 64 + fr, col0 = u.pn * BM + wc * 32 + 4 * fq;
        const float* gp = gate + grp * 6144 + col0;
        f32x4 gv[2][2];
#pragma unroll
        for (int bj = 0; bj < 2; ++bj)
#pragma unroll
            for (int n = 0; n < 2; ++n) gv[bj][n] = *(const f32x4*)(gp + bj * HALF + n * 16);
#pragma unroll
        for (int ai = 0; ai < 2; ++ai)
#pragma unroll
            for (int m = 0; m < 4; ++m) { const size_t off = (size_t)(row0 + ai * HALF + m * 16) * D + col0;
#pragma unroll
                for (int bj = 0; bj < 2; ++bj)
#pragma unroll
                    for (int n = 0; n < 2; ++n) { const f32x4 xs = *(const f32x4*)(src + off + bj * HALF + n * 16);
                        *(f32x4*)(dst + off + bj * HALF + n * 16) = xs + gv[bj][n] * acc[ai][bj][m][n]; } }
    }
};
struct EpiFF1 {
    static constexpr bool PERM = true;
    bf16_t* O;
    DI void operator()(const f32x4 (&acc)[2][2][4][2], const Unit& u, int wr, int wc, int fr, int fq) const {
        const int row0 = u.pm * BM + wr * 64 + fr, col0 = u.pn * BM + wc * 32 + 8 * fq;
#pragma unroll
        for (int ai = 0; ai < 2; ++ai)
#pragma unroll
            for (int m = 0; m < 4; ++m) { bf16_t* rowp = O + (size_t)(row0 + ai * HALF + m * 16) * DFF + col0;
#pragma unroll
                for (int bj = 0; bj < 2; ++bj) { f32x4 v0 = acc[ai][bj][m][0], v1 = acc[ai][bj][m][1];
#pragma unroll
                    for (int j = 0; j < 4; ++j) { const float a = fmaxf(v0[j], 0.f), b = fmaxf(v1[j], 0.f); v0[j] = a * a; v1[j] = b * b; }
                    u32x4 w; w.x = pk2(v0[0], v0[1]); w.y = pk2(v0[2], v0[3]); w.z = pk2(v1[0], v1[1]); w.w = pk2(v1[2], v1[3]);
                    *(u32x4*)(rowp + bj * HALF) = w; } }
    }
};
}

DI void phase_prep(const Args& a, LAS unsigned char* lds) {
    const int tid = tidx(), bid = bidx(), G = gridDim.x;
    if (bid == (1 % G)) {
        float* cosT = (float*)(wsp() + WS_ROPE); float* sinT = cosT + 1024;
        for (int i = tid; i < 1024; i += 512) { const int pos = i >> 4, f = i & 15; const float inv = powf(10000.0f, -(float)f / 16.0f); const float ang = (float)pos * inv;
            cosT[i] = cosf(ang); sinT[i] = sinf(ang); }
    }
    LAS float* cond = (LAS float*)lds;
    LAS float* red = (LAS float*)(lds + 20480);
    for (int i = tid; i < 5 * 1024; i += 512) { const int g = i >> 10, k = i & 1023; const float v = g < 4 ? inp<1>()[g * 1024 + k] : inp<3>()[k]; cond[i] = v * sigmoidf_(v); }
    __syncthreads();
    float* mod = (float*)(wsp() + WS_MOD);
    for (int it = bid; it < DEPTH * 96; it += G) {
        const int l = it / 96, cb = it % 96, c = tid & 63, kg = tid >> 6, col = cb * 64 + c;
        const float* w = inp<4>() + (size_t)l * D * 6144 + col;
        float acc[5] = {0.f, 0.f, 0.f, 0.f, 0.f};
#pragma unroll 8
        for (int k = kg * 128; k < kg * 128 + 128; ++k) { const float wv = w[(size_t)k * 6144];
#pragma unroll
            for (int g = 0; g < 5; ++g) acc[g] += cond[g * 1024 + k] * wv; }
#pragma unroll
        for (int g = 0; g < 5; ++g) red[(kg * 5 + g) * 64 + c] = acc[g];
        __syncthreads();
        if (tid < 320) { const int g = tid >> 6; float s = inp<5>()[l * 6144 + col];
#pragma unroll
            for (int k2 = 0; k2 < 8; ++k2) s += red[(k2 * 5 + g) * 64 + c];
            mod[(size_t)(l * 5 + g) * 6144 + col] = s; }
        __syncthreads();
    }
}

DI void transpose_item(const float* W, int K, int N, bf16_t* WT, LAS float* scr, int item, int lane) {
    const int nblk = N / 32, kb = item / nblk, nb = item % nblk, k0 = 64 * kb, n0 = 32 * nb;
#pragma unroll 8
    for (int i = 0; i < 32; ++i) { const int kk = 2 * i + (lane >> 5); scr[kk * 33 + (lane & 31)] = W[(size_t)(k0 + kk) * N + n0 + (lane & 31)]; }
    asm volatile("s_waitcnt lgkmcnt(0)" ::: "memory");
    const int c = lane & 7;
#pragma unroll
    for (int j = 0; j < 4; ++j) { const int n = (lane >> 3) + 8 * j; const LAS float* s = scr + (8 * c) * 33 + n;
        u32x4 o; o.x = pk2(s[0 * 33], s[1 * 33]); o.y = pk2(s[2 * 33], s[3 * 33]); o.z = pk2(s[4 * 33], s[5 * 33]); o.w = pk2(s[6 * 33], s[7 * 33]);
        *(u32x4*)(WT + (size_t)(n0 + n) * K + k0 + 8 * c) = o; }
    asm volatile("s_waitcnt lgkmcnt(0)" ::: "memory");
}

DI void phase_norm(const Args& a, LAS unsigned char* lds, int l, int which) {
    const int tid = tidx(), lane = tid & 63, wave = tid >> 6, G = gridDim.x;
    const int gw = bidx() * 8 + wave, NGW = G * 8;
    if (which == 0) {
        LAS float* scr = (LAS float*)(lds + wave * 8448);
        constexpr int I_IN = 16 * (INW / 32), I_BR = 16 * 32, I_FF1 = 16 * (DFF / 32), I_FF2 = 64 * 32;
        constexpr int NIT = I_IN + 4 * I_BR + I_FF1 + I_FF2;
        for (int it = gw; it < NIT; it += NGW) {
            int r = it;
            if (r < I_IN) { transpose_item(inp<7>() + (size_t)l * D * INW, D, INW, (bf16_t*)(wsp() + WS_WIN), scr, r, lane); continue; } r -= I_IN;
            if (r < 3 * I_BR) { const int s = r / I_BR; transpose_item(inp<22>() + ((size_t)l * 3 + s) * D * D, D, D, (bf16_t*)(wsp() + WS_WBR) + (size_t)s * D * D, scr, r % I_BR, lane); continue; } r -= 3 * I_BR;
            if (r < I_BR) { transpose_item(inp<23>() + (size_t)l * D * D, D, D, (bf16_t*)(wsp() + WS_WOUT), scr, r, lane); continue; } r -= I_BR;
            if (r < I_FF1) { transpose_item(inp<25>() + (size_t)l * D * DFF, D, DFF, (bf16_t*)(wsp() + WS_WFF1), scr, r, lane); continue; } r -= I_FF1;
            transpose_item(inp<26>() + (size_t)l * DFF * D, DFF, D, (bf16_t*)(wsp() + WS_WFF2), scr, r, lane);
        }
    }
    const bool from_in = (l == 0 && which == 0);
    const float* xc_src = from_in ? inp<2>() : (const float*)(wsp() + WS_XC);
    const float* xl_src = from_in ? inp<0>() : (const float*)outp();
    const float* gn = (which == 0 ? inp<6>() : inp<24>()) + l * D;
    const float* mod = (const float*)(wsp() + WS_MOD) + (size_t)l * 5 * 6144 + (which ? 3 * 1024 : 0);
    bf16_t* H = (bf16_t*)(wsp() + WS_H);
    const int rstart = (which == 1 && l == DEPTH - 1) ? TC : 0;
    for (int r = rstart + gw; r < T; r += NGW) {
        const float* xrow = r < TC ? xc_src + (size_t)r * D : xl_src + (size_t)(r - TC) * D;
        const int grp = r < TC ? 4 : ((r - TC) >> 12);
        const float* sh = mod + grp * 6144; const float* sc = sh + 1024;
        f32x4 v[4]; float ss = 0.f;
#pragma unroll
        for (int j = 0; j < 4; ++j) { v[j] = *((const f32x4*)xrow + lane + 64 * j); ss += (v[j].x * v[j].x + v[j].y * v[j].y) + (v[j].z * v[j].z + v[j].w * v[j].w); }
        const float rstd = 1.0f / sqrtf(wave_sum(ss) * (1.0f / D) + EPS);
#pragma unroll
        for (int j = 0; j < 4; ++j) { const int k = (lane + 64 * j) * 4; const f32x4 g = *(const f32x4*)(gn + k), s1 = *(const f32x4*)(sc + k), s0 = *(const f32x4*)(sh + k);
            const f32x4 y = (v[j] * rstd * g) * (s1 + 1.0f) + s0;
            u32x2 o; o.x = pk2(y.x, y.y); o.y = pk2(y.z, y.w);
            *(u32x2*)(H + (size_t)r * D + k) = o; }
    }
}

DI void scan_item(const Args& a, LAS unsigned char* lds, int l, int b, int cb) {
    const int tid = tidx(), half = tid >> 8, ht = tid & 255, lane = tid & 63, hw = (tid >> 6) & 3, hh = lane >> 5, r32 = lane & 31;
    LAS unsigned char* hb = lds + half * 65024;
    LAS bf16_t* WaT = (LAS bf16_t*)hb;
    LAS bf16_t* WxT = (LAS bf16_t*)(hb + 9216);
    LAS bf16_t* xcb = (LAS bf16_t*)(hb + 18432);
    LAS float* As = (LAS float*)(hb + 27648);
    LAS float* Us = (LAS float*)(hb + 44032);
    LAS float* carry = (LAS float*)(hb + 60416);
    LAS float* segP = (LAS float*)(hb + 60928);
    LAS float* segH = (LAS float*)(hb + 61952);
    LAS float* prm = (LAS float*)(hb + 62976);
    const bf16_t* ZA = (const bf16_t*)(wsp() + WS_ZA); bf16_t* YA = (bf16_t*)(wsp() + WS_H);
    {
        const size_t wofs = (((size_t)l * 2 + half) * 16 + cb) * 4096;
        const float* wa = inp<10>() + wofs; const float* wx = inp<12>() + wofs;
        for (int i = ht; i < 4096; i += 256) { const int ii = i >> 6, jj = i & 63; WaT[jj * 72 + ii] = f2bf(wa[i]); WxT[jj * 72 + ii] = f2bf(wx[i]); }
        if (ht < 64) { const int ch = cb * 64 + ht; const size_t po = ((size_t)l * 2 + half) * D + ch;
            prm[ht] = inp<11>()[po]; prm[64 + ht] = inp<13>()[po];
            const float lam = inp<14>()[po]; prm[128 + ht] = 8.0f * log1pf(expf(-lam));
#pragma unroll
            for (int k = 0; k < 4; ++k) prm[192 + k * 64 + ht] = inp<8>()[((size_t)l * 4 + k) * D + ch];
            prm[448 + ht] = inp<9>()[(size_t)l * D + ch];
            carry[ht] = 0.f; }
    }
    __syncthreads();
    for (int step = 0; step < 68; ++step) {
        int gid; if (half == 0) gid = step; else gid = step < 4 ? 3 - step : 71 - step;
        const bool isctx = gid < 4; const int chunk = isctx ? gid : gid - 4;
        const int L = isctx ? CTX : SEQ; const int rowbase = isctx ? b * CTX : TC + b * SEQ;
        const bool fwd_first = isctx ? (gid <= 1) : (gid <= 35);
        const bool second = (half == 0) ? !fwd_first : fwd_first;
        {
            const int tok = ht >> 2, c0 = (ht & 3) * 16;
            float xc[16];
#pragma unroll
            for (int j = 0; j < 16; ++j) xc[j] = prm[448 + c0 + j];
#pragma unroll
            for (int k = 0; k < 4; ++k) { const int ts = chunk * 64 + tok + k - 2;
                if (ts >= 0 && ts < L) { const bf16_t* p = ZA + (size_t)(rowbase + ts) * D + cb * 64 + c0;
                    const u32x4 w0 = *(const u32x4*)p, w1 = *(const u32x4*)(p + 8); float x0[8], x1[8]; unpack8(w0, x0); unpack8(w1, x1);
#pragma unroll
                    for (int j = 0; j < 8; ++j) { xc[j] += prm[192 + k * 64 + c0 + j] * x0[j]; xc[8 + j] += prm[192 + k * 64 + c0 + 8 + j] * x1[j]; } } }
            float t0[8], t1[8];
#pragma unroll
            for (int j = 0; j < 8; ++j) { t0[j] = xc[j]; t1[j] = xc[8 + j]; }
            *(LAS u32x4*)(xcb + tok * 72 + c0) = pack8(t0); *(LAS u32x4*)(xcb + tok * 72 + c0 + 8) = pack8(t1);
        }
        __syncthreads();
        {
            const int tb = 32 * (hw & 1), jb = 32 * (hw >> 1);
            f32x16 ar, ai;
#pragma unroll
            for (int i = 0; i < 16; ++i) { ar[i] = 0.f; ai[i] = 0.f; }
#pragma unroll
            for (int s = 0; s < 4; ++s) { const bf16x8 xa = *(const LAS bf16x8*)(xcb + (tb + r32) * 72 + 16 * s + 8 * hh);
                const bf16x8 wa = *(const LAS bf16x8*)(WaT + (jb + r32) * 72 + 16 * s + 8 * hh), wx = *(const LAS bf16x8*)(WxT + (jb + r32) * 72 + 16 * s + 8 * hh);
                ar = MFMA32(xa, wa, ar); ai = MFMA32(xa, wx, ai); }
            const int j = jb + r32; const float ba = prm[j], bx = prm[64 + j], sp8 = prm[128 + j];
#pragma unroll
            for (int i = 0; i < 16; ++i) { const int tok = tb + (i & 3) + 8 * (i >> 2) + 4 * hh;
                const float r = sigmoidf_(ar[i] + ba), ig = sigmoidf_(ai[i] + bx);
                const float la = -r * sp8; const float av = fexp2(la * LOG2E); const float mult = sqrtf(fmaxf(-expm1f(2.0f * la), 0.f));
                const float x = bf1(xcb[tok * 72 + j]);
                As[tok * 64 + j] = av; Us[tok * 64 + j] = x * ig * mult; }
        }
        __syncthreads();
        const int c = ht & 63, seg = ht >> 6;
        {
            float h = 0.f, P = 1.f;
#pragma unroll 4
            for (int p = seg * 16; p < seg * 16 + 16; ++p) { const int tok = half ? 63 - p : p; const float av = As[tok * 64 + c], uv = Us[tok * 64 + c];
                h = av * h + uv; P *= av; Us[tok * 64 + c] = h; As[tok * 64 + c] = P; }
            segH[seg * 64 + c] = h; segP[seg * 64 + c] = P;
        }
        __syncthreads();
        {
            float cin = carry[(step & 1) * 64 + c];
            for (int s2 = 0; s2 < seg; ++s2) cin = segP[s2 * 64 + c] * cin + segH[s2 * 64 + c];
            float hl = 0.f;
#pragma unroll 4
            for (int p = seg * 16; p < seg * 16 + 16; ++p) { const int tok = half ? 63 - p : p; hl = Us[tok * 64 + c] + As[tok * 64 + c] * cin; Us[tok * 64 + c] = hl; }
            if (seg == 3) carry[((step + 1) & 1) * 64 + c] = hl;
        }
        __syncthreads();
        {
            const int tok = ht >> 2, c0 = (ht & 3) * 16;
            bf16_t* p = YA + (size_t)(rowbase + chunk * 64 + tok) * D + cb * 64 + c0;
            float o0[8], o1[8];
#pragma unroll
            for (int j = 0; j < 8; ++j) { o0[j] = Us[tok * 64 + c0 + j]; o1[j] = Us[tok * 64 + c0 + 8 + j]; }
            if (second && !DBG_NOADD) { float e0[8], e1[8]; const unsigned long long* pq = (const unsigned long long*)p;
                const unsigned long long q0 = __hip_atomic_load(pq, __ATOMIC_RELAXED, __HIP_MEMORY_SCOPE_AGENT), q1 = __hip_atomic_load(pq + 1, __ATOMIC_RELAXED, __HIP_MEMORY_SCOPE_AGENT),
                                         q2 = __hip_atomic_load(pq + 2, __ATOMIC_RELAXED, __HIP_MEMORY_SCOPE_AGENT), q3 = __hip_atomic_load(pq + 3, __ATOMIC_RELAXED, __HIP_MEMORY_SCOPE_AGENT);
                u32x4 wA, wB; wA.x = (unsigned)q0; wA.y = (unsigned)(q0 >> 32); wA.z = (unsigned)q1; wA.w = (unsigned)(q1 >> 32); wB.x = (unsigned)q2; wB.y = (unsigned)(q2 >> 32); wB.z = (unsigned)q3; wB.w = (unsigned)(q3 >> 32);
                unpack8(wA, e0); unpack8(wB, e1);
#pragma unroll
                for (int j = 0; j < 8; ++j) { o0[j] += e0[j]; o1[j] += e1[j]; } }
            *(u32x4*)p = pack8(o0); *(u32x4*)(p + 8) = pack8(o1);
        }
        __syncthreads();
    }
}

DI void sgu_item(const Args& a, LAS unsigned char* lds, int l, int tc) {
    const int tid = tidx(), lane = tid & 63, w = tid >> 6, hh = lane >> 5, r32 = lane & 31;
    const int row0 = tc < 8 ? (tc >> 1) * CTX + (tc & 1) * 128 : TC + ((tc - 8) >> 5) * SEQ + ((tc - 8) & 31) * 128;
    LAS bf16_t* Wl = (LAS bf16_t*)lds;
    LAS bf16_t* VnT = (LAS bf16_t*)(lds + 34816);
    LAS float* st = (LAS float*)(lds + 69632);
    const bf16_t* ZV = (const bf16_t*)(wsp() + WS_ZV); bf16_t* ZU = (bf16_t*)(wsp() + WS_ZU);
    for (int t = w * 16; t < w * 16 + 16; ++t) {
        const bf16_t* p = ZV + (size_t)(row0 + t) * D + lane * 16;
        float x0[8], x1[8]; unpack8(*(const u32x4*)p, x0); unpack8(*(const u32x4*)(p + 8), x1);
        float s = 0.f;
#pragma unroll
        for (int j = 0; j < 8; ++j) s += x0[j] + x1[j];
        const float mean = wave_sum(s) * (1.0f / D); float q = 0.f;
#pragma unroll
        for (int j = 0; j < 8; ++j) { const float d0 = x0[j] - mean, d1 = x1[j] - mean; q += d0 * d0 + d1 * d1; }
        const float var = wave_sum(q) * (1.0f / D);
        if (lane == 0) { st[t * 2] = mean; st[t * 2 + 1] = 1.0f / sqrtf(var + EPS); }
    }
    __syncthreads();
    for (int g = 0; g < 8; ++g) {
        {
            const float* ws = inp<17>() + ((size_t)l * 8 + g) * 16384;
#pragma unroll
            for (int it = 0; it < 8; ++it) { const int idx = (it * 512 + tid) * 4; const f32x4 v = *(const f32x4*)(ws + idx); const int p = idx >> 7, q = idx & 127;
                u32x2 o; o.x = pk2(v.x, v.y); o.y = pk2(v.z, v.w); *(LAS u32x2*)(Wl + p * 136 + q) = o; }
            const int tok = tid >> 2, c0 = (tid & 3) * 32;
            const float mean = st[tok * 2], rstd = st[tok * 2 + 1];
            const bf16_t* p = ZV + (size_t)(row0 + tok) * D + g * 128 + c0;
            const float* lg = inp<15>() + (size_t)l * D + g * 128 + c0; const float* lb = inp<16>() + (size_t)l * D + g * 128 + c0;
#pragma unroll
            for (int q4 = 0; q4 < 4; ++q4) { float x[8]; unpack8(*(const u32x4*)(p + q4 * 8), x);
#pragma unroll
                for (int j = 0; j < 8; ++j) { const int cc = q4 * 8 + j; VnT[(c0 + cc) * 136 + tok] = f2bf((x[j] - mean) * rstd * lg[cc] + lb[cc]); } }
        }
        __syncthreads();
        {
            const int pt = w >> 1, ch = w & 1;
            f32x16 acc[2];
#pragma unroll
            for (int i = 0; i < 16; ++i) { acc[0][i] = 0.f; acc[1][i] = 0.f; }
#pragma unroll
            for (int s = 0; s < 8; ++s) { const bf16x8 af = *(const LAS bf16x8*)(Wl + (32 * pt + r32) * 136 + 16 * s + 8 * hh);
#pragma unroll
                for (int nt = 0; nt < 2; ++nt) { const bf16x8 bfr = *(const LAS bf16x8*)(VnT + (64 * ch + 32 * nt + r32) * 136 + 16 * s + 8 * hh); acc[nt] = MFMA32(af, bfr, acc[nt]); } }
            const float* sb = inp<18>() + ((size_t)l * 8 + g) * 128;
#pragma unroll
            for (int nt = 0; nt < 2; ++nt)
#pragma unroll
                for (int i = 0; i < 16; ++i) { const int p = 32 * pt + (i & 3) + 8 * (i >> 2) + 4 * hh, c = 64 * ch + 32 * nt + r32;
                    bf16_t* up = ZU + (size_t)(row0 + p) * D + g * 128 + c;
                    *up = f2bf(bf1(*up) * (acc[nt][i] + sb[p])); }
        }
        __syncthreads();
    }
}

DI void attn_tile(const LAS bf16_t* Ks, const LAS bf16_t* Vt, int kb, const bf16x8 (&qf)[2][4], float (&m)[2], float (&ls)[2], f32x16 (&o)[2][2],
                  int r32, int hh, bool masked, int qloc0, int kv_lo, int kv_hi) {
    bf16x8 kf[4];
#pragma unroll
    for (int s = 0; s < 4; ++s) kf[s] = *(const LAS bf16x8*)(Ks + (kb + r32) * 72 + 16 * s + 8 * hh);
    bf16x8 pf[2][2];
#pragma unroll
    for (int qt = 0; qt < 2; ++qt) {
        f32x16 sc;
#pragma unroll
        for (int i = 0; i < 16; ++i) sc[i] = 0.f;
#pragma unroll
        for (int s = 0; s < 4; ++s) sc = MFMA32(kf[s], qf[qt][s], sc);
        if (masked) { const int ql = qloc0 + 32 * qt + r32;
#pragma unroll
            for (int i = 0; i < 16; ++i) { const int key = kb + (i & 3) + 8 * (i >> 2) + 4 * hh; const int df = key - 128 - ql;
                const bool ok = (df >= -128) && (df <= 128) && (key >= kv_lo) && (key < kv_hi); sc[i] = ok ? sc[i] : -1e30f; } }
        float mx = sc[0];
#pragma unroll
        for (int i = 1; i < 16; ++i) mx = fmaxf(mx, sc[i]);
        mx = fmaxf(mx, __shfl_xor(mx, 32));
        const float mn = fmaxf(m[qt], mx); const float alpha = fexp2(m[qt] - mn); m[qt] = mn;
        float p[16]; float rs = 0.f;
#pragma unroll
        for (int i = 0; i < 16; ++i) { p[i] = fexp2(sc[i] - mn); rs += p[i]; }
        ls[qt] = ls[qt] * alpha + rs;
#pragma unroll
        for (int i = 0; i < 16; ++i) { o[qt][0][i] *= alpha; o[qt][1][i] *= alpha; }
#pragma unroll
        for (int ks = 0; ks < 2; ++ks) { u32x4 w; w.x = pk2(p[8 * ks], p[8 * ks + 1]); w.y = pk2(p[8 * ks + 2], p[8 * ks + 3]); w.z = pk2(p[8 * ks + 4], p[8 * ks + 5]); w.w = pk2(p[8 * ks + 6], p[8 * ks + 7]);
            pf[qt][ks] = __builtin_bit_cast(bf16x8, w); }
    }
#pragma unroll
    for (int dt = 0; dt < 2; ++dt)
#pragma unroll
        for (int ks = 0; ks < 2; ++ks) { const LAS bf16_t* vp = Vt + (32 * dt + r32) * 392 + kb + 16 * ks + 4 * hh;
            const u32x2 lo = *(const LAS u32x2*)vp, hi = *(const LAS u32x2*)(vp + 8);
            u32x4 w; w.x = lo.x; w.y = lo.y; w.z = hi.x; w.w = hi.y; const bf16x8 vf = __builtin_bit_cast(bf16x8, w);
#pragma unroll
            for (int qt = 0; qt < 2; ++qt) o[qt][dt] = MFMA32(vf, pf[qt][ks], o[qt][dt]); }
}

DI void attn_stage(const Args& a, LAS bf16_t* Ks, LAS bf16_t* Vt, int l, bool ctxstage, int b, int n, int kvh) {
    const int tid = tidx(), e = tid & 7;
    const bf16_t* ZK = (const bf16_t*)(wsp() + WS_ZK); const bf16_t* ZVV = (const bf16_t*)(wsp() + WS_ZVV);
    const float* cosT = (const float*)(wsp() + WS_ROPE); const float* sinT = cosT + 1024;
    const float* kg = inp<20>() + l * 64 + e * 8;
    float kgv[8];
#pragma unroll
    for (int j = 0; j < 8; ++j) kgv[j] = kg[j];
    const int nk = ctxstage ? 256 : 384;
    for (int key0 = 0; key0 < nk; key0 += 64) {
        const int key = key0 + (tid >> 3);
        int kt = 0, row; bool valid = true;
        if (ctxstage) row = b * CTX + key; else { kt = n * 128 - 128 + key; valid = (kt >= 0) && (kt < SEQ); kt = kt < 0 ? 0 : (kt >= SEQ ? SEQ - 1 : kt); row = TC + b * SEQ + kt; }
        u32x4 kw = {0u, 0u, 0u, 0u}, vw = {0u, 0u, 0u, 0u};
        if (valid) { kw = *(const u32x4*)(ZK + (size_t)row * 256 + kvh * 64 + e * 8); vw = *(const u32x4*)(ZVV + (size_t)row * 256 + kvh * 64 + e * 8); }
        float x[8]; unpack8(kw, x);
        float ss = 0.f;
#pragma unroll
        for (int j = 0; j < 8; ++j) ss += x[j] * x[j];
        ss += __shfl_xor(ss, 1); ss += __shfl_xor(ss, 2); ss += __shfl_xor(ss, 4);
        const float rstd = 1.0f / sqrtf(ss * (1.0f / 64.0f) + EPS);
#pragma unroll
        for (int j = 0; j < 8; ++j) x[j] = x[j] * rstd * kgv[j];
        if (!ctxstage) {
            const int pos = (e >> 2) ? (kt & 63) : (kt >> 6); const bool second = (e >> 1) & 1; const int f0 = 8 * (e & 1);
#pragma unroll
            for (int j = 0; j < 8; ++j) { const float pr = __shfl_xor(x[j], 2); const float cs = cosT[pos * 16 + f0 + j], sn = sinT[pos * 16 + f0 + j];
                x[j] = second ? (x[j] * cs + pr * sn) : (x[j] * cs - pr * sn); }
        }
        *(LAS u32x4*)(Ks + key * 72 + e * 8) = pack8(x);
        Vt[(e * 8 + 0) * 392 + key] = (bf16_t)(vw.x & 0xffffu); Vt[(e * 8 + 1) * 392 + key] = (bf16_t)(vw.x >> 16);
        Vt[(e * 8 + 2) * 392 + key] = (bf16_t)(vw.y & 0xffffu); Vt[(e * 8 + 3) * 392 + key] = (bf16_t)(vw.y >> 16);
        Vt[(e * 8 + 4) * 392 + key] = (bf16_t)(vw.z & 0xffffu); Vt[(e * 8 + 5) * 392 + key] = (bf16_t)(vw.z >> 16);
        Vt[(e * 8 + 6) * 392 + key] = (bf16_t)(vw.w & 0xffffu); Vt[(e * 8 + 7) * 392 + key] = (bf16_t)(vw.w >> 16);
    }
}

DI void attn_item(const Args& a, LAS unsigned char* lds, int l, int kind, int b, int n, int kvh) {
    const int tid = tidx(), lane = tid & 63, w = tid >> 6, hh = lane >> 5, r32 = lane & 31;
    const int g = w >> 1, qhalf = w & 1, h = kvh * 4 + g, qloc0 = qhalf * 64;
    LAS bf16_t* Ks = (LAS bf16_t*)lds;
    LAS bf16_t* Vt = (LAS bf16_t*)(lds + 55296);
    bf16_t* ZQ = (bf16_t*)(wsp() + WS_ZQ);
    const float* cosT = (const float*)(wsp() + WS_ROPE); const float* sinT = cosT + 1024;
    const float* qg = inp<19>() + l * 64;
    const float SCL = 0.125f * LOG2E;
    bf16x8 qf[2][4];
#pragma unroll
    for (int qt = 0; qt < 2; ++qt) {
        const int qtok = n * 128 + qloc0 + 32 * qt + r32; const int row = kind ? b * CTX + qtok : TC + b * SEQ + qtok;
        const bf16_t* qp = ZQ + (size_t)row * D + h * 64 + 8 * hh;
        float v[4][8]; float ss = 0.f;
#pragma unroll
        for (int s = 0; s < 4; ++s) { unpack8(*(const u32x4*)(qp + 16 * s), v[s]);
#pragma unroll
            for (int j = 0; j < 8; ++j) ss += v[s][j] * v[s][j]; }
        ss += __shfl_xor(ss, 32);
        const float rstd = 1.0f / sqrtf(ss * (1.0f / 64.0f) + EPS);
#pragma unroll
        for (int s = 0; s < 4; ++s)
#pragma unroll
            for (int j = 0; j < 8; ++j) v[s][j] = v[s][j] * rstd * qg[16 * s + 8 * hh + j];
        if (!kind) { const int prow = qtok >> 6, pcol = qtok & 63;
#pragma unroll
            for (int j = 0; j < 8; ++j) { const int f = 8 * hh + j;
                const float c0 = cosT[prow * 16 + f], s0 = sinT[prow * 16 + f], c1 = cosT[pcol * 16 + f], s1 = sinT[pcol * 16 + f];
                const float t1 = v[0][j], t2 = v[1][j]; v[0][j] = t1 * c0 - t2 * s0; v[1][j] = t2 * c0 + t1 * s0;
                const float t3 = v[2][j], t4 = v[3][j]; v[2][j] = t3 * c1 - t4 * s1; v[3][j] = t4 * c1 + t3 * s1; } }
#pragma unroll
        for (int s = 0; s < 4; ++s) {
#pragma unroll
            for (int j = 0; j < 8; ++j) v[s][j] *= SCL;
            qf[qt][s] = __builtin_bit_cast(bf16x8, pack8(v[s])); }
    }
    const float sk = inp<21>()[l * 16 + h] * LOG2E;
    float m[2] = {sk, sk}; float ls[2]; ls[0] = ls[1] = (hh == 0) ? 1.0f : 0.0f;
    f32x16 o[2][2];
#pragma unroll
    for (int i = 0; i < 16; ++i) { o[0][0][i] = 0.f; o[0][1][i] = 0.f; o[1][0][i] = 0.f; o[1][1][i] = 0.f; }
    if (!kind) {
        attn_stage(a, Ks, Vt, l, false, b, n, kvh);
        __syncthreads();
        const int kv_lo = 128 - n * 128 > 0 ? 128 - n * 128 : 0; const int kv_hi = (SEQ - n * 128 + 128) < 384 ? (SEQ - n * 128 + 128) : 384;
        int t_lo = qhalf ? 2 : 0, t_hi = qhalf ? 12 : 10;
        if (t_lo < (kv_lo >> 5)) t_lo = kv_lo >> 5;
        if (t_hi > (kv_hi >> 5)) t_hi = kv_hi >> 5;
        for (int t = t_lo; t < t_hi; ++t) attn_tile(Ks, Vt, 32 * t, qf, m, ls, o, r32, hh, true, qloc0, kv_lo, kv_hi);
        __syncthreads();
    }
    attn_stage(a, Ks, Vt, l, true, b, n, kvh);
    __syncthreads();
    for (int t = 0; t < 8; ++t) attn_tile(Ks, Vt, 32 * t, qf, m, ls, o, r32, hh, false, qloc0, 0, 256);
#pragma unroll
    for (int qt = 0; qt < 2; ++qt) {
        const float lt = ls[qt] + __shfl_xor(ls[qt], 32); const float inv = 1.0f / lt;
        const int qtok = n * 128 + qloc0 + 32 * qt + r32; const int row = kind ? b * CTX + qtok : TC + b * SEQ + qtok;
        bf16_t* op = ZQ + (size_t)row * D + h * 64 + 4 * hh;
#pragma unroll
        for (int dt = 0; dt < 2; ++dt)
#pragma unroll
            for (int q4 = 0; q4 < 4; ++q4) { u32x2 wv; wv.x = pk2(o[qt][dt][4 * q4] * inv, o[qt][dt][4 * q4 + 1] * inv); wv.y = pk2(o[qt][dt][4 * q4 + 2] * inv, o[qt][dt][4 * q4 + 3] * inv);
                *(u32x2*)(op + 32 * dt + 8 * q4) = wv; }
    }
}

DI void phase_mix(const Args& a, LAS unsigned char* lds, int l) {
    const int tid = tidx();
    const bool last = (l == DEPTH - 1);
    unsigned* ctr = (unsigned*)(wsp() + WS_CTL) + l;
    LAS int* slot = (LAS int*)(lds + LDS_MISC);
    const int n_scan = 64, n_attl = 512, n_attc = last ? 0 : 32, n_sgu = last ? 128 : 136;
    const int total = n_scan + n_attl + n_attc + n_sgu;
    for (;;) {
        __syncthreads();
        if (tid == 0) *slot = (int)atomicAdd(ctr, 1u);
        __syncthreads();
        int it = *slot;
        if (it >= total) break;
#ifndef NO_SCAN
        if (it < n_scan) { scan_item(a, lds, l, it >> 4, it & 15); continue; }
#endif
        it -= n_scan;
#ifndef NO_ATT
        if (it < n_attl) { attn_item(a, lds, l, 0, it >> 7, (it >> 2) & 31, it & 3); continue; }
#endif
        it -= n_attl;
#ifndef NO_ATT
        if (it < n_attc) { attn_item(a, lds, l, 1, it >> 3, (it >> 2) & 1, it & 3); continue; }
#endif
        it -= n_attc;
#ifndef NO_SGU
        sgu_item(a, lds, l, last ? it + 8 : it);
#endif
    }
}


DI void grid_barrier(unsigned* bar, unsigned target) {
    asm volatile("s_waitcnt vmcnt(0) lgkmcnt(0)" ::: "memory");
    __syncthreads();
    if (threadIdx.x == 0) {
        __builtin_amdgcn_fence(__ATOMIC_RELEASE, "agent");
        __hip_atomic_fetch_add(bar, 1u, __ATOMIC_RELAXED, __HIP_MEMORY_SCOPE_AGENT);
        while (__hip_atomic_load(bar, __ATOMIC_RELAXED, __HIP_MEMORY_SCOPE_AGENT) < target) __builtin_amdgcn_s_sleep(2);
        __builtin_amdgcn_fence(__ATOMIC_ACQUIRE, "agent");
    }
    __syncthreads();
}


#ifdef DBG_STOP
DI void dbg_dump(int which) {
    unsigned char* ws = wsp(); float* out = outp();
    const size_t n = (size_t)TL * D, stride = (size_t)gridDim.x * 512;
    const bf16_t* H = (const bf16_t*)(ws + WS_H); const bf16_t* MG = (const bf16_t*)(ws + WS_MG);
    const bf16_t* ZA = (const bf16_t*)(ws + WS_ZA); const bf16_t* ZU = (const bf16_t*)(ws + WS_ZU); const bf16_t* ZV = (const bf16_t*)(ws + WS_ZV); const bf16_t* ZQ = (const bf16_t*)(ws + WS_ZQ);
    const bf16_t* ZK = (const bf16_t*)(ws + WS_ZK); const bf16_t* ZVV = (const bf16_t*)(ws + WS_ZVV); const bf16_t* ZG = (const bf16_t*)(ws + WS_ZG);
    for (size_t i = (size_t)blockIdx.x * 512 + threadIdx.x; i < n; i += stride) {
        float v = 0.f;
        if (which == 1) v = bf1(H[i]) + bf1(H[i + (size_t)TC * D]);
        if (which == 2) v = bf1(ZA[i]) + bf1(ZU[i]) + bf1(ZV[i]) + bf1(ZQ[i]) + bf1(ZG[i]) + bf1(ZG[i + n]) + bf1(ZG[i + 2 * n]) + bf1(ZK[i % ((size_t)T * 256)]) + bf1(ZVV[i % ((size_t)T * 256)]) + bf1(ZA[i + (size_t)TC * D]);
        if (which == 3) v = bf1(H[i + (size_t)TC * D]);
        if (which == 4) v = bf1(ZU[i + (size_t)TC * D]);
        if (which == 5) v = bf1(ZQ[i + (size_t)TC * D]);
        if (which == 6) v = bf1(MG[i + (size_t)TC * D]);
        if (which == 7) v = bf1(H[i]) + bf1(ZU[i]) + bf1(ZQ[i]);
        out[i] = v;
    }
}
#endif

__global__ void __launch_bounds__(512, 2) fwd_megakernel(Args a) {
    extern __shared__ __attribute__((aligned(16))) unsigned char shm[];
    LAS unsigned char* lds = (LAS unsigned char*)shm;
    unsigned* gbar = (unsigned*)(wsp() + WS_CTL) + 64; unsigned nbar = 0;
#define GRID_SYNC() do { ++nbar; grid_barrier(gbar, nbar * (unsigned)G); } while (0)
    const int G = gridDim.x;
    unsigned char* ws = wsp();

#if !defined(ONLY) || ONLY == 0
    phase_prep(a, lds);
#endif
    GRID_SYNC();
    for (int l = 0; l < DEPTH; ++l) {
        const bool last = (l == DEPTH - 1);
        const int pm0 = last ? 4 : 0, nM = last ? 64 : 68;
        const float* modl = (const float*)(ws + WS_MOD) + (size_t)l * 5 * 6144;
#if !defined(ONLY) || ONLY == 1
        phase_norm(a, lds, l, 0);
#endif
        GRID_SYNC();
#if defined(DBG_STOP) && DBG_STOP == 1
        dbg_dump(1); return;
#endif
#if !defined(ONLY) || ONLY == 2
        {
            pg8::Sched S; S.nM = 68; S.nN = INW / 256; S.nwg = S.nM * S.nN; S.G = G; S.c = bidx(); S.nseg = 1; S.pm0 = 0;
            S.A0 = (const char*)(ws + WS_H); S.d1 = 0; S.d2 = 0; S.B0 = (const char*)(ws + WS_WIN); S.bseg = 0; S.tstep = (size_t)256 * D * 2;
            pg8::EpiIn E{ws};
            pg8::gemm_phase<pg8::EpiIn>(lds, D, S, E);
        }
#endif
        GRID_SYNC();
#if !defined(ONLY) || ONLY == 3
#if defined(DBG_STOP) && DBG_STOP == 2
        dbg_dump(2); return;
#endif
        phase_mix(a, lds, l);
#endif
        GRID_SYNC();
#if !defined(ONLY) || ONLY == 4
#if defined(DBG_STOP) && DBG_STOP >= 3 && DBG_STOP <= 5
        dbg_dump(DBG_STOP); return;
#endif
#if defined(DBG_STOP) && DBG_STOP == 7
        dbg_dump(7); return;
#endif
        {
            pg8::Sched S; S.nM = nM; S.nN = 4; S.nwg = S.nM * S.nN; S.G = G; S.c = bidx(); S.nseg = 3; S.pm0 = pm0;
            S.A0 = (const char*)(ws + WS_H); S.d1 = WS_ZU - WS_H; S.d2 = WS_ZQ - WS_ZU; S.B0 = (const char*)(ws + WS_WBR); S.bseg = (size_t)D * D * 2; S.tstep = (size_t)256 * D * 2;
            pg8::EpiMerge E{(bf16_t*)(ws + WS_MG), (const bf16_t*)(ws + WS_ZG)};
            pg8::gemm_phase<pg8::EpiMerge>(lds, D, S, E);
        }
#endif
        GRID_SYNC();
#if !defined(ONLY) || ONLY == 5
#if defined(DBG_STOP) && DBG_STOP == 6
        dbg_dump(6); return;
#endif
        {
            pg8::Sched S; S.nM = nM; S.nN = 4; S.nwg = S.nM * S.nN; S.G = G; S.c = bidx(); S.nseg = 1; S.pm0 = pm0;
            S.A0 = (const char*)(ws + WS_MG); S.d1 = 0; S.d2 = 0; S.B0 = (const char*)(ws + WS_WOUT); S.bseg = 0; S.tstep = (size_t)256 * D * 2;
            pg8::EpiRes E{l == 0 ? inp<2>() : (const float*)(ws + WS_XC), l == 0 ? inp<0>() : (const float*)outp(), (float*)(ws + WS_XC), outp(), modl + 2 * 1024};
            pg8::gemm_phase<pg8::EpiRes>(lds, D, S, E);
        }
#endif
        GRID_SYNC();
#if !defined(ONLY) || ONLY == 6
        phase_norm(a, lds, l, 1);
#endif
        GRID_SYNC();
#if !defined(ONLY) || ONLY == 7
        {
            pg8::Sched S; S.nM = nM; S.nN = DFF / 256; S.nwg = S.nM * S.nN; S.G = G; S.c = bidx(); S.nseg = 1; S.pm0 = pm0;
            S.A0 = (const char*)(ws + WS_H); S.d1 = 0; S.d2 = 0; S.B0 = (const char*)(ws + WS_WFF1); S.bseg = 0; S.tstep = (size_t)256 * D * 2;
            pg8::EpiFF1 E{(bf16_t*)(ws + WS_HID)};
            pg8::gemm_phase<pg8::EpiFF1>(lds, D, S, E);
        }
#endif
        GRID_SYNC();
#if !defined(ONLY) || ONLY == 8
        {
            pg8::Sched S; S.nM = nM; S.nN = 4; S.nwg = S.nM * S.nN; S.G = G; S.c = bidx(); S.nseg = 1; S.pm0 = pm0;
            S.A0 = (const char*)(ws + WS_HID); S.d1 = 0; S.d2 = 0; S.B0 = (const char*)(ws + WS_WFF2); S.bseg = 0; S.tstep = (size_t)256 * DFF * 2;
            pg8::EpiRes E{(const float*)(ws + WS_XC), (const float*)outp(), (float*)(ws + WS_XC), outp(), modl + 5 * 1024};
            pg8::gemm_phase<pg8::EpiRes>(lds, DFF, S, E);
        }
#endif
        if (!last) GRID_SYNC();
    }
}

extern "C" void kernel_launch(void* const* d_in, const int* in_sizes, int n_in, void* d_out, int out_size, void* d_ws, size_t ws_size, hipStream_t stream) {
    static int grid = 0;
    if (grid == 0) {
        if (n_in != 27 || out_size != TL * D || ws_size < WS_END) { fprintf(stderr, "kernel_launch: unexpected shapes (n_in %d out %d ws %zu need %zu)\n", n_in, out_size, ws_size, (size_t)WS_END); grid = -1; return; }
        int dev = 0, cus = 0, per_cu = 0;
        hipGetDevice(&dev);
        hipDeviceGetAttribute(&cus, hipDeviceAttributeMultiprocessorCount, dev);
        hipFuncSetAttribute((const void*)fwd_megakernel, hipFuncAttributeMaxDynamicSharedMemorySize, LDS_BYTES);
        hipOccupancyMaxActiveBlocksPerMultiprocessor(&per_cu, (const void*)fwd_megakernel, 512, LDS_BYTES);
        if (per_cu < 1) { fprintf(stderr, "kernel_launch: occupancy query says %d blocks/CU\n", per_cu); per_cu = 1; }
        (void)hipGetLastError();
        grid = cus;
    }
    if (grid < 0) return;
    if (hipMemsetAsync((char*)d_ws + WS_CTL, 0, 4096, stream) != hipSuccess) { fprintf(stderr, "memset failed\n"); return; }
    Args a{};
    for (int i = 0; i < 27; ++i) a.in[i] = (const float*)d_in[i];
    a.out = (float*)d_out; a.ws = (unsigned char*)d_ws;
    void* args[] = {&a};
    hipError_t e = hipLaunchCooperativeKernel((const void*)fwd_megakernel, dim3(grid), dim3(512), args, LDS_BYTES, stream);
    if (e != hipSuccess) fprintf(stderr, "cooperative launch failed: %s (grid %d)\n", hipGetErrorString(e), grid);
}
```

```cpp
#define DBG_NOADD 0
#include <hip/hip_runtime.h>
#include <hip/hip_cooperative_groups.h>
#include <cstdio>
#include <cstdint>
namespace cg = cooperative_groups;

#define LAS __attribute__((address_space(3)))
#define DI __device__ __forceinline__
typedef unsigned short bf16_t;
typedef short bf16x8 __attribute__((ext_vector_type(8)));
typedef short s16x4 __attribute__((ext_vector_type(4)));
typedef float f32x2 __attribute__((ext_vector_type(2)));
typedef float f32x4 __attribute__((ext_vector_type(4)));
typedef float f32x16 __attribute__((ext_vector_type(16)));
typedef unsigned u32x2 __attribute__((ext_vector_type(2)));
typedef unsigned u32x4 __attribute__((ext_vector_type(4)));
typedef __bf16 bf16x2_t __attribute__((ext_vector_type(2)));

constexpr int D = 1024, NB = 4, SEQ = 4096, CTX = 256, DEPTH = 4, DFF = 4096;
constexpr int TC = NB * CTX;
constexpr int TL = NB * SEQ;
constexpr int T = TC + TL;
constexpr int INW = 7680;
constexpr float EPS = 1e-6f;
constexpr float LOG2E = 1.4426950408889634f;

constexpr size_t WS_CTL = 0;
constexpr size_t WS_ROPE = 4096;
constexpr size_t WS_MOD = 65536;
constexpr size_t WS_XC = 1u << 20;
constexpr size_t WS_WIN = 5u << 20;
constexpr size_t WS_WBR = WS_WIN + (size_t)INW * D * 2;
constexpr size_t WS_WOUT = WS_WBR + (size_t)3 * D * D * 2;
constexpr size_t WS_WFF1 = WS_WOUT + (size_t)D * D * 2;
constexpr size_t WS_WFF2 = WS_WFF1 + (size_t)DFF * D * 2;
constexpr size_t SLOT = (size_t)T * D * 2;
constexpr size_t WS_H = WS_WFF2 + (size_t)DFF * D * 2;
constexpr size_t WS_ZV = WS_H + SLOT;
constexpr size_t WS_ZU = WS_H + 2 * SLOT;
constexpr size_t WS_ZA = WS_H + 3 * SLOT;
constexpr size_t WS_ZQ = WS_H + 4 * SLOT;
constexpr size_t WS_ZK = WS_H + 5 * SLOT;
constexpr size_t WS_ZVV = WS_ZK + (size_t)T * 256 * 2;
constexpr size_t WS_ZG = WS_ZVV + (size_t)T * 256 * 2;
constexpr size_t WS_MG = WS_ZG + (size_t)T * 3072 * 2;
constexpr size_t WS_PC = WS_MG + SLOT;
constexpr size_t WS_PX = WS_PC + (size_t)3 * TC * D * 2;
constexpr size_t WS_END = WS_PX + (size_t)12 * TC * D * 4;
constexpr size_t WS_HID = WS_ZV;

constexpr int LDS_BYTES = 147456;
constexpr int LDS_MISC = 143360;

struct Args { const float* in[27]; float* out; unsigned char* ws; };


template <int OFF> DI const void* kargp() { const unsigned long long k = (unsigned long long)__builtin_amdgcn_kernarg_segment_ptr(); const void* p;
    asm volatile("s_load_dwordx2 %0, %1, %2\n\ts_waitcnt lgkmcnt(0)" : "=s"(p) : "s"(k), "n"(OFF) : "memory"); return p; }
template <int I> DI const float* inp() { return (const float*)kargp<I * 8>(); }
DI float* outp() { return (float*)kargp<27 * 8>(); }
DI unsigned char* wsp() { return (unsigned char*)kargp<28 * 8>(); }
DI int tidx() { int t = threadIdx.x; asm volatile("" : "+v"(t)); return t; }
DI int bidx() { int b = blockIdx.x; asm volatile("" : "+s"(b)); return b; }

DI unsigned pk2(float lo, float hi) { f32x2 v = {lo, hi}; bf16x2_t b = __builtin_convertvector(v, bf16x2_t); return __builtin_bit_cast(unsigned, b); }
DI float bflo(unsigned w) { return __uint_as_float(w << 16); }
DI float bfhi(unsigned w) { return __uint_as_float(w & 0xffff0000u); }
DI float bf1(bf16_t h) { return __uint_as_float(((unsigned)h) << 16); }
DI bf16_t f2bf(float f) { return (bf16_t)(pk2(f, 0.f) & 0xffffu); }
DI float fexp2(float x) { return __builtin_amdgcn_exp2f(x); }
DI float frcp(float x) { return __builtin_amdgcn_rcpf(x); }
DI float sigmoidf_(float x) { return frcp(1.0f + fexp2(-x * LOG2E)); }
DI float gelu_tanh(float x) { const float u = x + 0.044715f * x * x * x; return x * frcp(1.0f + fexp2(-1.5957691216f * LOG2E * u)); }
DI float wave_sum(float v) {
#pragma unroll
    for (int o = 1; o < 64; o <<= 1) v += __shfl_xor(v, o);
    return v;
}
DI void unpack8(const u32x4 w, float (&v)[8]) { v[0] = bflo(w.x); v[1] = bfhi(w.x); v[2] = bflo(w.y); v[3] = bfhi(w.y); v[4] = bflo(w.z); v[5] = bfhi(w.z); v[6] = bflo(w.w); v[7] = bfhi(w.w); }
DI u32x4 pack8(const float (&v)[8]) { u32x4 w; w.x = pk2(v[0], v[1]); w.y = pk2(v[2], v[3]); w.z = pk2(v[4], v[5]); w.w = pk2(v[6], v[7]); return w; }
#define MFMA32(a, b, c) __builtin_amdgcn_mfma_f32_32x32x16_bf16((a), (b), (c), 0, 0, 0)

namespace pg8 {
constexpr int BM = 256, BK = 64, HALF = 128, HTB = HALF * BK * 2, STAGE_BYTES = 8 * HTB, NXCD = 8, WGM = 8;
DI int lds_byte(int r, int c) { const int st = (r >> 4) * 2 + (c >> 5), rr = r & 15, cc = c & 31, ob = rr * 64 + cc * 2; return st * 1024 + (ob ^ (((ob >> 9) & 1) << 5)); }
DI void stage_rc(int b, int& R, int& C) { const int st = b / 1024, sb = b % 1024, swz = sb ^ (((sb >> 9) & 1) << 5); R = (st >> 1) * 16 + swz / 64; C = (st & 1) * 32 + (swz % 64) / 2; }
DI int perm32(int rho) { const int n = rho >> 4, i = rho & 15; return 8 * (i >> 2) + 4 * n + (i & 3); }

struct Unit { int pm, pn, seg, q; const char* A; const char* B; };

struct Sched {
    int nM, nN, nwg, G, c, nseg, pm0;
    const char *A0, *B0; size_t d1, d2, bseg, tstep;
    DI bool next(int i, Unit& u) const {
        int ti = i, seg = 0;
        if (nseg == 3) { ti = i / 3; seg = i - 3 * ti; }
        const long L = (long)ti * G + c; if (L >= nwg) return false;
        int wgid = (int)L; { const int q = nwg / NXCD, r = nwg % NXCD, xcd = wgid % NXCD, off = wgid / NXCD; wgid = (xcd < r ? xcd * (q + 1) : r * (q + 1) + (xcd - r) * q) + off; }
        const int nig = WGM * nN, gid = wgid / nig, fm = gid * WGM, gsz = (nM - fm) < WGM ? (nM - fm) : WGM;
        u.pm = pm0 + fm + ((wgid % nig) % gsz); u.pn = (wgid % nig) / gsz; u.seg = seg; u.q = 0;
        const size_t ao = (seg >= 1 ? d1 : (size_t)0) + (seg >= 2 ? d2 : (size_t)0);
        u.A = A0 + ao + (size_t)u.pm * tstep; u.B = B0 + (size_t)seg * bseg + (size_t)u.pn * tstep;
        return true;
    }
};

struct SchedList {
    int n, G, c, nN, nS, nQ; const char *A0, *B0; size_t a_pm, a_s, a_q, b_pn, b_s, b_q;
    DI bool next(int i, Unit& u) const {
        const int idx = i * G + c; if (idx >= n) return false;
        const int q = idx % nQ; int t = idx / nQ; const int sg = t % nS; t /= nS; const int pn = t % nN, pm = t / nN;
        u.pm = pm; u.pn = pn; u.seg = sg; u.q = q;
        u.A = A0 + (size_t)pm * a_pm + (size_t)sg * a_s + (size_t)q * a_q; u.B = B0 + (size_t)pn * b_pn + (size_t)sg * b_s + (size_t)q * b_q;
        return true;
    }
};

template <class Epi, class SchedT>
DI void gemm_phase(LAS unsigned char* lds, const int K, const int pitch, const SchedT& S, const Epi& E) {
    const int tid = tidx(), wid = __builtin_amdgcn_readfirstlane(tid >> 6), lane = tid & 63, wr = wid >> 2, wc = wid & 3, fr = lane & 15, fq = lane >> 4;
    const int nt = K / BK;
    unsigned voffA[2], voffB[2];
#pragma unroll
    for (int i = 0; i < 2; ++i) { int R, C; stage_rc(tid * 16 + i * 8192, R, C); const int Rb = Epi::PERM ? ((R & ~31) + perm32(R & 31)) : R;
        voffA[i] = (unsigned)(R * pitch + C) * 2u; voffB[i] = (unsigned)(Rb * pitch + C) * 2u; }
    const size_t kstep = (size_t)(BK * 2);
    const size_t hstep = (size_t)HALF * pitch * 2;
    const unsigned ldsw = (unsigned)wid * 1024u;
    const int aoff = lds_byte(wr * 64 + fr, fq * 8), boff = lds_byte(wc * 32 + fr, fq * 8);
#define PG8_SA(b, h) (((b) * 2 + (h)) * HTB)
#define PG8_SB(b, h) ((4 + (b) * 2 + (h)) * HTB)
#define PG8_STAGE(bufoff, gbase, voff) do { _Pragma("unroll") for (int _i = 0; _i < 2; ++_i) \
        __builtin_amdgcn_global_load_lds((const unsigned*)((const char*)(gbase) + (voff)[_i]), (LAS unsigned*)(lds + (bufoff) + ldsw + _i * 8192), 16, 0, 0); } while (0)
#define PG8_LDA(dst, b, h) do { _Pragma("unroll") for (int m = 0; m < 4; ++m) _Pragma("unroll") for (int k = 0; k < 2; ++k) dst[m][k] = *(const LAS bf16x8*)(lds + PG8_SA(b, h) + aoff + m * 2048 + k * 1024); } while (0)
#define PG8_LDB(dst, b, h) do { _Pragma("unroll") for (int n = 0; n < 2; ++n) _Pragma("unroll") for (int k = 0; k < 2; ++k) dst[n][k] = *(const LAS bf16x8*)(lds + PG8_SB(b, h) + boff + n * 2048 + k * 1024); } while (0)
#define PG8_MMA(ai, bj, At, Bt) do { __builtin_amdgcn_s_setprio(1); _Pragma("unroll") for (int m = 0; m < 4; ++m) _Pragma("unroll") for (int n = 0; n < 2; ++n) _Pragma("unroll") for (int k = 0; k < 2; ++k) \
        acc[ai][bj][m][n] = __builtin_amdgcn_mfma_f32_16x16x32_bf16(Bt[n][k], At[m][k], acc[ai][bj][m][n], 0, 0, 0); __builtin_amdgcn_s_setprio(0); } while (0)
#define PG8_WAIT_V(n) asm volatile("s_waitcnt vmcnt(" #n ")" ::: "memory")
#define PG8_WAIT_L(n) asm volatile("s_waitcnt lgkmcnt(" #n ")" ::: "memory")
#define PG8_BAR __builtin_amdgcn_s_barrier()
#define PG8_SCHED __builtin_amdgcn_sched_barrier(0)
    Unit cur, nxt; int ui = 0;
    if (!S.next(0, cur)) return;
    f32x4 acc[2][2][4][2];
#pragma unroll
    for (int a = 0; a < 2; ++a)
#pragma unroll
        for (int b = 0; b < 2; ++b)
#pragma unroll
            for (int m = 0; m < 4; ++m)
#pragma unroll
                for (int n = 0; n < 2; ++n) acc[a][b][m][n] = (f32x4){0.f, 0.f, 0.f, 0.f};
    bf16x8 At[4][2], B0[2][2], B1[2][2];
    const char* cA = cur.A; const char* cB = cur.B;
    PG8_STAGE(PG8_SB(0, 0), cB, voffB); PG8_STAGE(PG8_SA(0, 0), cA, voffA); PG8_STAGE(PG8_SB(0, 1), cB + hstep, voffB); PG8_STAGE(PG8_SA(0, 1), cA + hstep, voffA);
    if (wr == 1) PG8_BAR;
    PG8_WAIT_V(4); PG8_BAR;
    PG8_STAGE(PG8_SB(1, 0), cB + kstep, voffB); PG8_STAGE(PG8_SA(1, 0), cA + kstep, voffA); PG8_STAGE(PG8_SB(1, 1), cB + hstep + kstep, voffB);
    PG8_WAIT_V(6); PG8_BAR;
    for (;;) {
        const bool has_next = S.next(ui + 1, nxt);
        const char* nA = has_next ? nxt.A : cA; const char* nB = has_next ? nxt.B : cB;
        for (int t = 0; t < nt; t += 2) {
            const bool last = (t == nt - 2);
            const char* a1 = cA + (size_t)(t + 1) * kstep;
            const char* a2 = last ? nA : cA + (size_t)(t + 2) * kstep; const char* b2 = last ? nB : cB + (size_t)(t + 2) * kstep;
            const char* a3 = a2 + kstep; const char* b3 = b2 + kstep;
            PG8_LDB(B0, 0, 0); PG8_SCHED; PG8_LDA(At, 0, 0); PG8_STAGE(PG8_SA(1, 1), a1 + hstep, voffA);
            PG8_WAIT_L(8); PG8_BAR; PG8_WAIT_L(0); PG8_MMA(0, 0, At, B0); PG8_BAR; PG8_SCHED;
            PG8_LDB(B1, 0, 1); PG8_STAGE(PG8_SB(0, 0), b2, voffB);
            PG8_BAR; PG8_WAIT_L(0); PG8_MMA(0, 1, At, B1); PG8_BAR;
            PG8_LDA(At, 0, 1); PG8_STAGE(PG8_SA(0, 0), a2, voffA);
            PG8_BAR; PG8_WAIT_L(0); PG8_MMA(1, 0, At, B0); PG8_BAR; PG8_SCHED;
            PG8_STAGE(PG8_SB(0, 1), b2 + hstep, voffB);
            PG8_WAIT_V(6); PG8_BAR; PG8_MMA(1, 1, At, B1); PG8_BAR;
            PG8_LDB(B0, 1, 0); PG8_SCHED; PG8_LDA(At, 1, 0); PG8_STAGE(PG8_SA(0, 1), a2 + hstep, voffA);
            PG8_WAIT_L(8); PG8_BAR; PG8_WAIT_L(0); PG8_MMA(0, 0, At, B0); PG8_BAR; PG8_SCHED;
            PG8_LDB(B1, 1, 1); PG8_STAGE(PG8_SB(1, 0), b3, voffB);
            PG8_BAR; PG8_WAIT_L(0); PG8_MMA(0, 1, At, B1); PG8_BAR;
            PG8_LDA(At, 1, 1); PG8_STAGE(PG8_SA(1, 0), a3, voffA);
            PG8_BAR; PG8_WAIT_L(0); PG8_MMA(1, 0, At, B0); PG8_BAR; PG8_SCHED;
            PG8_STAGE(PG8_SB(1, 1), b3 + hstep, voffB);
            PG8_WAIT_V(6); PG8_BAR; PG8_MMA(1, 1, At, B1); PG8_BAR;
        }
        E(acc, cur, wr, wc, fr, fq);
        if (!has_next) break;
#pragma unroll
        for (int a = 0; a < 2; ++a)
#pragma unroll
            for (int b = 0; b < 2; ++b)
#pragma unroll
                for (int m = 0; m < 4; ++m)
#pragma unroll
                    for (int n = 0; n < 2; ++n) acc[a][b][m][n] = (f32x4){0.f, 0.f, 0.f, 0.f};
        cur = nxt; cA = nA; cB = nB; ++ui;
    }
    PG8_WAIT_V(0);
    if (wr == 0) PG8_BAR;
    PG8_BAR;
#undef PG8_SA
#undef PG8_SB
#undef PG8_STAGE
#undef PG8_LDA
#undef PG8_LDB
#undef PG8_MMA
#undef PG8_WAIT_V
#undef PG8_WAIT_L
#undef PG8_BAR
#undef PG8_SCHED
}

struct EpiIn {
    static constexpr bool PERM = true;
    unsigned char* ws;
    DI void operator()(const f32x4 (&acc)[2][2][4][2], const Unit& u, int wr, int wc, int fr, int fq) const {
        const int pn = u.pn; bf16_t* base; int ldc, colt, mode;
        if (pn < 4) { base = (bf16_t*)(ws + WS_ZA); ldc = 1024; colt = pn * 256; mode = 0; }
        else if (pn < 8) { base = (bf16_t*)(ws + WS_ZU); ldc = 1024; colt = (pn - 4) * 256; mode = 1; }
        else if (pn < 12) { base = (bf16_t*)(ws + WS_ZV); ldc = 1024; colt = (pn - 8) * 256; mode = 1; }
        else if (pn < 16) { base = (bf16_t*)(ws + WS_ZQ); ldc = 1024; colt = (pn - 12) * 256; mode = 0; }
        else if (pn == 16) { base = (bf16_t*)(ws + WS_ZK); ldc = 256; colt = 0; mode = 0; }
        else if (pn == 17) { base = (bf16_t*)(ws + WS_ZVV); ldc = 256; colt = 0; mode = 0; }
        else { base = (bf16_t*)(ws + WS_ZG); ldc = 3072; colt = (pn - 18) * 256; mode = 2; }
        const int row0 = u.pm * BM + wr * 64 + fr, col0 = colt + wc * 32 + 8 * fq;
#pragma unroll
        for (int ai = 0; ai < 2; ++ai)
#pragma unroll
            for (int m = 0; m < 4; ++m) { bf16_t* rowp = base + (size_t)(row0 + ai * HALF + m * 16) * ldc + col0;
#pragma unroll
                for (int bj = 0; bj < 2; ++bj) { f32x4 v0 = acc[ai][bj][m][0], v1 = acc[ai][bj][m][1];
                    if (mode == 1) {
#pragma unroll
                        for (int j = 0; j < 4; ++j) { v0[j] = gelu_tanh(v0[j]); v1[j] = gelu_tanh(v1[j]); } }
                    else if (mode == 2) {
#pragma unroll
                        for (int j = 0; j < 4; ++j) { v0[j] = sigmoidf_(v0[j]); v1[j] = sigmoidf_(v1[j]); } }
                    u32x4 w; w.x = pk2(v0[0], v0[1]); w.y = pk2(v0[2], v0[3]); w.z = pk2(v1[0], v1[1]); w.w = pk2(v1[2], v1[3]);
                    *(u32x4*)(rowp + bj * HALF) = w; } }
    }
};
struct EpiMerge {
    static constexpr bool PERM = true;
    bf16_t* Mg; const bf16_t* ZG;
    DI void operator()(const f32x4 (&acc)[2][2][4][2], const Unit& u, int wr, int wc, int fr, int fq) const {
        const int row0 = u.pm * BM + wr * 64 + fr, col0 = u.pn * BM + wc * 32 + 8 * fq, seg = u.seg;
#pragma unroll
        for (int ai = 0; ai < 2; ++ai)
#pragma unroll
            for (int m = 0; m < 4; ++m) { const size_t r = (size_t)(row0 + ai * HALF + m * 16);
#pragma unroll
                for (int bj = 0; bj < 2; ++bj) {
                    const u32x4 gw = *(const u32x4*)(ZG + r * 3072 + seg * 1024 + col0 + bj * HALF);
                    float g[8]; unpack8(gw, g);
                    const f32x4 v0 = acc[ai][bj][m][0], v1 = acc[ai][bj][m][1];
                    float o[8] = {g[0] * v0[0], g[1] * v0[1], g[2] * v0[2], g[3] * v0[3], g[4] * v1[0], g[5] * v1[1], g[6] * v1[2], g[7] * v1[3]};
                    u32x4* mp = (u32x4*)(Mg + r * 1024 + col0 + bj * HALF);
                    if (seg != 0) { float p[8]; unpack8(*mp, p);
#pragma unroll
                        for (int j = 0; j < 8; ++j) o[j] += p[j]; }
                    *mp = pack8(o); } }
    }
};
struct EpiRes {
    static constexpr bool PERM = false;
    const float* src_c; const float* src_l; float* dst_c; float* dst_l; const float* gate;
    DI void operator()(const f32x4 (&acc)[2][2][4][2], const Unit& u, int wr, int wc, int fr, int fq) const {
        const int rowt = u.pm * BM; const int grp = rowt < TC ? 4 : ((rowt - TC) >> 12);
        const float* src = rowt < TC ? src_c + (size_t)rowt * D : src_l + (size_t)(rowt - TC) * D;
        float* dst = rowt < TC ? dst_c + (size_t)rowt * D : dst_l + (size_t)(rowt - TC) * D;
        const int row0 = wr * 64 + fr, col0 = u.pn * BM + wc * 32 + 4 * fq;
        const float* gp = gate + grp * 6144 + col0;
        f32x4 gv[2][2];
#pragma unroll
        for (int bj = 0; bj < 2; ++bj)
#pragma unroll
            for (int n = 0; n < 2; ++n) gv[bj][n] = *(const f32x4*)(gp + bj * HALF + n * 16);
#pragma unroll
        for (int ai = 0; ai < 2; ++ai)
#pragma unroll
            for (int m = 0; m < 4; ++m) { const size_t off = (size_t)(row0 + ai * HALF + m * 16) * D + col0;
#pragma unroll
                for (int bj = 0; bj < 2; ++bj)
#pragma unroll
                    for (int n = 0; n < 2; ++n) { const f32x4 xs = *(const f32x4*)(src + off + bj * HALF + n * 16);
                        *(f32x4*)(dst + off + bj * HALF + n * 16) = xs + gv[bj][n] * acc[ai][bj][m][n]; } }
    }
};
struct EpiMergeCtx {
    static constexpr bool PERM = true;
    bf16_t* Pc; const bf16_t* ZG;
    DI void operator()(const f32x4 (&acc)[2][2][4][2], const Unit& u, int wr, int wc, int fr, int fq) const {
        const int row0 = u.pm * BM + wr * 64 + fr, col0 = u.pn * BM + wc * 32 + 8 * fq, seg = u.seg;
#pragma unroll
        for (int ai = 0; ai < 2; ++ai)
#pragma unroll
            for (int m = 0; m < 4; ++m) { const size_t r = (size_t)(row0 + ai * HALF + m * 16);
#pragma unroll
                for (int bj = 0; bj < 2; ++bj) {
                    const u32x4 gw = *(const u32x4*)(ZG + r * 3072 + seg * 1024 + col0 + bj * HALF);
                    float g[8]; unpack8(gw, g);
                    const f32x4 v0 = acc[ai][bj][m][0], v1 = acc[ai][bj][m][1];
                    u32x4 w; w.x = pk2(g[0] * v0[0], g[1] * v0[1]); w.y = pk2(g[2] * v0[2], g[3] * v0[3]); w.z = pk2(g[4] * v1[0], g[5] * v1[1]); w.w = pk2(g[6] * v1[2], g[7] * v1[3]);
                    *(u32x4*)(Pc + (size_t)seg * TC * D + r * 1024 + col0 + bj * HALF) = w; } }
    }
};
struct EpiPartial {
    static constexpr bool PERM = false;
    float* PX; int nq;
    DI void operator()(const f32x4 (&acc)[2][2][4][2], const Unit& u, int wr, int wc, int fr, int fq) const {
        const int row0 = u.pm * BM + wr * 64 + fr, col0 = u.pn * BM + wc * 32 + 4 * fq;
        float* base = PX + (size_t)(u.seg * nq + u.q) * TC * D;
#pragma unroll
        for (int ai = 0; ai < 2; ++ai)
#pragma unroll
            for (int m = 0; m < 4; ++m) { float* rp = base + (size_t)(row0 + ai * HALF + m * 16) * D + col0;
#pragma unroll
                for (int bj = 0; bj < 2; ++bj)
#pragma unroll
                    for (int n = 0; n < 2; ++n) *(f32x4*)(rp + bj * HALF + n * 16) = acc[ai][bj][m][n]; }
    }
};
struct EpiFF1 {
    static constexpr bool PERM = true;
    bf16_t* O;
    DI void operator()(const f32x4 (&acc)[2][2][4][2], const Unit& u, int wr, int wc, int fr, int fq) const {
        const int row0 = u.pm * BM + wr * 64 + fr, col0 = u.pn * BM + wc * 32 + 8 * fq;
#pragma unroll
        for (int ai = 0; ai < 2; ++ai)
#pragma unroll
            for (int m = 0; m < 4; ++m) { bf16_t* rowp = O + (size_t)(row0 + ai * HALF + m * 16) * DFF + col0;
#pragma unroll
                for (int bj = 0; bj < 2; ++bj) { f32x4 v0 = acc[ai][bj][m][0], v1 = acc[ai][bj][m][1];
#pragma unroll
                    for (int j = 0; j < 4; ++j) { const float a = fmaxf(v0[j], 0.f), b = fmaxf(v1[j], 0.f); v0[j] = a * a; v1[j] = b * b; }
                    u32x4 w; w.x = pk2(v0[0], v0[1]); w.y = pk2(v0[2], v0[3]); w.z = pk2(v1[0], v1[1]); w.w = pk2(v1[2], v1[3]);
                    *(u32x4*)(rowp + bj * HALF) = w; } }
    }
};
}

DI void phase_prep(const Args& a, LAS unsigned char* lds) {
    const int tid = tidx(), bid = bidx(), G = gridDim.x;
    if (bid == (1 % G)) {
        float* cosT = (float*)(wsp() + WS_ROPE); float* sinT = cosT + 1024;
        for (int i = tid; i < 1024; i += 512) { const int pos = i >> 4, f = i & 15; const float inv = powf(10000.0f, -(float)f / 16.0f); const float ang = (float)pos * inv;
            cosT[i] = cosf(ang); sinT[i] = sinf(ang); }
    }
    LAS float* cond = (LAS float*)lds;
    LAS float* red = (LAS float*)(lds + 20480);
    for (int i = tid; i < 5 * 1024; i += 512) { const int g = i >> 10, k = i & 1023; const float v = g < 4 ? inp<1>()[g * 1024 + k] : inp<3>()[k]; cond[i] = v * sigmoidf_(v); }
    __syncthreads();
    float* mod = (float*)(wsp() + WS_MOD);
    for (int it = bid; it < DEPTH * 96; it += G) {
        const int l = it / 96, cb = it % 96, c = tid & 63, kg = tid >> 6, col = cb * 64 + c;
        const float* w = inp<4>() + (size_t)l * D * 6144 + col;
        float acc[5] = {0.f, 0.f, 0.f, 0.f, 0.f};
#pragma unroll 8
        for (int k = kg * 128; k < kg * 128 + 128; ++k) { const float wv = w[(size_t)k * 6144];
#pragma unroll
            for (int g = 0; g < 5; ++g) acc[g] += cond[g * 1024 + k] * wv; }
#pragma unroll
        for (int g = 0; g < 5; ++g) red[(kg * 5 + g) * 64 + c] = acc[g];
        __syncthreads();
        if (tid < 320) { const int g = tid >> 6; float s = inp<5>()[l * 6144 + col];
#pragma unroll
            for (int k2 = 0; k2 < 8; ++k2) s += red[(k2 * 5 + g) * 64 + c];
            mod[(size_t)(l * 5 + g) * 6144 + col] = s; }
        __syncthreads();
    }
}

DI void transpose_item(const float* W, int K, int N, bf16_t* WT, LAS float* scr, int item, int lane) {
    const int nblk = N / 32, kb = item / nblk, nb = item % nblk, k0 = 64 * kb, n0 = 32 * nb;
#pragma unroll 8
    for (int i = 0; i < 32; ++i) { const int kk = 2 * i + (lane >> 5); scr[kk * 33 + (lane & 31)] = W[(size_t)(k0 + kk) * N + n0 + (lane & 31)]; }
    asm volatile("s_waitcnt lgkmcnt(0)" ::: "memory");
    const int c = lane & 7;
#pragma unroll
    for (int j = 0; j < 4; ++j) { const int n = (lane >> 3) + 8 * j; const LAS float* s = scr + (8 * c) * 33 + n;
        u32x4 o; o.x = pk2(s[0 * 33], s[1 * 33]); o.y = pk2(s[2 * 33], s[3 * 33]); o.z = pk2(s[4 * 33], s[5 * 33]); o.w = pk2(s[6 * 33], s[7 * 33]);
        *(u32x4*)(WT + (size_t)(n0 + n) * K + k0 + 8 * c) = o; }
    asm volatile("s_waitcnt lgkmcnt(0)" ::: "memory");
}

DI void phase_norm(const Args& a, LAS unsigned char* lds, int l, int which) {
    const int tid = tidx(), lane = tid & 63, wave = tid >> 6, G = gridDim.x;
    const int gw = bidx() * 8 + wave, NGW = G * 8;
    if (which == 0) {
        LAS float* scr = (LAS float*)(lds + wave * 8448);
        constexpr int I_IN = 16 * (INW / 32), I_BR = 16 * 32, I_FF1 = 16 * (DFF / 32), I_FF2 = 64 * 32;
        constexpr int NIT = I_IN + 4 * I_BR + I_FF1 + I_FF2;
        for (int it = gw; it < NIT; it += NGW) {
            int r = it;
            if (r < I_IN) { transpose_item(inp<7>() + (size_t)l * D * INW, D, INW, (bf16_t*)(wsp() + WS_WIN), scr, r, lane); continue; } r -= I_IN;
            if (r < 3 * I_BR) { const int s = r / I_BR; transpose_item(inp<22>() + ((size_t)l * 3 + s) * D * D, D, D, (bf16_t*)(wsp() + WS_WBR) + (size_t)s * D * D, scr, r % I_BR, lane); continue; } r -= 3 * I_BR;
            if (r < I_BR) { transpose_item(inp<23>() + (size_t)l * D * D, D, D, (bf16_t*)(wsp() + WS_WOUT), scr, r, lane); continue; } r -= I_BR;
            if (r < I_FF1) { transpose_item(inp<25>() + (size_t)l * D * DFF, D, DFF, (bf16_t*)(wsp() + WS_WFF1), scr, r, lane); continue; } r -= I_FF1;
            transpose_item(inp<26>() + (size_t)l * DFF * D, DFF, D, (bf16_t*)(wsp() + WS_WFF2), scr, r, lane);
        }
    }
    const bool from_in = (l == 0 && which == 0);
    const float* xc_src = from_in ? inp<2>() : (const float*)(wsp() + WS_XC);
    const float* xl_src = from_in ? inp<0>() : (const float*)outp();
    const float* gn = (which == 0 ? inp<6>() : inp<24>()) + l * D;
    const float* mod = (const float*)(wsp() + WS_MOD) + (size_t)l * 5 * 6144 + (which ? 3 * 1024 : 0);
    bf16_t* H = (bf16_t*)(wsp() + WS_H);
    const int rstart = (which == 1 && l == DEPTH - 1) ? TC : 0;
    const int npart = which == 1 ? 12 : (l > 0 ? 4 : 0);
    const float* pgate = (const float*)(wsp() + WS_MOD) + (size_t)((which == 1 ? l : l - 1) * 5 + 4) * 6144 + (which == 1 ? 2 : 5) * 1024;
    for (int r = rstart + gw; r < T; r += NGW) {
        const float* xrow = r < TC ? xc_src + (size_t)r * D : xl_src + (size_t)(r - TC) * D;
        const int grp = r < TC ? 4 : ((r - TC) >> 12);
        const float* sh = mod + grp * 6144; const float* sc = sh + 1024;
        f32x4 v[4]; float ss = 0.f;
#pragma unroll
        for (int j = 0; j < 4; ++j) v[j] = *((const f32x4*)xrow + lane + 64 * j);
        if (r < TC && npart > 0) {
            const float* px = (const float*)(wsp() + WS_PX) + (size_t)r * D;
#pragma unroll
            for (int j = 0; j < 4; ++j) { f32x4 sum = *((const f32x4*)px + lane + 64 * j);
                for (int pi = 1; pi < npart; ++pi) sum += *((const f32x4*)(px + (size_t)pi * TC * D) + lane + 64 * j);
                v[j] += *((const f32x4*)pgate + lane + 64 * j) * sum;
                *((f32x4*)(wsp() + WS_XC + (size_t)r * D * 4) + lane + 64 * j) = v[j]; }
        }
#pragma unroll
        for (int j = 0; j < 4; ++j) ss += (v[j].x * v[j].x + v[j].y * v[j].y) + (v[j].z * v[j].z + v[j].w * v[j].w);
        const float rstd = 1.0f / sqrtf(wave_sum(ss) * (1.0f / D) + EPS);
        if (from_in && r < TC) {
#pragma unroll
            for (int j = 0; j < 4; ++j) *((f32x4*)(wsp() + WS_XC + (size_t)r * D * 4) + lane + 64 * j) = v[j]; }
#pragma unroll
        for (int j = 0; j < 4; ++j) { const int k = (lane + 64 * j) * 4; const f32x4 g = *(const f32x4*)(gn + k), s1 = *(const f32x4*)(sc + k), s0 = *(const f32x4*)(sh + k);
            const f32x4 y = (v[j] * rstd * g) * (s1 + 1.0f) + s0;
            u32x2 o; o.x = pk2(y.x, y.y); o.y = pk2(y.z, y.w);
            *(u32x2*)(H + (size_t)r * D + k) = o; }
    }
}

DI float neg_expm1(float x) {
    const float small = -x * (1.0f + x * (0.5f + x * (0.16666667f + x * 0.041666667f)));
    const float big = 1.0f - fexp2(x * LOG2E);
    return x > -0.1f ? small : big;
}
DI void scan_item(const Args& a, LAS unsigned char* lds, int l, int b, int cb, int hc) {
    const int tid = tidx(), half = tid >> 8, ht = tid & 255, lane = tid & 63, hw = (tid >> 6) & 3, l15 = lane & 15, l4 = lane >> 4;
    LAS unsigned char* hb = lds + half * 40960;
    LAS bf16_t* WaT = (LAS bf16_t*)hb;
    LAS bf16_t* WxT = (LAS bf16_t*)(hb + 4608);
    LAS bf16_t* xcb = (LAS bf16_t*)(hb + 9216);
    LAS float* As = (LAS float*)(hb + 18432);
    LAS float* Us = (LAS float*)(hb + 26624);
    LAS float* carry = (LAS float*)(hb + 34816);
    LAS float* segP = (LAS float*)(hb + 35072);
    LAS float* segH = (LAS float*)(hb + 36096);
    LAS float* prm = (LAS float*)(hb + 37120);
    const bf16_t* ZA = (const bf16_t*)(wsp() + WS_ZA); bf16_t* YA = (bf16_t*)(wsp() + WS_H);
    const int tokA = ht >> 2, c0A = (ht & 3) * 16;
    float cw[4][16], cbias[16];
    {
        const size_t wofs = (((size_t)l * 2 + half) * 16 + cb) * 4096;
        const float* wa = inp<10>() + wofs; const float* wx = inp<12>() + wofs;
        for (int i = ht; i < 2048; i += 256) { const int ii = i >> 5, jj = i & 31; WaT[jj * 72 + ii] = f2bf(wa[ii * 64 + hc * 32 + jj]); WxT[jj * 72 + ii] = f2bf(wx[ii * 64 + hc * 32 + jj]); }
        if (ht < 32) { const int ch = cb * 64 + hc * 32 + ht; const size_t po = ((size_t)l * 2 + half) * D + ch;
            prm[ht] = inp<11>()[po]; prm[32 + ht] = inp<13>()[po];
            const float lam = inp<14>()[po]; prm[64 + ht] = 8.0f * log1pf(expf(-lam));
            carry[ht] = 0.f; }
        const float* cwp = inp<8>() + (size_t)l * 4 * D + cb * 64 + c0A; const float* cbp = inp<9>() + (size_t)l * D + cb * 64 + c0A;
#pragma unroll
        for (int j = 0; j < 16; ++j) { cbias[j] = cbp[j];
#pragma unroll
            for (int k = 0; k < 4; ++k) cw[k][j] = cwp[(size_t)k * D + j]; }
    }
    __syncthreads();
#define LBAR() do { asm volatile("s_waitcnt lgkmcnt(0)" ::: "memory"); __builtin_amdgcn_s_barrier(); asm volatile("" ::: "memory"); } while (0)
#define SCAN_DESC(st_) const int gid = (half == 0) ? (st_) : ((st_) < 4 ? 3 - (st_) : 71 - (st_)); const bool isctx = gid < 4; const int chunk = isctx ? gid : gid - 4; \
        const int L = isctx ? CTX : SEQ; const int rowbase = isctx ? b * CTX : TC + b * SEQ;
    u32x4 tp[4][2];
    {   SCAN_DESC(0)
#pragma unroll
        for (int k = 0; k < 4; ++k) { const int ts = chunk * 64 + tokA + k - 2; tp[k][0] = (u32x4){0u, 0u, 0u, 0u}; tp[k][1] = (u32x4){0u, 0u, 0u, 0u};
            if (ts >= 0 && ts < L) { const bf16_t* p = ZA + (size_t)(rowbase + ts) * D + cb * 64 + c0A; tp[k][0] = *(const u32x4*)p; tp[k][1] = *(const u32x4*)(p + 8); } }
    }
    const int tokE = ht >> 2, c0E = (ht & 3) * 8;
    for (int step = 0; step < 68; ++step) {
        SCAN_DESC(step)
        const bool fwd_first = isctx ? (gid <= 1) : (gid <= 35);
        const bool second = (half == 0) ? !fwd_first : fwd_first;
        {
            float t0[8], t1[8];
#pragma unroll
            for (int j = 0; j < 8; ++j) { t0[j] = cbias[j]; t1[j] = cbias[8 + j]; }
#pragma unroll
            for (int k = 0; k < 4; ++k) { float x0[8], x1[8]; unpack8(tp[k][0], x0); unpack8(tp[k][1], x1);
#pragma unroll
                for (int j = 0; j < 8; ++j) { t0[j] += cw[k][j] * x0[j]; t1[j] += cw[k][8 + j] * x1[j]; } }
            *(LAS u32x4*)(xcb + tokA * 72 + c0A) = pack8(t0); *(LAS u32x4*)(xcb + tokA * 72 + c0A + 8) = pack8(t1);
        }
        LBAR();
        {
            f32x4 ar[2], ai[2];
#pragma unroll
            for (int nt = 0; nt < 2; ++nt) { ar[nt] = (f32x4){0.f, 0.f, 0.f, 0.f}; ai[nt] = (f32x4){0.f, 0.f, 0.f, 0.f}; }
#pragma unroll
            for (int s = 0; s < 2; ++s) { const bf16x8 xa = *(const LAS bf16x8*)(xcb + (16 * hw + l15) * 72 + 32 * s + 8 * l4);
#pragma unroll
                for (int nt = 0; nt < 2; ++nt) { const bf16x8 wa = *(const LAS bf16x8*)(WaT + (16 * nt + l15) * 72 + 32 * s + 8 * l4), wx = *(const LAS bf16x8*)(WxT + (16 * nt + l15) * 72 + 32 * s + 8 * l4);
                    ar[nt] = __builtin_amdgcn_mfma_f32_16x16x32_bf16(xa, wa, ar[nt], 0, 0, 0); ai[nt] = __builtin_amdgcn_mfma_f32_16x16x32_bf16(xa, wx, ai[nt], 0, 0, 0); } }
#pragma unroll
            for (int nt = 0; nt < 2; ++nt) { const int j = 16 * nt + l15; const float ba = prm[j], bx = prm[32 + j], sp8 = prm[64 + j];
#pragma unroll
                for (int i = 0; i < 4; ++i) { const int tok = 16 * hw + 4 * l4 + i;
                    const float r = sigmoidf_(ar[nt][i] + ba), ig = sigmoidf_(ai[nt][i] + bx);
                    const float la = -r * sp8; const float av = fexp2(la * LOG2E); const float mult = __builtin_amdgcn_sqrtf(fmaxf(neg_expm1(2.0f * la), 0.f));
                    const float x = bf1(xcb[tok * 72 + hc * 32 + j]);
                    As[tok * 32 + j] = av; Us[tok * 32 + j] = x * ig * mult; } }
        }
        asm volatile("s_waitcnt vmcnt(0)" ::: "memory");
        LBAR();
        bf16_t* outp_ = YA + (size_t)(rowbase + chunk * 64 + tokE) * D + cb * 64 + hc * 32 + c0E;
        unsigned long long q0 = 0, q1 = 0;
        if (second) { const unsigned long long* pq = (const unsigned long long*)outp_;
            q0 = __hip_atomic_load(pq, __ATOMIC_RELAXED, __HIP_MEMORY_SCOPE_AGENT); q1 = __hip_atomic_load(pq + 1, __ATOMIC_RELAXED, __HIP_MEMORY_SCOPE_AGENT); }
        if (step + 1 < 68) {
            const int st2 = step + 1;
            const int gid2 = (half == 0) ? st2 : (st2 < 4 ? 3 - st2 : 71 - st2); const bool isctx2 = gid2 < 4; const int chunk2 = isctx2 ? gid2 : gid2 - 4;
            const int L2 = isctx2 ? CTX : SEQ; const int rowbase2 = isctx2 ? b * CTX : TC + b * SEQ;
#pragma unroll
            for (int k = 0; k < 4; ++k) { const int ts = chunk2 * 64 + tokA + k - 2; tp[k][0] = (u32x4){0u, 0u, 0u, 0u}; tp[k][1] = (u32x4){0u, 0u, 0u, 0u};
                if (ts >= 0 && ts < L2) { const bf16_t* p = ZA + (size_t)(rowbase2 + ts) * D + cb * 64 + c0A; tp[k][0] = *(const u32x4*)p; tp[k][1] = *(const u32x4*)(p + 8); } }
        }
        const int c = ht & 31, seg = ht >> 5;
        {
            float h = 0.f, P = 1.f;
#pragma unroll
            for (int p = seg * 8; p < seg * 8 + 8; ++p) { const int tok = half ? 63 - p : p; const float av = As[tok * 32 + c], uv = Us[tok * 32 + c];
                h = av * h + uv; P *= av; Us[tok * 32 + c] = h; As[tok * 32 + c] = P; }
            segH[seg * 32 + c] = h; segP[seg * 32 + c] = P;
        }
        LBAR();
        {
            float cin = carry[(step & 1) * 32 + c];
            for (int s2 = 0; s2 < seg; ++s2) cin = segP[s2 * 32 + c] * cin + segH[s2 * 32 + c];
            float hl = 0.f;
#pragma unroll
            for (int p = seg * 8; p < seg * 8 + 8; ++p) { const int tok = half ? 63 - p : p; hl = Us[tok * 32 + c] + As[tok * 32 + c] * cin; Us[tok * 32 + c] = hl; }
            if (seg == 7) carry[((step + 1) & 1) * 32 + c] = hl;
        }
        LBAR();
        {
            float o0[8];
#pragma unroll
            for (int j = 0; j < 8; ++j) o0[j] = Us[tokE * 32 + c0E + j];
            if (second) { float e0[8]; u32x4 wA; wA.x = (unsigned)q0; wA.y = (unsigned)(q0 >> 32); wA.z = (unsigned)q1; wA.w = (unsigned)(q1 >> 32); unpack8(wA, e0);
#pragma unroll
                for (int j = 0; j < 8; ++j) o0[j] += e0[j]; }
            *(u32x4*)outp_ = pack8(o0);
        }
    }
    asm volatile("s_waitcnt vmcnt(0)" ::: "memory");
#undef SCAN_DESC
}

DI void sgu_item(const Args& a, LAS unsigned char* lds, int l, int tc) {
    const int tid = tidx(), lane = tid & 63, w = tid >> 6, hh = lane >> 5, r32 = lane & 31;
    const int row0 = tc < 8 ? (tc >> 1) * CTX + (tc & 1) * 128 : TC + ((tc - 8) >> 5) * SEQ + ((tc - 8) & 31) * 128;
    LAS bf16_t* Wl = (LAS bf16_t*)lds;
    LAS bf16_t* VnT = (LAS bf16_t*)(lds + 34816);
    LAS float* st = (LAS float*)(lds + 69632);
    const bf16_t* ZV = (const bf16_t*)(wsp() + WS_ZV); bf16_t* ZU = (bf16_t*)(wsp() + WS_ZU);
    for (int t = w * 16; t < w * 16 + 16; ++t) {
        const bf16_t* p = ZV + (size_t)(row0 + t) * D + lane * 16;
        float x0[8], x1[8]; unpack8(*(const u32x4*)p, x0); unpack8(*(const u32x4*)(p + 8), x1);
        float s = 0.f;
#pragma unroll
        for (int j = 0; j < 8; ++j) s += x0[j] + x1[j];
        const float mean = wave_sum(s) * (1.0f / D); float q = 0.f;
#pragma unroll
        for (int j = 0; j < 8; ++j) { const float d0 = x0[j] - mean, d1 = x1[j] - mean; q += d0 * d0 + d1 * d1; }
        const float var = wave_sum(q) * (1.0f / D);
        if (lane == 0) { st[t * 2] = mean; st[t * 2 + 1] = 1.0f / sqrtf(var + EPS); }
    }
    __syncthreads();
    for (int g = 0; g < 8; ++g) {
        {
            const float* ws = inp<17>() + ((size_t)l * 8 + g) * 16384;
#pragma unroll
            for (int it = 0; it < 8; ++it) { const int idx = (it * 512 + tid) * 4; const f32x4 v = *(const f32x4*)(ws + idx); const int p = idx >> 7, q = idx & 127;
                u32x2 o; o.x = pk2(v.x, v.y); o.y = pk2(v.z, v.w); *(LAS u32x2*)(Wl + p * 136 + q) = o; }
            const int tok = tid >> 2, c0 = (tid & 3) * 32;
            const float mean = st[tok * 2], rstd = st[tok * 2 + 1];
            const bf16_t* p = ZV + (size_t)(row0 + tok) * D + g * 128 + c0;
            const float* lg = inp<15>() + (size_t)l * D + g * 128 + c0; const float* lb = inp<16>() + (size_t)l * D + g * 128 + c0;
#pragma unroll
            for (int q4 = 0; q4 < 4; ++q4) { float x[8]; unpack8(*(const u32x4*)(p + q4 * 8), x);
#pragma unroll
                for (int j = 0; j < 8; ++j) { const int cc = q4 * 8 + j; VnT[(c0 + cc) * 136 + tok] = f2bf((x[j] - mean) * rstd * lg[cc] + lb[cc]); } }
        }
        __syncthreads();
        {
            const int pt = w >> 1, ch = w & 1;
            f32x16 acc[2];
#pragma unroll
            for (int i = 0; i < 16; ++i) { acc[0][i] = 0.f; acc[1][i] = 0.f; }
#pragma unroll
            for (int s = 0; s < 8; ++s) { const bf16x8 af = *(const LAS bf16x8*)(Wl + (32 * pt + r32) * 136 + 16 * s + 8 * hh);
#pragma unroll
                for (int nt = 0; nt < 2; ++nt) { const bf16x8 bfr = *(const LAS bf16x8*)(VnT + (64 * ch + 32 * nt + r32) * 136 + 16 * s + 8 * hh); acc[nt] = MFMA32(af, bfr, acc[nt]); } }
            const float* sb = inp<18>() + ((size_t)l * 8 + g) * 128;
#pragma unroll
            for (int nt = 0; nt < 2; ++nt)
#pragma unroll
                for (int i = 0; i < 16; ++i) { const int p = 32 * pt + (i & 3) + 8 * (i >> 2) + 4 * hh, c = 64 * ch + 32 * nt + r32;
                    bf16_t* up = ZU + (size_t)(row0 + p) * D + g * 128 + c;
                    *up = f2bf(bf1(*up) * (acc[nt][i] + sb[p])); }
        }
        __syncthreads();
    }
}

DI void attn_tile(const LAS bf16_t* Ks, const LAS bf16_t* Vt, int kb, const bf16x8 (&qf)[2][4], float (&m)[2], float (&ls)[2], f32x16 (&o)[2][2],
                  int r32, int hh, bool masked, int qloc0, int kv_lo, int kv_hi) {
    bf16x8 kf[4];
#pragma unroll
    for (int s = 0; s < 4; ++s) kf[s] = *(const LAS bf16x8*)(Ks + (kb + r32) * 72 + 16 * s + 8 * hh);
    bf16x8 pf[2][2];
#pragma unroll
    for (int qt = 0; qt < 2; ++qt) {
        f32x16 sc;
#pragma unroll
        for (int i = 0; i < 16; ++i) sc[i] = 0.f;
#pragma unroll
        for (int s = 0; s < 4; ++s) sc = MFMA32(kf[s], qf[qt][s], sc);
        if (masked) { const int ql = qloc0 + 32 * qt + r32;
#pragma unroll
            for (int i = 0; i < 16; ++i) { const int key = kb + (i & 3) + 8 * (i >> 2) + 4 * hh; const int df = key - 128 - ql;
                const bool ok = (df >= -128) && (df <= 128) && (key >= kv_lo) && (key < kv_hi); sc[i] = ok ? sc[i] : -1e30f; } }
        float mx = sc[0];
#pragma unroll
        for (int i = 1; i < 16; ++i) mx = fmaxf(mx, sc[i]);
        mx = fmaxf(mx, __shfl_xor(mx, 32));
        const float mn = fmaxf(m[qt], mx); const float alpha = fexp2(m[qt] - mn); m[qt] = mn;
        float p[16]; float rs = 0.f;
#pragma unroll
        for (int i = 0; i < 16; ++i) { p[i] = fexp2(sc[i] - mn); rs += p[i]; }
        ls[qt] = ls[qt] * alpha + rs;
#pragma unroll
        for (int i = 0; i < 16; ++i) { o[qt][0][i] *= alpha; o[qt][1][i] *= alpha; }
#pragma unroll
        for (int ks = 0; ks < 2; ++ks) { u32x4 w; w.x = pk2(p[8 * ks], p[8 * ks + 1]); w.y = pk2(p[8 * ks + 2], p[8 * ks + 3]); w.z = pk2(p[8 * ks + 4], p[8 * ks + 5]); w.w = pk2(p[8 * ks + 6], p[8 * ks + 7]);
            pf[qt][ks] = __builtin_bit_cast(bf16x8, w); }
    }
#pragma unroll
    for (int dt = 0; dt < 2; ++dt)
#pragma unroll
        for (int ks = 0; ks < 2; ++ks) { const LAS bf16_t* vp = Vt + (32 * dt + r32) * 392 + kb + 16 * ks + 4 * hh;
            const u32x2 lo = *(const LAS u32x2*)vp, hi = *(const LAS u32x2*)(vp + 8);
            u32x4 w; w.x = lo.x; w.y = lo.y; w.z = hi.x; w.w = hi.y; const bf16x8 vf = __builtin_bit_cast(bf16x8, w);
#pragma unroll
            for (int qt = 0; qt < 2; ++qt) o[qt][dt] = MFMA32(vf, pf[qt][ks], o[qt][dt]); }
}

DI void attn_stage(const Args& a, LAS bf16_t* Ks, LAS bf16_t* Vt, int l, bool ctxstage, int b, int n, int kvh) {
    const int tid = tidx(), e = tid & 7;
    const bf16_t* ZK = (const bf16_t*)(wsp() + WS_ZK); const bf16_t* ZVV = (const bf16_t*)(wsp() + WS_ZVV);
    const float* cosT = (const float*)(wsp() + WS_ROPE); const float* sinT = cosT + 1024;
    const float* kg = inp<20>() + l * 64 + e * 8;
    float kgv[8];
#pragma unroll
    for (int j = 0; j < 8; ++j) kgv[j] = kg[j];
    const int nk = ctxstage ? 256 : 384;
    for (int key0 = 0; key0 < nk; key0 += 64) {
        const int key = key0 + (tid >> 3);
        int kt = 0, row; bool valid = true;
        if (ctxstage) row = b * CTX + key; else { kt = n * 128 - 128 + key; valid = (kt >= 0) && (kt < SEQ); kt = kt < 0 ? 0 : (kt >= SEQ ? SEQ - 1 : kt); row = TC + b * SEQ + kt; }
        u32x4 kw = {0u, 0u, 0u, 0u}, vw = {0u, 0u, 0u, 0u};
        if (valid) { kw = *(const u32x4*)(ZK + (size_t)row * 256 + kvh * 64 + e * 8); vw = *(const u32x4*)(ZVV + (size_t)row * 256 + kvh * 64 + e * 8); }
        float x[8]; unpack8(kw, x);
        float ss = 0.f;
#pragma unroll
        for (int j = 0; j < 8; ++j) ss += x[j] * x[j];
        ss += __shfl_xor(ss, 1); ss += __shfl_xor(ss, 2); ss += __shfl_xor(ss, 4);
        const float rstd = 1.0f / sqrtf(ss * (1.0f / 64.0f) + EPS);
#pragma unroll
        for (int j = 0; j < 8; ++j) x[j] = x[j] * rstd * kgv[j];
        if (!ctxstage) {
            const int pos = (e >> 2) ? (kt & 63) : (kt >> 6); const bool second = (e >> 1) & 1; const int f0 = 8 * (e & 1);
#pragma unroll
            for (int j = 0; j < 8; ++j) { const float pr = __shfl_xor(x[j], 2); const float cs = cosT[pos * 16 + f0 + j], sn = sinT[pos * 16 + f0 + j];
                x[j] = second ? (x[j] * cs + pr * sn) : (x[j] * cs - pr * sn); }
        }
        *(LAS u32x4*)(Ks + key * 72 + e * 8) = pack8(x);
        Vt[(e * 8 + 0) * 392 + key] = (bf16_t)(vw.x & 0xffffu); Vt[(e * 8 + 1) * 392 + key] = (bf16_t)(vw.x >> 16);
        Vt[(e * 8 + 2) * 392 + key] = (bf16_t)(vw.y & 0xffffu); Vt[(e * 8 + 3) * 392 + key] = (bf16_t)(vw.y >> 16);
        Vt[(e * 8 + 4) * 392 + key] = (bf16_t)(vw.z & 0xffffu); Vt[(e * 8 + 5) * 392 + key] = (bf16_t)(vw.z >> 16);
        Vt[(e * 8 + 6) * 392 + key] = (bf16_t)(vw.w & 0xffffu); Vt[(e * 8 + 7) * 392 + key] = (bf16_t)(vw.w >> 16);
    }
}

DI void attn_item(const Args& a, LAS unsigned char* lds, int l, int kind, int b, int n, int kvh) {
    const int tid = tidx(), lane = tid & 63, w = tid >> 6, hh = lane >> 5, r32 = lane & 31;
    const int g = w >> 1, qhalf = w & 1, h = kvh * 4 + g, qloc0 = qhalf * 64;
    LAS bf16_t* Ks = (LAS bf16_t*)lds;
    LAS bf16_t* Vt = (LAS bf16_t*)(lds + 55296);
    bf16_t* ZQ = (bf16_t*)(wsp() + WS_ZQ);
    const float* cosT = (const float*)(wsp() + WS_ROPE); const float* sinT = cosT + 1024;
    const float* qg = inp<19>() + l * 64;
    const float SCL = 0.125f * LOG2E;
    bf16x8 qf[2][4];
#pragma unroll
    for (int qt = 0; qt < 2; ++qt) {
        const int qtok = n * 128 + qloc0 + 32 * qt + r32; const int row = kind ? b * CTX + qtok : TC + b * SEQ + qtok;
        const bf16_t* qp = ZQ + (size_t)row * D + h * 64 + 8 * hh;
        float v[4][8]; float ss = 0.f;
#pragma unroll
        for (int s = 0; s < 4; ++s) { unpack8(*(const u32x4*)(qp + 16 * s), v[s]);
#pragma unroll
            for (int j = 0; j < 8; ++j) ss += v[s][j] * v[s][j]; }
        ss += __shfl_xor(ss, 32);
        const float rstd = 1.0f / sqrtf(ss * (1.0f / 64.0f) + EPS);
#pragma unroll
        for (int s = 0; s < 4; ++s)
#pragma unroll
            for (int j = 0; j < 8; ++j) v[s][j] = v[s][j] * rstd * qg[16 * s + 8 * hh + j];
        if (!kind) { const int prow = qtok >> 6, pcol = qtok & 63;
#pragma unroll
            for (int j = 0; j < 8; ++j) { const int f = 8 * hh + j;
                const float c0 = cosT[prow * 16 + f], s0 = sinT[prow * 16 + f], c1 = cosT[pcol * 16 + f], s1 = sinT[pcol * 16 + f];
                const float t1 = v[0][j], t2 = v[1][j]; v[0][j] = t1 * c0 - t2 * s0; v[1][j] = t2 * c0 + t1 * s0;
                const float t3 = v[2][j], t4 = v[3][j]; v[2][j] = t3 * c1 - t4 * s1; v[3][j] = t4 * c1 + t3 * s1; } }
#pragma unroll
        for (int s = 0; s < 4; ++s) {
#pragma unroll
            for (int j = 0; j < 8; ++j) v[s][j] *= SCL;
            qf[qt][s] = __builtin_bit_cast(bf16x8, pack8(v[s])); }
    }
    const float sk = inp<21>()[l * 16 + h] * LOG2E;
    float m[2] = {sk, sk}; float ls[2]; ls[0] = ls[1] = (hh == 0) ? 1.0f : 0.0f;
    f32x16 o[2][2];
#pragma unroll
    for (int i = 0; i < 16; ++i) { o[0][0][i] = 0.f; o[0][1][i] = 0.f; o[1][0][i] = 0.f; o[1][1][i] = 0.f; }
    if (!kind) {
        attn_stage(a, Ks, Vt, l, false, b, n, kvh);
        __syncthreads();
        const int kv_lo = 128 - n * 128 > 0 ? 128 - n * 128 : 0; const int kv_hi = (SEQ - n * 128 + 128) < 384 ? (SEQ - n * 128 + 128) : 384;
        int t_lo = qhalf ? 2 : 0, t_hi = qhalf ? 12 : 10;
        if (t_lo < (kv_lo >> 5)) t_lo = kv_lo >> 5;
        if (t_hi > (kv_hi >> 5)) t_hi = kv_hi >> 5;
        for (int t = t_lo; t < t_hi; ++t) attn_tile(Ks, Vt, 32 * t, qf, m, ls, o, r32, hh, true, qloc0, kv_lo, kv_hi);
        __syncthreads();
    }
    attn_stage(a, Ks, Vt, l, true, b, n, kvh);
    __syncthreads();
    for (int t = 0; t < 8; ++t) attn_tile(Ks, Vt, 32 * t, qf, m, ls, o, r32, hh, false, qloc0, 0, 256);
#pragma unroll
    for (int qt = 0; qt < 2; ++qt) {
        const float lt = ls[qt] + __shfl_xor(ls[qt], 32); const float inv = 1.0f / lt;
        const int qtok = n * 128 + qloc0 + 32 * qt + r32; const int row = kind ? b * CTX + qtok : TC + b * SEQ + qtok;
        bf16_t* op = ZQ + (size_t)row * D + h * 64 + 4 * hh;
#pragma unroll
        for (int dt = 0; dt < 2; ++dt)
#pragma unroll
            for (int q4 = 0; q4 < 4; ++q4) { u32x2 wv; wv.x = pk2(o[qt][dt][4 * q4] * inv, o[qt][dt][4 * q4 + 1] * inv); wv.y = pk2(o[qt][dt][4 * q4 + 2] * inv, o[qt][dt][4 * q4 + 3] * inv);
                *(u32x2*)(op + 32 * dt + 8 * q4) = wv; }
    }
}

DI void phase_mix(const Args& a, LAS unsigned char* lds, int l) {
    const int tid = tidx();
    const bool last = (l == DEPTH - 1);
    unsigned* ctr = (unsigned*)(wsp() + WS_CTL) + l;
    LAS int* slot = (LAS int*)(lds + LDS_MISC);
    const int n_scan = 128, n_attl = 512, n_attc = last ? 0 : 32, n_sgu = last ? 128 : 136;
    const int total = n_scan + n_attl + n_attc + n_sgu;
    for (;;) {
        __syncthreads();
        if (tid == 0) *slot = (int)atomicAdd(ctr, 1u);
        __syncthreads();
        int it = *slot;
        if (it >= total) break;
#ifndef NO_SCAN
#ifdef PROBE_K
        const unsigned long long pt0 = __builtin_amdgcn_s_memrealtime();
#define PT_END(k, mx) do { if (tid == 0) { const unsigned dt = (unsigned)(__builtin_amdgcn_s_memrealtime() - pt0); if (mx) atomicMax((unsigned*)(wsp() + WS_CTL) + 128 + (k), dt); else atomicAdd((unsigned*)(wsp() + WS_CTL) + 128 + (k), dt); } } while (0)
#else
#define PT_END(k, mx) do {} while (0)
#endif
        if (it < n_scan) { scan_item(a, lds, l, it >> 5, (it >> 1) & 15, it & 1); PT_END(0, 1); continue; }
#endif
        it -= n_scan;
#ifndef NO_ATT
        if (it < n_attl) { attn_item(a, lds, l, 0, it >> 7, (it >> 2) & 31, it & 3); PT_END(1, 0); continue; }
#endif
        it -= n_attl;
#ifndef NO_ATT
        if (it < n_attc) { attn_item(a, lds, l, 1, it >> 3, (it >> 2) & 1, it & 3); PT_END(3, 0); continue; }
#endif
        it -= n_attc;
#ifndef NO_SGU
        sgu_item(a, lds, l, last ? it + 8 : it);
#endif
        PT_END(2, 0);
    }
}


DI void grid_barrier(unsigned* bar, unsigned target) {
    asm volatile("s_waitcnt vmcnt(0) lgkmcnt(0)" ::: "memory");
    __syncthreads();
    if (threadIdx.x == 0) {
        __builtin_amdgcn_fence(__ATOMIC_RELEASE, "agent");
        __hip_atomic_fetch_add(bar, 1u, __ATOMIC_RELAXED, __HIP_MEMORY_SCOPE_AGENT);
        while (__hip_atomic_load(bar, __ATOMIC_RELAXED, __HIP_MEMORY_SCOPE_AGENT) < target) __builtin_amdgcn_s_sleep(2);
        __builtin_amdgcn_fence(__ATOMIC_ACQUIRE, "agent");
    }
    __syncthreads();
}


#ifdef DBG_STOP
DI void dbg_dump(int which) {
    unsigned char* ws = wsp(); float* out = outp();
    const size_t n = (size_t)TL * D, stride = (size_t)gridDim.x * 512;
    const bf16_t* H = (const bf16_t*)(ws + WS_H); const bf16_t* MG = (const bf16_t*)(ws + WS_MG);
    const bf16_t* ZA = (const bf16_t*)(ws + WS_ZA); const bf16_t* ZU = (const bf16_t*)(ws + WS_ZU); const bf16_t* ZV = (const bf16_t*)(ws + WS_ZV); const bf16_t* ZQ = (const bf16_t*)(ws + WS_ZQ);
    const bf16_t* ZK = (const bf16_t*)(ws + WS_ZK); const bf16_t* ZVV = (const bf16_t*)(ws + WS_ZVV); const bf16_t* ZG = (const bf16_t*)(ws + WS_ZG);
    for (size_t i = (size_t)blockIdx.x * 512 + threadIdx.x; i < n; i += stride) {
        float v = 0.f;
        if (which == 1) v = bf1(H[i]) + bf1(H[i + (size_t)TC * D]);
        if (which == 2) v = bf1(ZA[i]) + bf1(ZU[i]) + bf1(ZV[i]) + bf1(ZQ[i]) + bf1(ZG[i]) + bf1(ZG[i + n]) + bf1(ZG[i + 2 * n]) + bf1(ZK[i % ((size_t)T * 256)]) + bf1(ZVV[i % ((size_t)T * 256)]) + bf1(ZA[i + (size_t)TC * D]);
        if (which == 3) v = bf1(H[i + (size_t)TC * D]);
        if (which == 4) v = bf1(ZU[i + (size_t)TC * D]);
        if (which == 5) v = bf1(ZQ[i + (size_t)TC * D]);
        if (which == 6) v = bf1(MG[i + (size_t)TC * D]);
        if (which == 7) v = bf1(H[i]) + bf1(ZU[i]) + bf1(ZQ[i]);
        out[i] = v;
    }
}
#endif

__global__ void __launch_bounds__(512, 2) fwd_megakernel(Args a) {
    extern __shared__ __attribute__((aligned(16))) unsigned char shm[];
    LAS unsigned char* lds = (LAS unsigned char*)shm;
    unsigned* gbar = (unsigned*)(wsp() + WS_CTL) + 64; unsigned nbar = 0;
#define GRID_SYNC() do { ++nbar; grid_barrier(gbar, nbar * (unsigned)G); } while (0)
#ifdef PROBE_K
    unsigned long long pr_prev = __builtin_amdgcn_s_memrealtime(), pr_acc = 0;
#define PROBE(k) do { const unsigned long long now_ = __builtin_amdgcn_s_memrealtime(); if ((k) == PROBE_K || PROBE_K == 99) pr_acc += now_ - pr_prev; pr_prev = now_; } while (0)
#else
#define PROBE(k) do {} while (0)
#endif
    const int G = gridDim.x;
    unsigned char* ws = wsp();

#if !defined(ONLY) || ONLY == 0
    phase_prep(a, lds);
#endif
    GRID_SYNC();
    PROBE(0);
    for (int l = 0; l < DEPTH; ++l) {
        const bool last = (l == DEPTH - 1);
        const int pm0 = last ? 4 : 0, nM = last ? 64 : 68;
        const float* modl = (const float*)(ws + WS_MOD) + (size_t)l * 5 * 6144;
#if !defined(ONLY) || ONLY == 1
        phase_norm(a, lds, l, 0);
#endif
        GRID_SYNC();
    PROBE(1);
#if defined(DBG_STOP) && DBG_STOP == 1
        dbg_dump(1); return;
#endif
        {
            pg8::Sched S; S.nM = 68; S.nN = INW / 256; S.nwg = S.nM * S.nN; S.G = G; S.c = bidx(); S.nseg = 1; S.pm0 = 0;
            S.A0 = (const char*)(ws + WS_H); S.d1 = 0; S.d2 = 0; S.B0 = (const char*)(ws + WS_WIN); S.bseg = 0; S.tstep = (size_t)256 * D * 2;
            pg8::EpiIn E{ws};
            pg8::gemm_phase<pg8::EpiIn, pg8::Sched>(lds, D, D, S, E);
        }
        GRID_SYNC();
    PROBE(2);
#if defined(DBG_STOP) && DBG_STOP == 2
        dbg_dump(2); return;
#endif
        phase_mix(a, lds, l);
        GRID_SYNC();
    PROBE(3);
#if defined(DBG_STOP) && DBG_STOP >= 3 && DBG_STOP <= 5
        dbg_dump(DBG_STOP); return;
#endif
#if defined(DBG_STOP) && DBG_STOP == 7
        dbg_dump(7); return;
#endif
        {
            pg8::Sched S; S.nM = 64; S.nN = 4; S.nwg = S.nM * S.nN; S.G = G; S.c = bidx(); S.nseg = 3; S.pm0 = 4;
            S.A0 = (const char*)(ws + WS_H); S.d1 = 2 * SLOT; S.d2 = 2 * SLOT; S.B0 = (const char*)(ws + WS_WBR); S.bseg = (size_t)D * D * 2; S.tstep = (size_t)256 * D * 2;
            pg8::EpiMerge E{(bf16_t*)(ws + WS_MG), (const bf16_t*)(ws + WS_ZG)};
            pg8::gemm_phase<pg8::EpiMerge, pg8::Sched>(lds, D, D, S, E);
        }
        if (!last) {
            pg8::SchedList S; S.n = 48; S.G = G; S.c = bidx(); S.nN = 4; S.nS = 3; S.nQ = 1;
            S.A0 = (const char*)(ws + WS_H); S.a_pm = (size_t)256 * D * 2; S.a_s = 2 * SLOT; S.a_q = 0;
            S.B0 = (const char*)(ws + WS_WBR); S.b_pn = (size_t)256 * D * 2; S.b_s = (size_t)D * D * 2; S.b_q = 0;
            pg8::EpiMergeCtx E{(bf16_t*)(ws + WS_PC), (const bf16_t*)(ws + WS_ZG)};
            pg8::gemm_phase<pg8::EpiMergeCtx, pg8::SchedList>(lds, D, D, S, E);
        }
        GRID_SYNC();
    PROBE(4);
#if defined(DBG_STOP) && DBG_STOP == 6
        dbg_dump(6); return;
#endif
        {
            pg8::Sched S; S.nM = 64; S.nN = 4; S.nwg = S.nM * S.nN; S.G = G; S.c = bidx(); S.nseg = 1; S.pm0 = 4;
            S.A0 = (const char*)(ws + WS_MG); S.d1 = 0; S.d2 = 0; S.B0 = (const char*)(ws + WS_WOUT); S.bseg = 0; S.tstep = (size_t)256 * D * 2;
            pg8::EpiRes E{(const float*)(ws + WS_XC), l == 0 ? inp<0>() : (const float*)outp(), (float*)(ws + WS_XC), outp(), modl + 2 * 1024};
            pg8::gemm_phase<pg8::EpiRes, pg8::Sched>(lds, D, D, S, E);
        }
        if (!last) {
            pg8::SchedList S; S.n = 192; S.G = G; S.c = bidx(); S.nN = 4; S.nS = 3; S.nQ = 4;
            S.A0 = (const char*)(ws + WS_PC); S.a_pm = (size_t)256 * D * 2; S.a_s = (size_t)TC * D * 2; S.a_q = 256 * 2;
            S.B0 = (const char*)(ws + WS_WOUT); S.b_pn = (size_t)256 * D * 2; S.b_s = 0; S.b_q = 256 * 2;
            pg8::EpiPartial E{(float*)(ws + WS_PX), 4};
            pg8::gemm_phase<pg8::EpiPartial, pg8::SchedList>(lds, 256, D, S, E);
        }
        GRID_SYNC();
    PROBE(5);
        phase_norm(a, lds, l, 1);
        GRID_SYNC();
    PROBE(6);
        {
            pg8::Sched S; S.nM = nM; S.nN = DFF / 256; S.nwg = S.nM * S.nN; S.G = G; S.c = bidx(); S.nseg = 1; S.pm0 = pm0;
            S.A0 = (const char*)(ws + WS_H); S.d1 = 0; S.d2 = 0; S.B0 = (const char*)(ws + WS_WFF1); S.bseg = 0; S.tstep = (size_t)256 * D * 2;
            pg8::EpiFF1 E{(bf16_t*)(ws + WS_HID)};
            pg8::gemm_phase<pg8::EpiFF1, pg8::Sched>(lds, D, D, S, E);
        }
        GRID_SYNC();
    PROBE(7);
        {
            pg8::Sched S; S.nM = 64; S.nN = 4; S.nwg = S.nM * S.nN; S.G = G; S.c = bidx(); S.nseg = 1; S.pm0 = 4;
            S.A0 = (const char*)(ws + WS_HID); S.d1 = 0; S.d2 = 0; S.B0 = (const char*)(ws + WS_WFF2); S.bseg = 0; S.tstep = (size_t)256 * DFF * 2;
            pg8::EpiRes E{(const float*)(ws + WS_XC), (const float*)outp(), (float*)(ws + WS_XC), outp(), modl + 5 * 1024};
            pg8::gemm_phase<pg8::EpiRes, pg8::Sched>(lds, DFF, DFF, S, E);
        }
        if (!last) {
            pg8::SchedList S; S.n = 64; S.G = G; S.c = bidx(); S.nN = 4; S.nS = 1; S.nQ = 4;
            S.A0 = (const char*)(ws + WS_HID); S.a_pm = (size_t)256 * DFF * 2; S.a_s = 0; S.a_q = 1024 * 2;
            S.B0 = (const char*)(ws + WS_WFF2); S.b_pn = (size_t)256 * DFF * 2; S.b_s = 0; S.b_q = 1024 * 2;
            pg8::EpiPartial E{(float*)(ws + WS_PX), 4};
            pg8::gemm_phase<pg8::EpiPartial, pg8::SchedList>(lds, 1024, DFF, S, E);
        }
#ifdef PROBE_K
        GRID_SYNC();
#else
        if (!last) GRID_SYNC();
#endif
    PROBE(8);
    }
#ifdef PROBE_K
    if (blockIdx.x == 0 && threadIdx.x == 0) { float pv = (float)pr_acc * 0.01f; if (PROBE_K >= 30 && PROBE_K < 40) pv = (float)(((unsigned*)(wsp() + WS_CTL))[128 + PROBE_K - 30]) * 0.01f; { const float sc_ = exp10f(floorf(log10f(fmaxf(pv, 1.0f))) - 1.0f); pv = floorf(pv / sc_ + 0.5f) * sc_; } outp()[0] += pv; }
#endif
}

extern "C" void kernel_launch(void* const* d_in, const int* in_sizes, int n_in, void* d_out, int out_size, void* d_ws, size_t ws_size, hipStream_t stream) {
    static int grid = 0;
    if (grid == 0) {
        if (n_in != 27 || out_size != TL * D || ws_size < WS_END) { fprintf(stderr, "kernel_launch: unexpected shapes (n_in %d out %d ws %zu need %zu)\n", n_in, out_size, ws_size, (size_t)WS_END); grid = -1; return; }
        int dev = 0, cus = 0, per_cu = 0;
        hipGetDevice(&dev);
        hipDeviceGetAttribute(&cus, hipDeviceAttributeMultiprocessorCount, dev);
        hipFuncSetAttribute((const void*)fwd_megakernel, hipFuncAttributeMaxDynamicSharedMemorySize, LDS_BYTES);
        hipOccupancyMaxActiveBlocksPerMultiprocessor(&per_cu, (const void*)fwd_megakernel, 512, LDS_BYTES);
        if (per_cu < 1) { fprintf(stderr, "kernel_launch: occupancy query says %d blocks/CU\n", per_cu); per_cu = 1; }
        (void)hipGetLastError();
        grid = cus;
    }
    if (grid < 0) return;
    if (hipMemsetAsync((char*)d_ws + WS_CTL, 0, 4096, stream) != hipSuccess) { fprintf(stderr, "memset failed\n"); return; }
    Args a{};
    for (int i = 0; i < 27; ++i) a.in[i] = (const float*)d_in[i];
    a.out = (float*)d_out; a.ws = (unsigned char*)d_ws;
    void* args[] = {&a};
    hipError_t e = hipLaunchCooperativeKernel((const void*)fwd_megakernel, dim3(grid), dim3(512), args, LDS_BYTES, stream);
    if (e != hipSuccess) fprintf(stderr, "cooperative launch failed: %s (grid %d)\n", hipGetErrorString(e), grid);
}
```

```cpp
#define DBG_NOADD 0
#include <hip/hip_runtime.h>
#include <hip/hip_cooperative_groups.h>
#include <cstdio>
#include <cstdint>
namespace cg = cooperative_groups;

#define LAS __attribute__((address_space(3)))
#define DI __device__ __forceinline__
typedef unsigned short bf16_t;
typedef short bf16x8 __attribute__((ext_vector_type(8)));
typedef short s16x4 __attribute__((ext_vector_type(4)));
typedef float f32x2 __attribute__((ext_vector_type(2)));
typedef float f32x4 __attribute__((ext_vector_type(4)));
typedef float f32x16 __attribute__((ext_vector_type(16)));
typedef unsigned u32x2 __attribute__((ext_vector_type(2)));
typedef unsigned u32x4 __attribute__((ext_vector_type(4)));
typedef __bf16 bf16x2_t __attribute__((ext_vector_type(2)));

constexpr int D = 1024, NB = 4, SEQ = 4096, CTX = 256, DEPTH = 4, DFF = 4096;
constexpr int TC = NB * CTX;
constexpr int TL = NB * SEQ;
constexpr int T = TC + TL;
constexpr int INW = 7680;
constexpr float EPS = 1e-6f;
constexpr float LOG2E = 1.4426950408889634f;

constexpr size_t WS_CTL = 0;
constexpr size_t WS_ROPE = 4096;
constexpr size_t WS_MOD = 65536;
constexpr size_t WS_XC = 1u << 20;
constexpr size_t WS_WIN = 5u << 20;
constexpr size_t WS_WBR = WS_WIN + (size_t)INW * D * 2;
constexpr size_t WS_WOUT = WS_WBR + (size_t)3 * D * D * 2;
constexpr size_t WS_WFF1 = WS_WOUT + (size_t)D * D * 2;
constexpr size_t WS_WFF2 = WS_WFF1 + (size_t)DFF * D * 2;
constexpr size_t SLOT = (size_t)T * D * 2;
constexpr size_t WT_BYTES = WS_WFF2 + (size_t)DFF * D * 2 - WS_WIN;
constexpr size_t WS_H = WS_WIN + 2 * WT_BYTES;
constexpr size_t WS_ZV = WS_H + SLOT;
constexpr size_t WS_ZU = WS_H + 2 * SLOT;
constexpr size_t WS_ZA = WS_H + 3 * SLOT;
constexpr size_t WS_ZQ = WS_H + 4 * SLOT;
constexpr size_t WS_ZK = WS_H + 5 * SLOT;
constexpr size_t WS_ZVV = WS_ZK + (size_t)T * 256 * 2;
constexpr size_t WS_ZG = WS_ZVV + (size_t)T * 256 * 2;
constexpr size_t WS_MG = WS_ZG + (size_t)T * 3072 * 2;
constexpr size_t WS_PC = WS_MG + SLOT;
constexpr size_t WS_PX = WS_PC + (size_t)3 * TC * D * 2;
constexpr size_t WS_END = WS_PX + (size_t)12 * TC * D * 4;
constexpr size_t WS_HID = WS_ZV;

constexpr int LDS_BYTES = 147456;
constexpr int LDS_MISC = 143360;

struct Args { const float* in[27]; float* out; unsigned char* ws; };


template <int OFF> DI const void* kargp() { const unsigned long long k = (unsigned long long)__builtin_amdgcn_kernarg_segment_ptr(); const void* p;
    asm volatile("s_load_dwordx2 %0, %1, %2\n\ts_waitcnt lgkmcnt(0)" : "=s"(p) : "s"(k), "n"(OFF) : "memory"); return p; }
template <int I> DI const float* inp() { return (const float*)kargp<I * 8>(); }
DI float* outp() { return (float*)kargp<27 * 8>(); }
DI unsigned char* wsp() { return (unsigned char*)kargp<28 * 8>(); }
DI int tidx() { int t = threadIdx.x; asm volatile("" : "+v"(t)); return t; }
DI int bidx() { int b = blockIdx.x; asm volatile("" : "+s"(b)); return b; }

DI unsigned pk2(float lo, float hi) { f32x2 v = {lo, hi}; bf16x2_t b = __builtin_convertvector(v, bf16x2_t); return __builtin_bit_cast(unsigned, b); }
DI float bflo(unsigned w) { return __uint_as_float(w << 16); }
DI float bfhi(unsigned w) { return __uint_as_float(w & 0xffff0000u); }
DI float bf1(bf16_t h) { return __uint_as_float(((unsigned)h) << 16); }
DI bf16_t f2bf(float f) { return (bf16_t)(pk2(f, 0.f) & 0xffffu); }
DI float fexp2(float x) { return __builtin_amdgcn_exp2f(x); }
DI float frcp(float x) { return __builtin_amdgcn_rcpf(x); }
DI float sigmoidf_(float x) { return frcp(1.0f + fexp2(-x * LOG2E)); }
DI float gelu_tanh(float x) { const float u = x + 0.044715f * x * x * x; return x * frcp(1.0f + fexp2(-1.5957691216f * LOG2E * u)); }
DI float wave_sum(float v) {
#pragma unroll
    for (int o = 1; o < 64; o <<= 1) v += __shfl_xor(v, o);
    return v;
}
DI void unpack8(const u32x4 w, float (&v)[8]) { v[0] = bflo(w.x); v[1] = bfhi(w.x); v[2] = bflo(w.y); v[3] = bfhi(w.y); v[4] = bflo(w.z); v[5] = bfhi(w.z); v[6] = bflo(w.w); v[7] = bfhi(w.w); }
DI u32x4 pack8(const float (&v)[8]) { u32x4 w; w.x = pk2(v[0], v[1]); w.y = pk2(v[2], v[3]); w.z = pk2(v[4], v[5]); w.w = pk2(v[6], v[7]); return w; }
#define MFMA32(a, b, c) __builtin_amdgcn_mfma_f32_32x32x16_bf16((a), (b), (c), 0, 0, 0)

namespace pg8 {
constexpr int BM = 256, BK = 64, HALF = 128, HTB = HALF * BK * 2, STAGE_BYTES = 8 * HTB, NXCD = 8, WGM = 8;
DI int lds_byte(int r, int c) { const int st = (r >> 4) * 2 + (c >> 5), rr = r & 15, cc = c & 31, ob = rr * 64 + cc * 2; return st * 1024 + (ob ^ (((ob >> 9) & 1) << 5)); }
DI void stage_rc(int b, int& R, int& C) { const int st = b / 1024, sb = b % 1024, swz = sb ^ (((sb >> 9) & 1) << 5); R = (st >> 1) * 16 + swz / 64; C = (st & 1) * 32 + (swz % 64) / 2; }
DI int perm32(int rho) { const int n = rho >> 4, i = rho & 15; return 8 * (i >> 2) + 4 * n + (i & 3); }

struct Unit { int pm, pn, seg, q; const char* A; const char* B; };

struct Sched {
    int nM, nN, nwg, G, c, nseg, pm0;
    const char *A0, *B0; size_t d1, d2, bseg, tstep;
    DI bool next(int i, Unit& u) const {
        int ti = i, seg = 0;
        if (nseg == 3) { ti = i / 3; seg = i - 3 * ti; }
        const long L = (long)ti * G + c; if (L >= nwg) return false;
        int wgid = (int)L; { const int q = nwg / NXCD, r = nwg % NXCD, xcd = wgid % NXCD, off = wgid / NXCD; wgid = (xcd < r ? xcd * (q + 1) : r * (q + 1) + (xcd - r) * q) + off; }
        const int nig = WGM * nN, gid = wgid / nig, fm = gid * WGM, gsz = (nM - fm) < WGM ? (nM - fm) : WGM;
        u.pm = pm0 + fm + ((wgid % nig) % gsz); u.pn = (wgid % nig) / gsz; u.seg = seg; u.q = 0;
        const size_t ao = (seg >= 1 ? d1 : (size_t)0) + (seg >= 2 ? d2 : (size_t)0);
        u.A = A0 + ao + (size_t)u.pm * tstep; u.B = B0 + (size_t)seg * bseg + (size_t)u.pn * tstep;
        return true;
    }
};

struct SchedList {
    int n, G, c, nN, nS, nQ; const char *A0, *B0; size_t a_pm, a_s, a_q, b_pn, b_s, b_q;
    DI bool next(int i, Unit& u) const {
        const int idx = i * G + c; if (idx >= n) return false;
        const int q = idx % nQ; int t = idx / nQ; const int sg = t % nS; t /= nS; const int pn = t % nN, pm = t / nN;
        u.pm = pm; u.pn = pn; u.seg = sg; u.q = q;
        u.A = A0 + (size_t)pm * a_pm + (size_t)sg * a_s + (size_t)q * a_q; u.B = B0 + (size_t)pn * b_pn + (size_t)sg * b_s + (size_t)q * b_q;
        return true;
    }
};

template <class Epi, class SchedT>
DI void gemm_phase(LAS unsigned char* lds, const int K, const int pitch, const SchedT& S, const Epi& E) {
    const int tid = tidx(), wid = __builtin_amdgcn_readfirstlane(tid >> 6), lane = tid & 63, wr = wid >> 2, wc = wid & 3, fr = lane & 15, fq = lane >> 4;
    const int nt = K / BK;
    unsigned voffA[2], voffB[2];
#pragma unroll
    for (int i = 0; i < 2; ++i) { int R, C; stage_rc(tid * 16 + i * 8192, R, C); const int Rb = Epi::PERM ? ((R & ~31) + perm32(R & 31)) : R;
        voffA[i] = (unsigned)(R * pitch + C) * 2u; voffB[i] = (unsigned)(Rb * pitch + C) * 2u; }
    const size_t kstep = (size_t)(BK * 2);
    const size_t hstep = (size_t)HALF * pitch * 2;
    const unsigned ldsw = (unsigned)wid * 1024u;
    const int aoff = lds_byte(wr * 64 + fr, fq * 8), boff = lds_byte(wc * 32 + fr, fq * 8);
#define PG8_SA(b, h) (((b) * 2 + (h)) * HTB)
#define PG8_SB(b, h) ((4 + (b) * 2 + (h)) * HTB)
#define PG8_STAGE(bufoff, gbase, voff) do { _Pragma("unroll") for (int _i = 0; _i < 2; ++_i) \
        __builtin_amdgcn_global_load_lds((const unsigned*)((const char*)(gbase) + (voff)[_i]), (LAS unsigned*)(lds + (bufoff) + ldsw + _i * 8192), 16, 0, 0); } while (0)
#define PG8_LDA(dst, b, h) do { _Pragma("unroll") for (int m = 0; m < 4; ++m) _Pragma("unroll") for (int k = 0; k < 2; ++k) dst[m][k] = *(const LAS bf16x8*)(lds + PG8_SA(b, h) + aoff + m * 2048 + k * 1024); } while (0)
#define PG8_LDB(dst, b, h) do { _Pragma("unroll") for (int n = 0; n < 2; ++n) _Pragma("unroll") for (int k = 0; k < 2; ++k) dst[n][k] = *(const LAS bf16x8*)(lds + PG8_SB(b, h) + boff + n * 2048 + k * 1024); } while (0)
#define PG8_MMA(ai, bj, At, Bt) do { __builtin_amdgcn_s_setprio(1); _Pragma("unroll") for (int m = 0; m < 4; ++m) _Pragma("unroll") for (int n = 0; n < 2; ++n) _Pragma("unroll") for (int k = 0; k < 2; ++k) \
        acc[ai][bj][m][n] = __builtin_amdgcn_mfma_f32_16x16x32_bf16(Bt[n][k], At[m][k], acc[ai][bj][m][n], 0, 0, 0); __builtin_amdgcn_s_setprio(0); } while (0)
#define PG8_WAIT_V(n) asm volatile("s_waitcnt vmcnt(" #n ")" ::: "memory")
#define PG8_WAIT_L(n) asm volatile("s_waitcnt lgkmcnt(" #n ")" ::: "memory")
#define PG8_BAR __builtin_amdgcn_s_barrier()
#define PG8_SCHED __builtin_amdgcn_sched_barrier(0)
    Unit cur, nxt; int ui = 0;
    if (!S.next(0, cur)) return;
    f32x4 acc[2][2][4][2];
#pragma unroll
    for (int a = 0; a < 2; ++a)
#pragma unroll
        for (int b = 0; b < 2; ++b)
#pragma unroll
            for (int m = 0; m < 4; ++m)
#pragma unroll
                for (int n = 0; n < 2; ++n) acc[a][b][m][n] = (f32x4){0.f, 0.f, 0.f, 0.f};
    bf16x8 At[4][2], B0[2][2], B1[2][2];
    const char* cA = cur.A; const char* cB = cur.B;
    PG8_STAGE(PG8_SB(0, 0), cB, voffB); PG8_STAGE(PG8_SA(0, 0), cA, voffA); PG8_STAGE(PG8_SB(0, 1), cB + hstep, voffB); PG8_STAGE(PG8_SA(0, 1), cA + hstep, voffA);
    if (wr == 1) PG8_BAR;
    PG8_WAIT_V(4); PG8_BAR;
    PG8_STAGE(PG8_SB(1, 0), cB + kstep, voffB); PG8_STAGE(PG8_SA(1, 0), cA + kstep, voffA); PG8_STAGE(PG8_SB(1, 1), cB + hstep + kstep, voffB);
    PG8_WAIT_V(6); PG8_BAR;
    for (;;) {
        const bool has_next = S.next(ui + 1, nxt);
        const char* nA = has_next ? nxt.A : cA; const char* nB = has_next ? nxt.B : cB;
        for (int t = 0; t < nt; t += 2) {
            const bool last = (t == nt - 2);
            const char* a1 = cA + (size_t)(t + 1) * kstep;
            const char* a2 = last ? nA : cA + (size_t)(t + 2) * kstep; const char* b2 = last ? nB : cB + (size_t)(t + 2) * kstep;
            const char* a3 = a2 + kstep; const char* b3 = b2 + kstep;
            PG8_LDB(B0, 0, 0); PG8_SCHED; PG8_LDA(At, 0, 0); PG8_STAGE(PG8_SA(1, 1), a1 + hstep, voffA);
            PG8_WAIT_L(8); PG8_BAR; PG8_WAIT_L(0); PG8_MMA(0, 0, At, B0); PG8_BAR; PG8_SCHED;
            PG8_LDB(B1, 0, 1); PG8_STAGE(PG8_SB(0, 0), b2, voffB);
            PG8_BAR; PG8_WAIT_L(0); PG8_MMA(0, 1, At, B1); PG8_BAR;
            PG8_LDA(At, 0, 1); PG8_STAGE(PG8_SA(0, 0), a2, voffA);
            PG8_BAR; PG8_WAIT_L(0); PG8_MMA(1, 0, At, B0); PG8_BAR; PG8_SCHED;
            PG8_STAGE(PG8_SB(0, 1), b2 + hstep, voffB);
            PG8_WAIT_V(6); PG8_BAR; PG8_MMA(1, 1, At, B1); PG8_BAR;
            PG8_LDB(B0, 1, 0); PG8_SCHED; PG8_LDA(At, 1, 0); PG8_STAGE(PG8_SA(0, 1), a2 + hstep, voffA);
            PG8_WAIT_L(8); PG8_BAR; PG8_WAIT_L(0); PG8_MMA(0, 0, At, B0); PG8_BAR; PG8_SCHED;
            PG8_LDB(B1, 1, 1); PG8_STAGE(PG8_SB(1, 0), b3, voffB);
            PG8_BAR; PG8_WAIT_L(0); PG8_MMA(0, 1, At, B1); PG8_BAR;
            PG8_LDA(At, 1, 1); PG8_STAGE(PG8_SA(1, 0), a3, voffA);
            PG8_BAR; PG8_WAIT_L(0); PG8_MMA(1, 0, At, B0); PG8_BAR; PG8_SCHED;
            PG8_STAGE(PG8_SB(1, 1), b3 + hstep, voffB);
            PG8_WAIT_V(6); PG8_BAR; PG8_MMA(1, 1, At, B1); PG8_BAR;
        }
        E(acc, cur, wr, wc, fr, fq);
        if (!has_next) break;
        if (!Epi::KEEP || nxt.seg == 0) {
#pragma unroll
        for (int a = 0; a < 2; ++a)
#pragma unroll
            for (int b = 0; b < 2; ++b)
#pragma unroll
                for (int m = 0; m < 4; ++m)
#pragma unroll
                    for (int n = 0; n < 2; ++n) acc[a][b][m][n] = (f32x4){0.f, 0.f, 0.f, 0.f};
        }
        cur = nxt; cA = nA; cB = nB; ++ui;
    }
    PG8_WAIT_V(0);
    if (wr == 0) PG8_BAR;
    PG8_BAR;
#undef PG8_SA
#undef PG8_SB
#undef PG8_STAGE
#undef PG8_LDA
#undef PG8_LDB
#undef PG8_MMA
#undef PG8_WAIT_V
#undef PG8_WAIT_L
#undef PG8_BAR
#undef PG8_SCHED
}

struct EpiIn {
    static constexpr bool PERM = true, KEEP = false;
    unsigned char* ws;
    DI void operator()(const f32x4 (&acc)[2][2][4][2], const Unit& u, int wr, int wc, int fr, int fq) const {
        const int pn = u.pn; bf16_t* base; int ldc, colt, mode;
        if (pn < 4) { base = (bf16_t*)(ws + WS_ZA); ldc = 1024; colt = pn * 256; mode = 0; }
        else if (pn < 8) { base = (bf16_t*)(ws + WS_ZU); ldc = 1024; colt = (pn - 4) * 256; mode = 1; }
        else if (pn < 12) { base = (bf16_t*)(ws + WS_ZV); ldc = 1024; colt = (pn - 8) * 256; mode = 1; }
        else if (pn < 16) { base = (bf16_t*)(ws + WS_ZQ); ldc = 1024; colt = (pn - 12) * 256; mode = 0; }
        else if (pn == 16) { base = (bf16_t*)(ws + WS_ZK); ldc = 256; colt = 0; mode = 0; }
        else if (pn == 17) { base = (bf16_t*)(ws + WS_ZVV); ldc = 256; colt = 0; mode = 0; }
        else { base = (bf16_t*)(ws + WS_ZG); ldc = 3072; colt = (pn - 18) * 256; mode = 2; }
        const int row0 = u.pm * BM + wr * 64 + fr, col0 = colt + wc * 32 + 8 * fq;
#pragma unroll
        for (int ai = 0; ai < 2; ++ai)
#pragma unroll
            for (int m = 0; m < 4; ++m) { bf16_t* rowp = base + (size_t)(row0 + ai * HALF + m * 16) * ldc + col0;
#pragma unroll
                for (int bj = 0; bj < 2; ++bj) { f32x4 v0 = acc[ai][bj][m][0], v1 = acc[ai][bj][m][1];
                    if (mode == 1) {
#pragma unroll
                        for (int j = 0; j < 4; ++j) { v0[j] = gelu_tanh(v0[j]); v1[j] = gelu_tanh(v1[j]); } }
                    else if (mode == 2) {
#pragma unroll
                        for (int j = 0; j < 4; ++j) { v0[j] = sigmoidf_(v0[j]); v1[j] = sigmoidf_(v1[j]); } }
                    u32x4 w; w.x = pk2(v0[0], v0[1]); w.y = pk2(v0[2], v0[3]); w.z = pk2(v1[0], v1[1]); w.w = pk2(v1[2], v1[3]);
                    *(u32x4*)(rowp + bj * HALF) = w; } }
    }
};
struct EpiMerge {
    static constexpr bool PERM = true, KEEP = true;
    bf16_t* Mg; const bf16_t* ZG;
    DI void operator()(f32x4 (&acc)[2][2][4][2], const Unit& u, int wr, int wc, int fr, int fq) const {
        const int row0 = u.pm * BM + wr * 64 + fr, col0 = u.pn * BM + wc * 32 + 8 * fq, seg = u.seg;
#pragma unroll
        for (int ai = 0; ai < 2; ++ai)
#pragma unroll
            for (int m = 0; m < 4; ++m) { const size_t r = (size_t)(row0 + ai * HALF + m * 16);
#pragma unroll
                for (int bj = 0; bj < 2; ++bj) {
                    const bf16_t* gp = ZG + r * 3072 + seg * 1024 + col0 + bj * HALF;
                    float g[8]; unpack8(*(const u32x4*)gp, g);
#pragma unroll
                    for (int j = 0; j < 8; ++j) g[j] = fmaxf(g[j], 1e-6f);
                    if (seg < 2) { float gn[8]; unpack8(*(const u32x4*)(gp + 1024), gn);
#pragma unroll
                        for (int j = 0; j < 8; ++j) g[j] *= frcp(fmaxf(gn[j], 1e-6f)); }
                    f32x4& v0 = acc[ai][bj][m][0]; f32x4& v1 = acc[ai][bj][m][1];
                    v0[0] *= g[0]; v0[1] *= g[1]; v0[2] *= g[2]; v0[3] *= g[3]; v1[0] *= g[4]; v1[1] *= g[5]; v1[2] *= g[6]; v1[3] *= g[7];
                    if (seg == 2) { u32x4 w; w.x = pk2(v0[0], v0[1]); w.y = pk2(v0[2], v0[3]); w.z = pk2(v1[0], v1[1]); w.w = pk2(v1[2], v1[3]);
                        *(u32x4*)(Mg + r * 1024 + col0 + bj * HALF) = w; } } }
    }
};
struct EpiRes {
    static constexpr bool PERM = false, KEEP = false;
    const float* src_c; const float* src_l; float* dst_c; float* dst_l; const float* gate;
    DI void operator()(const f32x4 (&acc)[2][2][4][2], const Unit& u, int wr, int wc, int fr, int fq) const {
        const int rowt = u.pm * BM; const int grp = rowt < TC ? 4 : ((rowt - TC) >> 12);
        const float* src = rowt < TC ? src_c + (size_t)rowt * D : src_l + (size_t)(rowt - TC) * D;
        float* dst = rowt < TC ? dst_c + (size_t)rowt * D : dst_l + (size_t)(rowt - TC) * D;
        const int row0 = wr * 64 + fr, col0 = u.pn * BM + wc * 32 + 4 * fq;
        const float* gp = gate + grp * 6144 + col0;
        f32x4 gv[2][2];
#pragma unroll
        for (int bj = 0; bj < 2; ++bj)
#pragma unroll
            for (int n = 0; n < 2; ++n) gv[bj][n] = *(const f32x4*)(gp + bj * HALF + n * 16);
#pragma unroll
        for (int ai = 0; ai < 2; ++ai)
#pragma unroll
            for (int m = 0; m < 4; ++m) { const size_t off = (size_t)(row0 + ai * HALF + m * 16) * D + col0;
#pragma unroll
                for (int bj = 0; bj < 2; ++bj)
#pragma unroll
                    for (int n = 0; n < 2; ++n) { const f32x4 xs = *(const f32x4*)(src + off + bj * HALF + n * 16);
                        *(f32x4*)(dst + off + bj * HALF + n * 16) = xs + gv[bj][n] * acc[ai][bj][m][n]; } }
    }
};
struct EpiMergeCtx {
    static constexpr bool PERM = true, KEEP = false;
    bf16_t* Pc; const bf16_t* ZG;
    DI void operator()(const f32x4 (&acc)[2][2][4][2], const Unit& u, int wr, int wc, int fr, int fq) const {
        const int row0 = u.pm * BM + wr * 64 + fr, col0 = u.pn * BM + wc * 32 + 8 * fq, seg = u.seg;
#pragma unroll
        for (int ai = 0; ai < 2; ++ai)
#pragma unroll
            for (int m = 0; m < 4; ++m) { const size_t r = (size_t)(row0 + ai * HALF + m * 16);
#pragma unroll
                for (int bj = 0; bj < 2; ++bj) {
                    const u32x4 gw = *(const u32x4*)(ZG + r * 3072 + seg * 1024 + col0 + bj * HALF);
                    float g[8]; unpack8(gw, g);
                    const f32x4 v0 = acc[ai][bj][m][0], v1 = acc[ai][bj][m][1];
                    u32x4 w; w.x = pk2(g[0] * v0[0], g[1] * v0[1]); w.y = pk2(g[2] * v0[2], g[3] * v0[3]); w.z = pk2(g[4] * v1[0], g[5] * v1[1]); w.w = pk2(g[6] * v1[2], g[7] * v1[3]);
                    *(u32x4*)(Pc + (size_t)seg * TC * D + r * 1024 + col0 + bj * HALF) = w; } }
    }
};
struct EpiPartial {
    static constexpr bool PERM = false, KEEP = false;
    float* PX; int nq;
    DI void operator()(const f32x4 (&acc)[2][2][4][2], const Unit& u, int wr, int wc, int fr, int fq) const {
        const int row0 = u.pm * BM + wr * 64 + fr, col0 = u.pn * BM + wc * 32 + 4 * fq;
        float* base = PX + (size_t)(u.seg * nq + u.q) * TC * D;
#pragma unroll
        for (int ai = 0; ai < 2; ++ai)
#pragma unroll
            for (int m = 0; m < 4; ++m) { float* rp = base + (size_t)(row0 + ai * HALF + m * 16) * D + col0;
#pragma unroll
                for (int bj = 0; bj < 2; ++bj)
#pragma unroll
                    for (int n = 0; n < 2; ++n) *(f32x4*)(rp + bj * HALF + n * 16) = acc[ai][bj][m][n]; }
    }
};
struct EpiFF1 {
    static constexpr bool PERM = true, KEEP = false;
    bf16_t* O;
    DI void operator()(const f32x4 (&acc)[2][2][4][2], const Unit& u, int wr, int wc, int fr, int fq) const {
        const int row0 = u.pm * BM + wr * 64 + fr, col0 = u.pn * BM + wc * 32 + 8 * fq;
#pragma unroll
        for (int ai = 0; ai < 2; ++ai)
#pragma unroll
            for (int m = 0; m < 4; ++m) { bf16_t* rowp = O + (size_t)(row0 + ai * HALF + m * 16) * DFF + col0;
#pragma unroll
                for (int bj = 0; bj < 2; ++bj) { f32x4 v0 = acc[ai][bj][m][0], v1 = acc[ai][bj][m][1];
#pragma unroll
                    for (int j = 0; j < 4; ++j) { const float a = fmaxf(v0[j], 0.f), b = fmaxf(v1[j], 0.f); v0[j] = a * a; v1[j] = b * b; }
                    u32x4 w; w.x = pk2(v0[0], v0[1]); w.y = pk2(v0[2], v0[3]); w.z = pk2(v1[0], v1[1]); w.w = pk2(v1[2], v1[3]);
                    *(u32x4*)(rowp + bj * HALF) = w; } }
    }
};
}

DI void phase_prep(const Args& a, LAS unsigned char* lds) {
    const int tid = tidx(), bid = bidx(), G = gridDim.x;
    if (bid == (1 % G)) {
        float* cosT = (float*)(wsp() + WS_ROPE); float* sinT = cosT + 1024;
        for (int i = tid; i < 1024; i += 512) { const int pos = i >> 4, f = i & 15; const float inv = powf(10000.0f, -(float)f / 16.0f); const float ang = (float)pos * inv;
            cosT[i] = cosf(ang); sinT[i] = sinf(ang); }
    }
    LAS float* cond = (LAS float*)lds;
    LAS float* red = (LAS float*)(lds + 20480);
    for (int i = tid; i < 5 * 1024; i += 512) { const int g = i >> 10, k = i & 1023; const float v = g < 4 ? inp<1>()[g * 1024 + k] : inp<3>()[k]; cond[i] = v * sigmoidf_(v); }
    __syncthreads();
    float* mod = (float*)(wsp() + WS_MOD);
    for (int it = bid; it < DEPTH * 96; it += G) {
        const int l = it / 96, cb = it % 96, c = tid & 63, kg = tid >> 6, col = cb * 64 + c;
        const float* w = inp<4>() + (size_t)l * D * 6144 + col;
        float acc[5] = {0.f, 0.f, 0.f, 0.f, 0.f};
#pragma unroll 8
        for (int k = kg * 128; k < kg * 128 + 128; ++k) { const float wv = w[(size_t)k * 6144];
#pragma unroll
            for (int g = 0; g < 5; ++g) acc[g] += cond[g * 1024 + k] * wv; }
#pragma unroll
        for (int g = 0; g < 5; ++g) red[(kg * 5 + g) * 64 + c] = acc[g];
        __syncthreads();
        if (tid < 320) { const int g = tid >> 6; float s = inp<5>()[l * 6144 + col];
#pragma unroll
            for (int k2 = 0; k2 < 8; ++k2) s += red[(k2 * 5 + g) * 64 + c];
            mod[(size_t)(l * 5 + g) * 6144 + col] = s; }
        __syncthreads();
    }
}

DI void transpose_item(const float* W, int K, int N, bf16_t* WT, LAS float* scr, int item, int lane) {
    const int nblk = N / 32, kb = item / nblk, nb = item % nblk, k0 = 64 * kb, n0 = 32 * nb;
#pragma unroll 8
    for (int i = 0; i < 32; ++i) { const int kk = 2 * i + (lane >> 5); scr[kk * 33 + (lane & 31)] = W[(size_t)(k0 + kk) * N + n0 + (lane & 31)]; }
    asm volatile("s_waitcnt lgkmcnt(0)" ::: "memory");
    const int c = lane & 7;
#pragma unroll
    for (int j = 0; j < 4; ++j) { const int n = (lane >> 3) + 8 * j; const LAS float* s = scr + (8 * c) * 33 + n;
        u32x4 o; o.x = pk2(s[0 * 33], s[1 * 33]); o.y = pk2(s[2 * 33], s[3 * 33]); o.z = pk2(s[4 * 33], s[5 * 33]); o.w = pk2(s[6 * 33], s[7 * 33]);
        *(u32x4*)(WT + (size_t)(n0 + n) * K + k0 + 8 * c) = o; }
    asm volatile("s_waitcnt lgkmcnt(0)" ::: "memory");
}


DI void transpose_tile(const float* W, int K, int N, bf16_t* WT, LAS float* scr, int item, int tid) {
    const int nblk = N / 256, kb = item / nblk, nb = item % nblk, k0 = 64 * kb, n0 = 256 * nb;
#pragma unroll
    for (int it = 0; it < 8; ++it) { const int idx = it * 512 + tid, kk = idx >> 6, c4 = idx & 63;
        const f32x4 v = *(const f32x4*)(W + (size_t)(k0 + kk) * N + n0 + c4 * 4);
        LAS float* d = scr + kk * 257 + c4 * 4; d[0] = v.x; d[1] = v.y; d[2] = v.z; d[3] = v.w; }
    __syncthreads();
#pragma unroll
    for (int it = 0; it < 4; ++it) { const int idx = it * 512 + tid, n = idx >> 3, c = idx & 7; const LAS float* sp = scr + (8 * c) * 257 + n;
        u32x4 o; o.x = pk2(sp[0], sp[257]); o.y = pk2(sp[2 * 257], sp[3 * 257]); o.z = pk2(sp[4 * 257], sp[5 * 257]); o.w = pk2(sp[6 * 257], sp[7 * 257]);
        *(u32x4*)(WT + (size_t)(n0 + n) * K + k0 + 8 * c) = o; }
    __syncthreads();
}

DI void convert_weights(int l, size_t wtoff, LAS unsigned char* lds, int rank, int nranks, int tid) {
    LAS float* scr = (LAS float*)lds;
    unsigned char* wb = wsp() + wtoff;
    constexpr int I_IN = 16 * (INW / 256), I_BR = 16 * 4, I_FF1 = 16 * (DFF / 256), I_FF2 = 64 * 4;
    constexpr int NIT = I_IN + 4 * I_BR + I_FF1 + I_FF2;
    for (int it = rank; it < NIT; it += nranks) {
        int r = it;
        if (r < I_IN) { transpose_tile(inp<7>() + (size_t)l * D * INW, D, INW, (bf16_t*)(wb + WS_WIN), scr, r, tid); continue; } r -= I_IN;
        if (r < 3 * I_BR) { const int sg = r / I_BR; transpose_tile(inp<22>() + ((size_t)l * 3 + sg) * D * D, D, D, (bf16_t*)(wb + WS_WBR) + (size_t)sg * D * D, scr, r % I_BR, tid); continue; } r -= 3 * I_BR;
        if (r < I_BR) { transpose_tile(inp<23>() + (size_t)l * D * D, D, D, (bf16_t*)(wb + WS_WOUT), scr, r, tid); continue; } r -= I_BR;
        if (r < I_FF1) { transpose_tile(inp<25>() + (size_t)l * D * DFF, D, DFF, (bf16_t*)(wb + WS_WFF1), scr, r, tid); continue; } r -= I_FF1;
        transpose_tile(inp<26>() + (size_t)l * DFF * D, DFF, D, (bf16_t*)(wb + WS_WFF2), scr, r, tid);
    }
}

DI void phase_norm(const Args& a, LAS unsigned char* lds, int l, int which) {
    const int tid = tidx(), lane = tid & 63, wave = tid >> 6, G = gridDim.x;
    const int gw = bidx() * 8 + wave, NGW = G * 8;
    if (which == 0 && l == 0) convert_weights(0, 0, lds, bidx(), G, tid);
    const bool from_in = (l == 0 && which == 0);
    const float* xc_src = from_in ? inp<2>() : (const float*)(wsp() + WS_XC);
    const float* xl_src = from_in ? inp<0>() : (const float*)outp();
    const float* gn = (which == 0 ? inp<6>() : inp<24>()) + l * D;
    const float* mod = (const float*)(wsp() + WS_MOD) + (size_t)l * 5 * 6144 + (which ? 3 * 1024 : 0);
    bf16_t* H = (bf16_t*)(wsp() + WS_H);
    const int rstart = (which == 1 && l == DEPTH - 1) ? TC : 0;
    const int npart = which == 1 ? 12 : (l > 0 ? 4 : 0);
    const float* pgate = (const float*)(wsp() + WS_MOD) + (size_t)((which == 1 ? l : l - 1) * 5 + 4) * 6144 + (which == 1 ? 2 : 5) * 1024;
    for (int r = rstart + gw; r < T; r += NGW) {
        const float* xrow = r < TC ? xc_src + (size_t)r * D : xl_src + (size_t)(r - TC) * D;
        const int grp = r < TC ? 4 : ((r - TC) >> 12);
        const float* sh = mod + grp * 6144; const float* sc = sh + 1024;
        f32x4 v[4]; float ss = 0.f;
#pragma unroll
        for (int j = 0; j < 4; ++j) v[j] = *((const f32x4*)xrow + lane + 64 * j);
        if (r < TC && npart > 0) {
            const float* px = (const float*)(wsp() + WS_PX) + (size_t)r * D;
#pragma unroll
            for (int j = 0; j < 4; ++j) { f32x4 sum = *((const f32x4*)px + lane + 64 * j);
                for (int pi = 1; pi < npart; ++pi) sum += *((const f32x4*)(px + (size_t)pi * TC * D) + lane + 64 * j);
                v[j] += *((const f32x4*)pgate + lane + 64 * j) * sum;
                *((f32x4*)(wsp() + WS_XC + (size_t)r * D * 4) + lane + 64 * j) = v[j]; }
        }
#pragma unroll
        for (int j = 0; j < 4; ++j) ss += (v[j].x * v[j].x + v[j].y * v[j].y) + (v[j].z * v[j].z + v[j].w * v[j].w);
        const float rstd = 1.0f / sqrtf(wave_sum(ss) * (1.0f / D) + EPS);
        if (from_in && r < TC) {
#pragma unroll
            for (int j = 0; j < 4; ++j) *((f32x4*)(wsp() + WS_XC + (size_t)r * D * 4) + lane + 64 * j) = v[j]; }
#pragma unroll
        for (int j = 0; j < 4; ++j) { const int k = (lane + 64 * j) * 4; const f32x4 g = *(const f32x4*)(gn + k), s1 = *(const f32x4*)(sc + k), s0 = *(const f32x4*)(sh + k);
            const f32x4 y = (v[j] * rstd * g) * (s1 + 1.0f) + s0;
            u32x2 o; o.x = pk2(y.x, y.y); o.y = pk2(y.z, y.w);
            *(u32x2*)(H + (size_t)r * D + k) = o; }
    }
}

DI float neg_expm1(float x) {
    const float small = -x * (1.0f + x * (0.5f + x * (0.16666667f + x * 0.041666667f)));
    const float big = 1.0f - fexp2(x * LOG2E);
    return x > -0.1f ? small : big;
}
DI void scan_item(const Args& a, LAS unsigned char* lds, int l, int b, int cb, int hc) {
    const int tid = tidx(), half = tid >> 8, ht = tid & 255, lane = tid & 63, hw = (tid >> 6) & 3, l15 = lane & 15, l4 = lane >> 4;
    LAS unsigned char* hb = lds + half * 63488;
    LAS bf16_t* WaT = (LAS bf16_t*)hb;
    LAS bf16_t* WxT = (LAS bf16_t*)(hb + 4608);
    LAS bf16_t* xcb = (LAS bf16_t*)(hb + 9216);
    LAS float* As = (LAS float*)(hb + 27648);
    LAS float* Us = (LAS float*)(hb + 44032);
    LAS float* carry = (LAS float*)(hb + 60416);
    LAS float* segP = (LAS float*)(hb + 60672);
    LAS float* segH = (LAS float*)(hb + 61696);
    LAS float* prm = (LAS float*)(hb + 62720);
    const bf16_t* ZA = (const bf16_t*)(wsp() + WS_ZA); bf16_t* YA = (bf16_t*)(wsp() + WS_H);
    const int tokA = ht >> 2, c0A = (ht & 3) * 16;
    float cw[4][16], cbias[16];
    {
        const size_t wofs = (((size_t)l * 2 + half) * 16 + cb) * 4096;
        const float* wa = inp<10>() + wofs; const float* wx = inp<12>() + wofs;
        for (int i = ht; i < 2048; i += 256) { const int ii = i >> 5, jj = i & 31; WaT[jj * 72 + ii] = f2bf(wa[ii * 64 + hc * 32 + jj]); WxT[jj * 72 + ii] = f2bf(wx[ii * 64 + hc * 32 + jj]); }
        if (ht < 32) { const int ch = cb * 64 + hc * 32 + ht; const size_t po = ((size_t)l * 2 + half) * D + ch;
            prm[ht] = inp<11>()[po]; prm[32 + ht] = inp<13>()[po];
            const float lam = inp<14>()[po]; prm[64 + ht] = 8.0f * log1pf(expf(-lam));
            carry[ht] = 0.f; }
        const float* cwp = inp<8>() + (size_t)l * 4 * D + cb * 64 + c0A; const float* cbp = inp<9>() + (size_t)l * D + cb * 64 + c0A;
#pragma unroll
        for (int j = 0; j < 16; ++j) { cbias[j] = cbp[j];
#pragma unroll
            for (int k = 0; k < 4; ++k) cw[k][j] = cwp[(size_t)k * D + j]; }
    }
    __syncthreads();
#define LBAR() do { asm volatile("s_waitcnt lgkmcnt(0)" ::: "memory"); __builtin_amdgcn_s_barrier(); asm volatile("" ::: "memory"); } while (0)
#define SCAN_GID(st_) ((half == 0) ? (st_) : ((st_) < 2 ? 1 - (st_) : 35 - (st_)))
#define SCAN_LOAD(st_) do { const int gid_ = SCAN_GID(st_); const bool ic_ = gid_ < 2; const int ck_ = ic_ ? gid_ : gid_ - 2; const int L_ = ic_ ? CTX : SEQ; const int rb_ = ic_ ? b * CTX : TC + b * SEQ; \
        _Pragma("unroll") for (int t2 = 0; t2 < 2; ++t2) _Pragma("unroll") for (int k = 0; k < 4; ++k) { const int ts = ck_ * 128 + tokA + 64 * t2 + k - 2; tp[t2][k][0] = (u32x4){0u, 0u, 0u, 0u}; tp[t2][k][1] = (u32x4){0u, 0u, 0u, 0u}; \
            if (ts >= 0 && ts < L_) { const bf16_t* p = ZA + (size_t)(rb_ + ts) * D + cb * 64 + c0A; tp[t2][k][0] = *(const u32x4*)p; tp[t2][k][1] = *(const u32x4*)(p + 8); } } } while (0)
    u32x4 tp[2][4][2];
    SCAN_LOAD(0);
    const int tokE = ht >> 1, c0E = (ht & 1) * 16;
    for (int step = 0; step < 34; ++step) {
        const int gid = SCAN_GID(step); const bool isctx = gid < 2; const int chunk = isctx ? gid : gid - 2; const int rowbase = isctx ? b * CTX : TC + b * SEQ;
        const bool fwd_first = isctx ? (gid == 0) : (gid <= 17);
        const bool second = (half == 0) ? !fwd_first : fwd_first;
#pragma unroll
        for (int t2 = 0; t2 < 2; ++t2) {
            float t0[8], t1[8];
#pragma unroll
            for (int j = 0; j < 8; ++j) { t0[j] = cbias[j]; t1[j] = cbias[8 + j]; }
#pragma unroll
            for (int k = 0; k < 4; ++k) { float x0[8], x1[8]; unpack8(tp[t2][k][0], x0); unpack8(tp[t2][k][1], x1);
#pragma unroll
                for (int j = 0; j < 8; ++j) { t0[j] += cw[k][j] * x0[j]; t1[j] += cw[k][8 + j] * x1[j]; } }
            *(LAS u32x4*)(xcb + (tokA + 64 * t2) * 72 + c0A) = pack8(t0); *(LAS u32x4*)(xcb + (tokA + 64 * t2) * 72 + c0A + 8) = pack8(t1);
        }
        LBAR();
#pragma unroll
        for (int mt = 0; mt < 2; ++mt) {
            f32x4 ar[2], ai[2];
#pragma unroll
            for (int nt = 0; nt < 2; ++nt) { ar[nt] = (f32x4){0.f, 0.f, 0.f, 0.f}; ai[nt] = (f32x4){0.f, 0.f, 0.f, 0.f}; }
#pragma unroll
            for (int s = 0; s < 2; ++s) { const bf16x8 xa = *(const LAS bf16x8*)(xcb + (32 * hw + 16 * mt + l15) * 72 + 32 * s + 8 * l4);
#pragma unroll
                for (int nt = 0; nt < 2; ++nt) { const bf16x8 wa = *(const LAS bf16x8*)(WaT + (16 * nt + l15) * 72 + 32 * s + 8 * l4), wx = *(const LAS bf16x8*)(WxT + (16 * nt + l15) * 72 + 32 * s + 8 * l4);
                    ar[nt] = __builtin_amdgcn_mfma_f32_16x16x32_bf16(xa, wa, ar[nt], 0, 0, 0); ai[nt] = __builtin_amdgcn_mfma_f32_16x16x32_bf16(xa, wx, ai[nt], 0, 0, 0); } }
#pragma unroll
            for (int nt = 0; nt < 2; ++nt) { const int j = 16 * nt + l15; const float ba = prm[j], bx = prm[32 + j], sp8 = prm[64 + j];
#pragma unroll
                for (int i = 0; i < 4; ++i) { const int tok = 32 * hw + 16 * mt + 4 * l4 + i;
                    const float r = sigmoidf_(ar[nt][i] + ba), ig = sigmoidf_(ai[nt][i] + bx);
                    const float la = -r * sp8; const float av = fexp2(la * LOG2E); const float mult = __builtin_amdgcn_sqrtf(fmaxf(neg_expm1(2.0f * la), 0.f));
                    const float x = bf1(xcb[tok * 72 + hc * 32 + j]);
                    As[tok * 32 + j] = av; Us[tok * 32 + j] = x * ig * mult; } }
        }
        asm volatile("s_waitcnt vmcnt(0)" ::: "memory");
        LBAR();
        bf16_t* outp_ = YA + (size_t)(rowbase + chunk * 128 + tokE) * D + cb * 64 + hc * 32 + c0E;
        unsigned long long q0 = 0, q1 = 0, q2 = 0, q3 = 0;
        if (second) { const unsigned long long* pq = (const unsigned long long*)outp_;
            q0 = __hip_atomic_load(pq, __ATOMIC_RELAXED, __HIP_MEMORY_SCOPE_AGENT); q1 = __hip_atomic_load(pq + 1, __ATOMIC_RELAXED, __HIP_MEMORY_SCOPE_AGENT);
            q2 = __hip_atomic_load(pq + 2, __ATOMIC_RELAXED, __HIP_MEMORY_SCOPE_AGENT); q3 = __hip_atomic_load(pq + 3, __ATOMIC_RELAXED, __HIP_MEMORY_SCOPE_AGENT); }
        if (step + 1 < 34) SCAN_LOAD(step + 1);
        const int c = ht & 31, seg = ht >> 5;
        {
            float h = 0.f, P = 1.f;
#pragma unroll 8
            for (int p = seg * 16; p < seg * 16 + 16; ++p) { const int tok = half ? 127 - p : p; const float av = As[tok * 32 + c], uv = Us[tok * 32 + c];
                h = av * h + uv; P *= av; Us[tok * 32 + c] = h; As[tok * 32 + c] = P; }
            segH[seg * 32 + c] = h; segP[seg * 32 + c] = P;
        }
        LBAR();
        {
            float cin = carry[(step & 1) * 32 + c];
            for (int s2 = 0; s2 < seg; ++s2) cin = segP[s2 * 32 + c] * cin + segH[s2 * 32 + c];
            float hl = 0.f;
#pragma unroll 8
            for (int p = seg * 16; p < seg * 16 + 16; ++p) { const int tok = half ? 127 - p : p; hl = Us[tok * 32 + c] + As[tok * 32 + c] * cin; Us[tok * 32 + c] = hl; }
            if (seg == 7) carry[((step + 1) & 1) * 32 + c] = hl;
        }
        LBAR();
        {
            float o0[8], o1[8];
#pragma unroll
            for (int j = 0; j < 8; ++j) { o0[j] = Us[tokE * 32 + c0E + j]; o1[j] = Us[tokE * 32 + c0E + 8 + j]; }
            if (second) { float e0[8], e1[8]; u32x4 wA, wB; wA.x = (unsigned)q0; wA.y = (unsigned)(q0 >> 32); wA.z = (unsigned)q1; wA.w = (unsigned)(q1 >> 32); wB.x = (unsigned)q2; wB.y = (unsigned)(q2 >> 32); wB.z = (unsigned)q3; wB.w = (unsigned)(q3 >> 32);
                unpack8(wA, e0); unpack8(wB, e1);
#pragma unroll
                for (int j = 0; j < 8; ++j) { o0[j] += e0[j]; o1[j] += e1[j]; } }
            *(u32x4*)outp_ = pack8(o0); *(u32x4*)(outp_ + 8) = pack8(o1);
        }
    }
    asm volatile("s_waitcnt vmcnt(0)" ::: "memory");
#undef SCAN_GID
#undef SCAN_LOAD
}

DI void sgu_item(const Args& a, LAS unsigned char* lds, int l, int tc) {
    const int tid = tidx(), lane = tid & 63, w = tid >> 6, hh = lane >> 5, r32 = lane & 31;
    const int row0 = tc < 8 ? (tc >> 1) * CTX + (tc & 1) * 128 : TC + ((tc - 8) >> 5) * SEQ + ((tc - 8) & 31) * 128;
    LAS bf16_t* Wl = (LAS bf16_t*)lds;
    LAS bf16_t* VnT = (LAS bf16_t*)(lds + 34816);
    LAS float* st = (LAS float*)(lds + 69632);
    const bf16_t* ZV = (const bf16_t*)(wsp() + WS_ZV); bf16_t* ZU = (bf16_t*)(wsp() + WS_ZU);
    for (int t = w * 16; t < w * 16 + 16; ++t) {
        const bf16_t* p = ZV + (size_t)(row0 + t) * D + lane * 16;
        float x0[8], x1[8]; unpack8(*(const u32x4*)p, x0); unpack8(*(const u32x4*)(p + 8), x1);
        float s = 0.f;
#pragma unroll
        for (int j = 0; j < 8; ++j) s += x0[j] + x1[j];
        const float mean = wave_sum(s) * (1.0f / D); float q = 0.f;
#pragma unroll
        for (int j = 0; j < 8; ++j) { const float d0 = x0[j] - mean, d1 = x1[j] - mean; q += d0 * d0 + d1 * d1; }
        const float var = wave_sum(q) * (1.0f / D);
        if (lane == 0) { st[t * 2] = mean; st[t * 2 + 1] = 1.0f / sqrtf(var + EPS); }
    }
    __syncthreads();
    for (int g = 0; g < 8; ++g) {
        {
            const float* ws = inp<17>() + ((size_t)l * 8 + g) * 16384;
#pragma unroll
            for (int it = 0; it < 8; ++it) { const int idx = (it * 512 + tid) * 4; const f32x4 v = *(const f32x4*)(ws + idx); const int p = idx >> 7, q = idx & 127;
                u32x2 o; o.x = pk2(v.x, v.y); o.y = pk2(v.z, v.w); *(LAS u32x2*)(Wl + p * 136 + q) = o; }
            const int tok = tid >> 2, c0 = (tid & 3) * 32;
            const float mean = st[tok * 2], rstd = st[tok * 2 + 1];
            const bf16_t* p = ZV + (size_t)(row0 + tok) * D + g * 128 + c0;
            const float* lg = inp<15>() + (size_t)l * D + g * 128 + c0; const float* lb = inp<16>() + (size_t)l * D + g * 128 + c0;
#pragma unroll
            for (int q4 = 0; q4 < 4; ++q4) { float x[8]; unpack8(*(const u32x4*)(p + q4 * 8), x);
                const f32x4 g0 = *(const f32x4*)(lg + q4 * 8), g1 = *(const f32x4*)(lg + q4 * 8 + 4), b0 = *(const f32x4*)(lb + q4 * 8), b1 = *(const f32x4*)(lb + q4 * 8 + 4);
#pragma unroll
                for (int j = 0; j < 8; ++j) { const int cc = q4 * 8 + j; const float gg = j < 4 ? g0[j & 3] : g1[j & 3], bb = j < 4 ? b0[j & 3] : b1[j & 3];
                    VnT[(c0 + cc) * 136 + tok] = f2bf((x[j] - mean) * rstd * gg + bb); } }
        }
        __syncthreads();
        {
            const int pt = w >> 1, ch = w & 1;
            f32x16 acc[2];
#pragma unroll
            for (int i = 0; i < 16; ++i) { acc[0][i] = 0.f; acc[1][i] = 0.f; }
#pragma unroll
            for (int s = 0; s < 8; ++s) { const bf16x8 af = *(const LAS bf16x8*)(Wl + (32 * pt + r32) * 136 + 16 * s + 8 * hh);
#pragma unroll
                for (int nt = 0; nt < 2; ++nt) { const bf16x8 bfr = *(const LAS bf16x8*)(VnT + (64 * ch + 32 * nt + r32) * 136 + 16 * s + 8 * hh); acc[nt] = MFMA32(af, bfr, acc[nt]); } }
            const float* sb = inp<18>() + ((size_t)l * 8 + g) * 128 + 32 * pt + 4 * hh;
            f32x4 sbv[4];
#pragma unroll
            for (int i4 = 0; i4 < 4; ++i4) sbv[i4] = *(const f32x4*)(sb + 8 * i4);
            __syncthreads();
            LAS bf16_t* Mx = Wl;
#pragma unroll
            for (int nt = 0; nt < 2; ++nt)
#pragma unroll
                for (int i = 0; i < 16; ++i) { const int pp = 32 * pt + (i & 3) + 8 * (i >> 2) + 4 * hh, c = 64 * ch + 32 * nt + r32;
                    Mx[pp * 136 + c] = f2bf(acc[nt][i] + sbv[i >> 2][i & 3]); }
            __syncthreads();
            const int pr = tid >> 2, cq = (tid & 3) * 32;
            bf16_t* up = ZU + (size_t)(row0 + pr) * D + g * 128 + cq;
#pragma unroll
            for (int q4 = 0; q4 < 4; ++q4) { float uu[8], mm[8]; unpack8(*(const u32x4*)(up + q4 * 8), uu); unpack8(*(const LAS u32x4*)(Mx + pr * 136 + cq + q4 * 8), mm);
#pragma unroll
                for (int j = 0; j < 8; ++j) uu[j] *= mm[j];
                *(u32x4*)(up + q4 * 8) = pack8(uu); }
        }
        __syncthreads();
    }
}

DI void attn_tile(const LAS bf16_t* Ks, const LAS bf16_t* Vt, int kb, const bf16x8 (&qf)[2][4], float (&m)[2], float (&ls)[2], f32x16 (&o)[2][2],
                  int r32, int hh, bool masked, int qloc0, int kv_lo, int kv_hi) {
    bf16x8 kf[4];
#pragma unroll
    for (int s = 0; s < 4; ++s) kf[s] = *(const LAS bf16x8*)(Ks + (kb + r32) * 72 + 16 * s + 8 * hh);
    bf16x8 pf[2][2];
#pragma unroll
    for (int qt = 0; qt < 2; ++qt) {
        f32x16 sc;
#pragma unroll
        for (int i = 0; i < 16; ++i) sc[i] = 0.f;
#pragma unroll
        for (int s = 0; s < 4; ++s) sc = MFMA32(kf[s], qf[qt][s], sc);
        if (masked) { const int ql = qloc0 + 32 * qt + r32;
#pragma unroll
            for (int i = 0; i < 16; ++i) { const int key = kb + (i & 3) + 8 * (i >> 2) + 4 * hh; const int df = key - 128 - ql;
                const bool ok = (df >= -128) && (df <= 128) && (key >= kv_lo) && (key < kv_hi); sc[i] = ok ? sc[i] : -1e30f; } }
        float mx = sc[0];
#pragma unroll
        for (int i = 1; i < 16; ++i) mx = fmaxf(mx, sc[i]);
        mx = fmaxf(mx, __shfl_xor(mx, 32));
        const float mn = fmaxf(m[qt], mx); const float alpha = fexp2(m[qt] - mn); m[qt] = mn;
        float p[16]; float rs = 0.f;
#pragma unroll
        for (int i = 0; i < 16; ++i) { p[i] = fexp2(sc[i] - mn); rs += p[i]; }
        ls[qt] = ls[qt] * alpha + rs;
        if (__any(alpha != 1.0f)) {
#pragma unroll
            for (int i = 0; i < 16; ++i) { o[qt][0][i] *= alpha; o[qt][1][i] *= alpha; } }
#pragma unroll
        for (int ks = 0; ks < 2; ++ks) { u32x4 w; w.x = pk2(p[8 * ks], p[8 * ks + 1]); w.y = pk2(p[8 * ks + 2], p[8 * ks + 3]); w.z = pk2(p[8 * ks + 4], p[8 * ks + 5]); w.w = pk2(p[8 * ks + 6], p[8 * ks + 7]);
            pf[qt][ks] = __builtin_bit_cast(bf16x8, w); }
    }
#pragma unroll
    for (int dt = 0; dt < 2; ++dt)
#pragma unroll
        for (int ks = 0; ks < 2; ++ks) { const LAS bf16_t* vp = Vt + (32 * dt + r32) * 392 + kb + 16 * ks + 4 * hh;
            const u32x2 lo = *(const LAS u32x2*)vp, hi = *(const LAS u32x2*)(vp + 8);
            u32x4 w; w.x = lo.x; w.y = lo.y; w.z = hi.x; w.w = hi.y; const bf16x8 vf = __builtin_bit_cast(bf16x8, w);
#pragma unroll
            for (int qt = 0; qt < 2; ++qt) o[qt][dt] = MFMA32(vf, pf[qt][ks], o[qt][dt]); }
}

template <bool ctxstage> DI void attn_stage(const Args& a, LAS bf16_t* Ks, LAS bf16_t* Vt, int l, int b, int n, int kvh) {
    const int tid = tidx(), e = tid & 7;
    const bf16_t* ZK = (const bf16_t*)(wsp() + WS_ZK); const bf16_t* ZVV = (const bf16_t*)(wsp() + WS_ZVV);
    const float* cosT = (const float*)(wsp() + WS_ROPE); const float* sinT = cosT + 1024;
    const float* kg = inp<20>() + l * 64 + e * 8;
    float kgv[8];
#pragma unroll
    for (int j = 0; j < 8; ++j) kgv[j] = kg[j];
    constexpr int NP = 2;
    for (int pg = 0; pg < (ctxstage ? 2 : 3); ++pg) {
    u32x4 kwa[NP], vwa[NP];
#pragma unroll
    for (int ps = 0; ps < NP; ++ps) {
        const int key = (pg * NP + ps) * 64 + (tid >> 3);
        int kt = 0, row; bool valid = true;
        if (ctxstage) row = b * CTX + key; else { kt = n * 128 - 128 + key; valid = (kt >= 0) && (kt < SEQ); kt = kt < 0 ? 0 : (kt >= SEQ ? SEQ - 1 : kt); row = TC + b * SEQ + kt; }
        kwa[ps] = (u32x4){0u, 0u, 0u, 0u}; vwa[ps] = (u32x4){0u, 0u, 0u, 0u};
        if (valid) { kwa[ps] = *(const u32x4*)(ZK + (size_t)row * 256 + kvh * 64 + e * 8); vwa[ps] = *(const u32x4*)(ZVV + (size_t)row * 256 + kvh * 64 + e * 8); }
    }
#pragma unroll
    for (int ps = 0; ps < NP; ++ps) {
        const int key = (pg * NP + ps) * 64 + (tid >> 3);
        int kt = 0;
        if (!ctxstage) { kt = n * 128 - 128 + key; kt = kt < 0 ? 0 : (kt >= SEQ ? SEQ - 1 : kt); }
        const u32x4 kw = kwa[ps], vw = vwa[ps];
        float x[8]; unpack8(kw, x);
        float ss = 0.f;
#pragma unroll
        for (int j = 0; j < 8; ++j) ss += x[j] * x[j];
        ss += __shfl_xor(ss, 1); ss += __shfl_xor(ss, 2); ss += __shfl_xor(ss, 4);
        const float rstd = 1.0f / sqrtf(ss * (1.0f / 64.0f) + EPS);
#pragma unroll
        for (int j = 0; j < 8; ++j) x[j] = x[j] * rstd * kgv[j];
        if (!ctxstage) {
            const int pos = (e >> 2) ? (kt & 63) : (kt >> 6); const bool second = (e >> 1) & 1; const int f0 = 8 * (e & 1);
#pragma unroll
            for (int j = 0; j < 8; ++j) { const float pr = __shfl_xor(x[j], 2); const float cs = cosT[pos * 16 + f0 + j], sn = sinT[pos * 16 + f0 + j];
                x[j] = second ? (x[j] * cs + pr * sn) : (x[j] * cs - pr * sn); }
        }
        *(LAS u32x4*)(Ks + key * 72 + e * 8) = pack8(x);
        Vt[(e * 8 + 0) * 392 + key] = (bf16_t)(vw.x & 0xffffu); Vt[(e * 8 + 1) * 392 + key] = (bf16_t)(vw.x >> 16);
        Vt[(e * 8 + 2) * 392 + key] = (bf16_t)(vw.y & 0xffffu); Vt[(e * 8 + 3) * 392 + key] = (bf16_t)(vw.y >> 16);
        Vt[(e * 8 + 4) * 392 + key] = (bf16_t)(vw.z & 0xffffu); Vt[(e * 8 + 5) * 392 + key] = (bf16_t)(vw.z >> 16);
        Vt[(e * 8 + 6) * 392 + key] = (bf16_t)(vw.w & 0xffffu); Vt[(e * 8 + 7) * 392 + key] = (bf16_t)(vw.w >> 16);
    }
    }
}

DI void attn_item(const Args& a, LAS unsigned char* lds, int l, int kind, int b, int n, int kvh) {
    const int tid = tidx(), lane = tid & 63, w = tid >> 6, hh = lane >> 5, r32 = lane & 31;
    const int g = w >> 1, qhalf = w & 1, h = kvh * 4 + g, qloc0 = qhalf * 64;
    LAS bf16_t* Ks = (LAS bf16_t*)lds;
    LAS bf16_t* Vt = (LAS bf16_t*)(lds + 55296);
    bf16_t* ZQ = (bf16_t*)(wsp() + WS_ZQ);
    const float* cosT = (const float*)(wsp() + WS_ROPE); const float* sinT = cosT + 1024;
    const float* qg = inp<19>() + l * 64;
    const float SCL = 0.125f * LOG2E;
    bf16x8 qf[2][4];
#pragma unroll
    for (int qt = 0; qt < 2; ++qt) {
        const int qtok = n * 128 + qloc0 + 32 * qt + r32; const int row = kind ? b * CTX + qtok : TC + b * SEQ + qtok;
        const bf16_t* qp = ZQ + (size_t)row * D + h * 64 + 8 * hh;
        float v[4][8]; float ss = 0.f;
#pragma unroll
        for (int s = 0; s < 4; ++s) { unpack8(*(const u32x4*)(qp + 16 * s), v[s]);
#pragma unroll
            for (int j = 0; j < 8; ++j) ss += v[s][j] * v[s][j]; }
        ss += __shfl_xor(ss, 32);
        const float rstd = 1.0f / sqrtf(ss * (1.0f / 64.0f) + EPS);
#pragma unroll
        for (int s = 0; s < 4; ++s)
#pragma unroll
            for (int j = 0; j < 8; ++j) v[s][j] = v[s][j] * rstd * qg[16 * s + 8 * hh + j];
        if (!kind) { const int prow = qtok >> 6, pcol = qtok & 63;
#pragma unroll
            for (int j = 0; j < 8; ++j) { const int f = 8 * hh + j;
                const float c0 = cosT[prow * 16 + f], s0 = sinT[prow * 16 + f], c1 = cosT[pcol * 16 + f], s1 = sinT[pcol * 16 + f];
                const float t1 = v[0][j], t2 = v[1][j]; v[0][j] = t1 * c0 - t2 * s0; v[1][j] = t2 * c0 + t1 * s0;
                const float t3 = v[2][j], t4 = v[3][j]; v[2][j] = t3 * c1 - t4 * s1; v[3][j] = t4 * c1 + t3 * s1; } }
#pragma unroll
        for (int s = 0; s < 4; ++s) {
#pragma unroll
            for (int j = 0; j < 8; ++j) v[s][j] *= SCL;
            qf[qt][s] = __builtin_bit_cast(bf16x8, pack8(v[s])); }
    }
    const float sk = inp<21>()[l * 16 + h] * LOG2E;
    float m[2] = {sk, sk}; float ls[2]; ls[0] = ls[1] = (hh == 0) ? 1.0f : 0.0f;
    f32x16 o[2][2];
#pragma unroll
    for (int i = 0; i < 16; ++i) { o[0][0][i] = 0.f; o[0][1][i] = 0.f; o[1][0][i] = 0.f; o[1][1][i] = 0.f; }
    if (!kind) {
        attn_stage<false>(a, Ks, Vt, l, b, n, kvh);
        __syncthreads();
        const int kv_lo = 128 - n * 128 > 0 ? 128 - n * 128 : 0; const int kv_hi = (SEQ - n * 128 + 128) < 384 ? (SEQ - n * 128 + 128) : 384;
        int t_lo = qhalf ? 2 : 0, t_hi = qhalf ? 12 : 10;
        if (t_lo < (kv_lo >> 5)) t_lo = kv_lo >> 5;
        if (t_hi > (kv_hi >> 5)) t_hi = kv_hi >> 5;
        for (int t = t_lo; t < t_hi; ++t) { const int kb = 32 * t; const bool interior = (kb >= qloc0 + 63) && (kb <= qloc0 + 225) && (kb >= kv_lo) && (kb + 32 <= kv_hi);
            attn_tile(Ks, Vt, kb, qf, m, ls, o, r32, hh, !interior, qloc0, kv_lo, kv_hi); }
        __syncthreads();
    }
    attn_stage<true>(a, Ks, Vt, l, b, n, kvh);
    __syncthreads();
    for (int t = 0; t < 8; ++t) attn_tile(Ks, Vt, 32 * t, qf, m, ls, o, r32, hh, false, qloc0, 0, 256);
#pragma unroll
    for (int qt = 0; qt < 2; ++qt) {
        const float lt = ls[qt] + __shfl_xor(ls[qt], 32); const float inv = 1.0f / lt;
        const int qtok = n * 128 + qloc0 + 32 * qt + r32; const int row = kind ? b * CTX + qtok : TC + b * SEQ + qtok;
        bf16_t* op = ZQ + (size_t)row * D + h * 64 + 4 * hh;
#pragma unroll
        for (int dt = 0; dt < 2; ++dt)
#pragma unroll
            for (int q4 = 0; q4 < 4; ++q4) { u32x2 wv; wv.x = pk2(o[qt][dt][4 * q4] * inv, o[qt][dt][4 * q4 + 1] * inv); wv.y = pk2(o[qt][dt][4 * q4 + 2] * inv, o[qt][dt][4 * q4 + 3] * inv);
                *(u32x2*)(op + 32 * dt + 8 * q4) = wv; }
    }
}

DI void phase_mix(const Args& a, LAS unsigned char* lds, int l) {
    const int tid = tidx();
    const bool last = (l == DEPTH - 1);
    unsigned* ctr = (unsigned*)(wsp() + WS_CTL) + l;
    LAS int* slot = (LAS int*)(lds + LDS_MISC);
    const int n_scan = 128, n_attl = 512, n_attc = last ? 0 : 32, n_sgu = last ? 128 : 136;
    const int total = n_scan + n_attl + n_attc + n_sgu;
    for (;;) {
        __syncthreads();
        if (tid == 0) *slot = (int)atomicAdd(ctr, 1u);
        __syncthreads();
        int it = *slot;
        if (it >= total) break;
#ifndef NO_SCAN
#ifdef PROBE_K
        const unsigned long long pt0 = __builtin_amdgcn_s_memrealtime();
#define PT_END(k, mx) do { if (tid == 0) { const unsigned dt = (unsigned)(__builtin_amdgcn_s_memrealtime() - pt0); if (mx) atomicMax((unsigned*)(wsp() + WS_CTL) + 128 + (k), dt); else atomicAdd((unsigned*)(wsp() + WS_CTL) + 128 + (k), dt); } } while (0)
#else
#define PT_END(k, mx) do {} while (0)
#endif
        if (it < n_scan) { scan_item(a, lds, l, it >> 5, (it >> 1) & 15, it & 1); PT_END(0, 1); continue; }
#endif
        it -= n_scan;
#ifndef NO_ATT
        if (it < n_attl) { attn_item(a, lds, l, 0, it >> 7, (it >> 2) & 31, it & 3); PT_END(1, 0); continue; }
#endif
        it -= n_attl;
#ifndef NO_ATT
        if (it < n_attc) { attn_item(a, lds, l, 1, it >> 3, (it >> 2) & 1, it & 3); PT_END(3, 0); continue; }
#endif
        it -= n_attc;
#ifndef NO_SGU
        sgu_item(a, lds, l, last ? it + 8 : it);
#endif
        PT_END(2, 0);
    }
}


DI void grid_barrier(unsigned* bar, unsigned target) {
    asm volatile("s_waitcnt vmcnt(0) lgkmcnt(0)" ::: "memory");
    __syncthreads();
    if (threadIdx.x == 0) {
        __builtin_amdgcn_fence(__ATOMIC_RELEASE, "agent");
        __hip_atomic_fetch_add(bar, 1u, __ATOMIC_RELAXED, __HIP_MEMORY_SCOPE_AGENT);
        while (__hip_atomic_load(bar, __ATOMIC_RELAXED, __HIP_MEMORY_SCOPE_AGENT) < target) __builtin_amdgcn_s_sleep(2);
        __builtin_amdgcn_fence(__ATOMIC_ACQUIRE, "agent");
    }
    __syncthreads();
}


#ifdef DBG_STOP
DI void dbg_dump(int which) {
    unsigned char* ws = wsp(); float* out = outp();
    const size_t n = (size_t)TL * D, stride = (size_t)gridDim.x * 512;
    const bf16_t* H = (const bf16_t*)(ws + WS_H); const bf16_t* MG = (const bf16_t*)(ws + WS_MG);
    const bf16_t* ZA = (const bf16_t*)(ws + WS_ZA); const bf16_t* ZU = (const bf16_t*)(ws + WS_ZU); const bf16_t* ZV = (const bf16_t*)(ws + WS_ZV); const bf16_t* ZQ = (const bf16_t*)(ws + WS_ZQ);
    const bf16_t* ZK = (const bf16_t*)(ws + WS_ZK); const bf16_t* ZVV = (const bf16_t*)(ws + WS_ZVV); const bf16_t* ZG = (const bf16_t*)(ws + WS_ZG);
    for (size_t i = (size_t)blockIdx.x * 512 + threadIdx.x; i < n; i += stride) {
        float v = 0.f;
        if (which == 1) v = bf1(H[i]) + bf1(H[i + (size_t)TC * D]);
        if (which == 2) v = bf1(ZA[i]) + bf1(ZU[i]) + bf1(ZV[i]) + bf1(ZQ[i]) + bf1(ZG[i]) + bf1(ZG[i + n]) + bf1(ZG[i + 2 * n]) + bf1(ZK[i % ((size_t)T * 256)]) + bf1(ZVV[i % ((size_t)T * 256)]) + bf1(ZA[i + (size_t)TC * D]);
        if (which == 3) v = bf1(H[i + (size_t)TC * D]);
        if (which == 4) v = bf1(ZU[i + (size_t)TC * D]);
        if (which == 5) v = bf1(ZQ[i + (size_t)TC * D]);
        if (which == 6) v = bf1(MG[i + (size_t)TC * D]);
        if (which == 7) v = bf1(H[i]) + bf1(ZU[i]) + bf1(ZQ[i]);
        out[i] = v;
    }
}
#endif

__global__ void __launch_bounds__(512, 2) fwd_megakernel(Args a) {
    extern __shared__ __attribute__((aligned(16))) unsigned char shm[];
    LAS unsigned char* lds = (LAS unsigned char*)shm;
    unsigned* gbar = (unsigned*)(wsp() + WS_CTL) + 64; unsigned nbar = 0;
#define GRID_SYNC() do { ++nbar; grid_barrier(gbar, nbar * (unsigned)G); } while (0)
#ifdef PROBE_K
    unsigned long long pr_prev = __builtin_amdgcn_s_memrealtime(), pr_acc = 0;
#define PROBE(k) do { const unsigned long long now_ = __builtin_amdgcn_s_memrealtime(); if ((k) == PROBE_K || PROBE_K == 99) pr_acc += now_ - pr_prev; pr_prev = now_; } while (0)
#else
#define PROBE(k) do {} while (0)
#endif
    const int G = gridDim.x;
    unsigned char* ws = wsp();

#if !defined(ONLY) || ONLY == 0
    phase_prep(a, lds);
#endif
    GRID_SYNC();
    PROBE(0);
    for (int l = 0; l < DEPTH; ++l) {
        const bool last = (l == DEPTH - 1);
        const int pm0 = last ? 4 : 0, nM = last ? 64 : 68;
        const float* modl = (const float*)(ws + WS_MOD) + (size_t)l * 5 * 6144;
        const size_t wto = (size_t)(l & 1) * WT_BYTES;
#if !defined(ONLY) || ONLY == 1
        phase_norm(a, lds, l, 0);
#endif
        GRID_SYNC();
    PROBE(1);
#if defined(DBG_STOP) && DBG_STOP == 1
        dbg_dump(1); return;
#endif
        {
            pg8::Sched S; S.nM = 68; S.nN = INW / 256; S.nwg = S.nM * S.nN; S.G = G; S.c = bidx(); S.nseg = 1; S.pm0 = 0;
            S.A0 = (const char*)(ws + WS_H); S.d1 = 0; S.d2 = 0; S.B0 = (const char*)(ws + wto + WS_WIN); S.bseg = 0; S.tstep = (size_t)256 * D * 2;
            pg8::EpiIn E{ws};
            pg8::gemm_phase<pg8::EpiIn, pg8::Sched>(lds, D, D, S, E);
        }
        GRID_SYNC();
    PROBE(2);
#if defined(DBG_STOP) && DBG_STOP == 2
        dbg_dump(2); return;
#endif
        phase_mix(a, lds, l);
        GRID_SYNC();
    PROBE(3);
#if defined(DBG_STOP) && DBG_STOP >= 3 && DBG_STOP <= 5
        dbg_dump(DBG_STOP); return;
#endif
#if defined(DBG_STOP) && DBG_STOP == 7
        dbg_dump(7); return;
#endif
        {
            pg8::Sched S; S.nM = 64; S.nN = 4; S.nwg = S.nM * S.nN; S.G = G; S.c = bidx(); S.nseg = 3; S.pm0 = 4;
            S.A0 = (const char*)(ws + WS_H); S.d1 = 2 * SLOT; S.d2 = 2 * SLOT; S.B0 = (const char*)(ws + wto + WS_WBR); S.bseg = (size_t)D * D * 2; S.tstep = (size_t)256 * D * 2;
            pg8::EpiMerge E{(bf16_t*)(ws + WS_MG), (const bf16_t*)(ws + WS_ZG)};
            pg8::gemm_phase<pg8::EpiMerge, pg8::Sched>(lds, D, D, S, E);
        }
        if (!last) {
            pg8::SchedList S; S.n = 48; S.G = G; S.c = bidx(); S.nN = 4; S.nS = 3; S.nQ = 1;
            S.A0 = (const char*)(ws + WS_H); S.a_pm = (size_t)256 * D * 2; S.a_s = 2 * SLOT; S.a_q = 0;
            S.B0 = (const char*)(ws + wto + WS_WBR); S.b_pn = (size_t)256 * D * 2; S.b_s = (size_t)D * D * 2; S.b_q = 0;
            pg8::EpiMergeCtx E{(bf16_t*)(ws + WS_PC), (const bf16_t*)(ws + WS_ZG)};
            pg8::gemm_phase<pg8::EpiMergeCtx, pg8::SchedList>(lds, D, D, S, E);
        }
        GRID_SYNC();
    PROBE(4);
#if defined(DBG_STOP) && DBG_STOP == 6
        dbg_dump(6); return;
#endif
        {
            pg8::Sched S; S.nM = 64; S.nN = 4; S.nwg = S.nM * S.nN; S.G = G; S.c = bidx(); S.nseg = 1; S.pm0 = 4;
            S.A0 = (const char*)(ws + WS_MG); S.d1 = 0; S.d2 = 0; S.B0 = (const char*)(ws + wto + WS_WOUT); S.bseg = 0; S.tstep = (size_t)256 * D * 2;
            pg8::EpiRes E{(const float*)(ws + WS_XC), l == 0 ? inp<0>() : (const float*)outp(), (float*)(ws + WS_XC), outp(), modl + 2 * 1024};
            pg8::gemm_phase<pg8::EpiRes, pg8::Sched>(lds, D, D, S, E);
        }
        if (!last) {
            pg8::SchedList S; S.n = 192; S.G = G; S.c = bidx(); S.nN = 4; S.nS = 3; S.nQ = 4;
            S.A0 = (const char*)(ws + WS_PC); S.a_pm = (size_t)256 * D * 2; S.a_s = (size_t)TC * D * 2; S.a_q = 256 * 2;
            S.B0 = (const char*)(ws + wto + WS_WOUT); S.b_pn = (size_t)256 * D * 2; S.b_s = 0; S.b_q = 256 * 2;
            pg8::EpiPartial E{(float*)(ws + WS_PX), 4};
            pg8::gemm_phase<pg8::EpiPartial, pg8::SchedList>(lds, 256, D, S, E);
        }
        GRID_SYNC();
    PROBE(5);
        phase_norm(a, lds, l, 1);
        GRID_SYNC();
    PROBE(6);
        {
            pg8::Sched S; S.nM = nM; S.nN = DFF / 256; S.nwg = S.nM * S.nN; S.G = G; S.c = bidx(); S.nseg = 1; S.pm0 = pm0;
            S.A0 = (const char*)(ws + WS_H); S.d1 = 0; S.d2 = 0; S.B0 = (const char*)(ws + wto + WS_WFF1); S.bseg = 0; S.tstep = (size_t)256 * D * 2;
            pg8::EpiFF1 E{(bf16_t*)(ws + WS_HID)};
            pg8::gemm_phase<pg8::EpiFF1, pg8::Sched>(lds, D, D, S, E);
        }
        GRID_SYNC();
    PROBE(7);
        {
            pg8::Sched S; S.nM = 64; S.nN = 4; S.nwg = S.nM * S.nN; S.G = G; S.c = bidx(); S.nseg = 1; S.pm0 = 4;
            S.A0 = (const char*)(ws + WS_HID); S.d1 = 0; S.d2 = 0; S.B0 = (const char*)(ws + wto + WS_WFF2); S.bseg = 0; S.tstep = (size_t)256 * DFF * 2;
            pg8::EpiRes E{(const float*)(ws + WS_XC), (const float*)outp(), (float*)(ws + WS_XC), outp(), modl + 5 * 1024};
            pg8::gemm_phase<pg8::EpiRes, pg8::Sched>(lds, DFF, DFF, S, E);
        }
        if (!last) {
            pg8::SchedList S; S.n = 64; S.G = G; S.c = bidx(); S.nN = 4; S.nS = 1; S.nQ = 4;
            S.A0 = (const char*)(ws + WS_HID); S.a_pm = (size_t)256 * DFF * 2; S.a_s = 0; S.a_q = 1024 * 2;
            S.B0 = (const char*)(ws + wto + WS_WFF2); S.b_pn = (size_t)256 * DFF * 2; S.b_s = 0; S.b_q = 1024 * 2;
            pg8::EpiPartial E{(float*)(ws + WS_PX), 4};
            pg8::gemm_phase<pg8::EpiPartial, pg8::SchedList>(lds, 1024, DFF, S, E);
        }
        if (!last && G > 64) { const int bq = bidx(); if (bq >= 64) convert_weights(l + 1, (size_t)((l + 1) & 1) * WT_BYTES, lds, bq - 64, G - 64, tidx()); }
        else if (!last) convert_weights(l + 1, (size_t)((l + 1) & 1) * WT_BYTES, lds, bidx(), G, tidx());
#ifdef PROBE_K
        GRID_SYNC();
#else
        if (!last) GRID_SYNC();
#endif
    PROBE(8);
    }
#ifdef PROBE_K
    if (blockIdx.x == 0 && threadIdx.x == 0) { float pv = (float)pr_acc * 0.01f; if (PROBE_K >= 30 && PROBE_K < 40) pv = (float)(((unsigned*)(wsp() + WS_CTL))[128 + PROBE_K - 30]) * 0.01f; { const float sc_ = exp10f(floorf(log10f(fmaxf(pv, 1.0f))) - 1.0f); pv = floorf(pv / sc_ + 0.5f) * sc_; } outp()[0] += pv; }
#endif
}

extern "C" void kernel_launch(void* const* d_in, const int* in_sizes, int n_in, void* d_out, int out_size, void* d_ws, size_t ws_size, hipStream_t stream) {
    static int grid = 0;
    if (grid == 0) {
        if (n_in != 27 || out_size != TL * D || ws_size < WS_END) { fprintf(stderr, "kernel_launch: unexpected shapes (n_in %d out %d ws %zu need %zu)\n", n_in, out_size, ws_size, (size_t)WS_END); grid = -1; return; }
        int dev = 0, cus = 0, per_cu = 0;
        hipGetDevice(&dev);
        hipDeviceGetAttribute(&cus, hipDeviceAttributeMultiprocessorCount, dev);
        hipFuncSetAttribute((const void*)fwd_megakernel, hipFuncAttributeMaxDynamicSharedMemorySize, LDS_BYTES);
        hipOccupancyMaxActiveBlocksPerMultiprocessor(&per_cu, (const void*)fwd_megakernel, 512, LDS_BYTES);
        if (per_cu < 1) { fprintf(stderr, "kernel_launch: occupancy query says %d blocks/CU\n", per_cu); per_cu = 1; }
        (void)hipGetLastError();
        grid = cus;
    }
    if (grid < 0) return;
    if (hipMemsetAsync((char*)d_ws + WS_CTL, 0, 4096, stream) != hipSuccess) { fprintf(stderr, "memset failed\n"); return; }
    Args a{};
    for (int i = 0; i < 27; ++i) a.in[i] = (const float*)d_in[i];
    a.out = (float*)d_out; a.ws = (unsigned char*)d_ws;
    void* args[] = {&a};
    hipError_t e = hipLaunchCooperativeKernel((const void*)fwd_megakernel, dim3(grid), dim3(512), args, LDS_BYTES, stream);
    if (e != hipSuccess) fprintf(stderr, "cooperative launch failed: %s (grid %d)\n", hipGetErrorString(e), grid);
}
```

```cpp
#define DBG_NOADD 0
#include <hip/hip_runtime.h>
#include <hip/hip_cooperative_groups.h>
#include <cstdio>
#include <cstdint>
namespace cg = cooperative_groups;

#define LAS __attribute__((address_space(3)))
#define DI __device__ __forceinline__
typedef unsigned short bf16_t;
typedef short bf16x8 __attribute__((ext_vector_type(8)));
typedef short s16x4 __attribute__((ext_vector_type(4)));
typedef float f32x2 __attribute__((ext_vector_type(2)));
typedef float f32x4 __attribute__((ext_vector_type(4)));
typedef float f32x16 __attribute__((ext_vector_type(16)));
typedef unsigned u32x2 __attribute__((ext_vector_type(2)));
typedef unsigned u32x4 __attribute__((ext_vector_type(4)));
typedef __bf16 bf16x2_t __attribute__((ext_vector_type(2)));

constexpr int D = 1024, NB = 4, SEQ = 4096, CTX = 256, DEPTH = 4, DFF = 4096;
constexpr int TC = NB * CTX;
constexpr int TL = NB * SEQ;
constexpr int T = TC + TL;
constexpr int INW = 7680;
constexpr float EPS = 1e-6f;
constexpr float LOG2E = 1.4426950408889634f;

constexpr size_t WS_CTL = 0;
constexpr size_t WS_ROPE = 4096;
constexpr size_t WS_MOD = 65536;
constexpr size_t WS_XC = 1u << 20;
constexpr size_t WS_WIN = 5u << 20;
constexpr size_t WS_WBR = WS_WIN + (size_t)INW * D * 2;
constexpr size_t WS_WOUT = WS_WBR + (size_t)3 * D * D * 2;
constexpr size_t WS_WFF1 = WS_WOUT + (size_t)D * D * 2;
constexpr size_t WS_WFF2 = WS_WFF1 + (size_t)DFF * D * 2;
constexpr size_t SLOT = (size_t)T * D * 2;
constexpr size_t WT_BYTES = WS_WFF2 + (size_t)DFF * D * 2 - WS_WIN;
constexpr size_t WS_H = WS_WIN + 2 * WT_BYTES;
constexpr size_t WS_ZV = WS_H + SLOT;
constexpr size_t WS_ZU = WS_H + 2 * SLOT;
constexpr size_t WS_ZA = WS_H + 3 * SLOT;
constexpr size_t WS_ZQ = WS_H + 4 * SLOT;
constexpr size_t WS_ZK = WS_H + 5 * SLOT;
constexpr size_t WS_ZVV = WS_ZK + (size_t)T * 256 * 2;
constexpr size_t WS_ZG = WS_ZVV + (size_t)T * 256 * 2;
constexpr size_t WS_MG = WS_ZG + (size_t)T * 3072 * 2;
constexpr size_t WS_PC = WS_MG + SLOT;
constexpr size_t WS_PX = WS_PC + (size_t)3 * TC * D * 2;
constexpr size_t WS_END = WS_PX + (size_t)12 * TC * D * 4;
constexpr size_t WS_HID = WS_ZV;

constexpr int LDS_BYTES = 147456;
constexpr int LDS_MISC = 143360;

struct Args { const float* in[27]; float* out; unsigned char* ws; };


template <int OFF> DI const void* kargp() { const unsigned long long k = (unsigned long long)__builtin_amdgcn_kernarg_segment_ptr(); const void* p;
    asm volatile("s_load_dwordx2 %0, %1, %2\n\ts_waitcnt lgkmcnt(0)" : "=s"(p) : "s"(k), "n"(OFF) : "memory"); return p; }
template <int I> DI const float* inp() { return (const float*)kargp<I * 8>(); }
DI float* outp() { return (float*)kargp<27 * 8>(); }
DI unsigned char* wsp() { return (unsigned char*)kargp<28 * 8>(); }
DI int tidx() { int t = threadIdx.x; asm volatile("" : "+v"(t)); return t; }
DI int bidx() { int b = blockIdx.x; asm volatile("" : "+s"(b)); return b; }

DI unsigned pk2(float lo, float hi) { f32x2 v = {lo, hi}; bf16x2_t b = __builtin_convertvector(v, bf16x2_t); return __builtin_bit_cast(unsigned, b); }
DI float bflo(unsigned w) { return __uint_as_float(w << 16); }
DI float bfhi(unsigned w) { return __uint_as_float(w & 0xffff0000u); }
DI float bf1(bf16_t h) { return __uint_as_float(((unsigned)h) << 16); }
DI bf16_t f2bf(float f) { return (bf16_t)(pk2(f, 0.f) & 0xffffu); }
DI float fexp2(float x) { return __builtin_amdgcn_exp2f(x); }
DI float frcp(float x) { return __builtin_amdgcn_rcpf(x); }
DI float sigmoidf_(float x) { return frcp(1.0f + fexp2(-x * LOG2E)); }
DI float gelu_tanh(float x) { const float u = x + 0.044715f * x * x * x; return x * frcp(1.0f + fexp2(-1.5957691216f * LOG2E * u)); }
DI float wave_sum(float v) {
#pragma unroll
    for (int o = 1; o < 64; o <<= 1) v += __shfl_xor(v, o);
    return v;
}
DI void unpack8(const u32x4 w, float (&v)[8]) { v[0] = bflo(w.x); v[1] = bfhi(w.x); v[2] = bflo(w.y); v[3] = bfhi(w.y); v[4] = bflo(w.z); v[5] = bfhi(w.z); v[6] = bflo(w.w); v[7] = bfhi(w.w); }
DI u32x4 pack8(const float (&v)[8]) { u32x4 w; w.x = pk2(v[0], v[1]); w.y = pk2(v[2], v[3]); w.z = pk2(v[4], v[5]); w.w = pk2(v[6], v[7]); return w; }
typedef short v4i16_t __attribute__((ext_vector_type(4)));
DI bf16x8 tr_read2(const LAS bf16_t* p0, const LAS bf16_t* p1) {
    const v4i16_t a = __builtin_amdgcn_ds_read_tr16_b64_v4i16((LAS v4i16_t*)p0), b = __builtin_amdgcn_ds_read_tr16_b64_v4i16((LAS v4i16_t*)p1);
    bf16x8 r; r[0] = a[0]; r[1] = a[1]; r[2] = a[2]; r[3] = a[3]; r[4] = b[0]; r[5] = b[1]; r[6] = b[2]; r[7] = b[3]; return r;
}
#define MFMA32(a, b, c) __builtin_amdgcn_mfma_f32_32x32x16_bf16((a), (b), (c), 0, 0, 0)

namespace pg8 {
constexpr int BM = 256, BK = 64, HALF = 128, HTB = HALF * BK * 2, STAGE_BYTES = 8 * HTB, NXCD = 8, WGM = 8;
DI int lds_byte(int r, int c) { const int st = (r >> 4) * 2 + (c >> 5), rr = r & 15, cc = c & 31, ob = rr * 64 + cc * 2; return st * 1024 + (ob ^ (((ob >> 9) & 1) << 5)); }
DI void stage_rc(int b, int& R, int& C) { const int st = b / 1024, sb = b % 1024, swz = sb ^ (((sb >> 9) & 1) << 5); R = (st >> 1) * 16 + swz / 64; C = (st & 1) * 32 + (swz % 64) / 2; }
DI int perm32(int rho) { const int n = rho >> 4, i = rho & 15; return 8 * (i >> 2) + 4 * n + (i & 3); }

struct Unit { int pm, pn, seg, q; const char* A; const char* B; };

struct Sched {
    int nM, nN, nwg, G, c, nseg, pm0;
    const char *A0, *B0; size_t d1, d2, bseg, tstep;
    DI bool next(int i, Unit& u) const {
        int ti = i, seg = 0;
        if (nseg == 3) { ti = i / 3; seg = i - 3 * ti; }
        const long L = (long)ti * G + c; if (L >= nwg) return false;
        int wgid = (int)L; { const int q = nwg / NXCD, r = nwg % NXCD, xcd = wgid % NXCD, off = wgid / NXCD; wgid = (xcd < r ? xcd * (q + 1) : r * (q + 1) + (xcd - r) * q) + off; }
        const int nig = WGM * nN, gid = wgid / nig, fm = gid * WGM, gsz = (nM - fm) < WGM ? (nM - fm) : WGM;
        u.pm = pm0 + fm + ((wgid % nig) % gsz); u.pn = (wgid % nig) / gsz; u.seg = seg; u.q = 0;
        const size_t ao = (seg >= 1 ? d1 : (size_t)0) + (seg >= 2 ? d2 : (size_t)0);
        u.A = A0 + ao + (size_t)u.pm * tstep; u.B = B0 + (size_t)seg * bseg + (size_t)u.pn * tstep;
        return true;
    }
};

struct SchedList {
    int n, G, c, nN, nS, nQ; const char *A0, *B0; size_t a_pm, a_s, a_q, b_pn, b_s, b_q;
    DI bool next(int i, Unit& u) const {
        const int idx = i * G + c; if (idx >= n) return false;
        const int q = idx % nQ; int t = idx / nQ; const int sg = t % nS; t /= nS; const int pn = t % nN, pm = t / nN;
        u.pm = pm; u.pn = pn; u.seg = sg; u.q = q;
        u.A = A0 + (size_t)pm * a_pm + (size_t)sg * a_s + (size_t)q * a_q; u.B = B0 + (size_t)pn * b_pn + (size_t)sg * b_s + (size_t)q * b_q;
        return true;
    }
};

template <class Epi, class SchedT>
DI void gemm_phase(LAS unsigned char* lds, const int K, const int pitch, const SchedT& S, const Epi& E) {
    const int tid = tidx(), wid = __builtin_amdgcn_readfirstlane(tid >> 6), lane = tid & 63, wr = wid >> 2, wc = wid & 3, fr = lane & 15, fq = lane >> 4;
    const int nt = K / BK;
    unsigned voffA[2], voffB[2];
#pragma unroll
    for (int i = 0; i < 2; ++i) { int R, C; stage_rc(tid * 16 + i * 8192, R, C); const int Rb = Epi::PERM ? ((R & ~31) + perm32(R & 31)) : R;
        voffA[i] = (unsigned)(R * pitch + C) * 2u; voffB[i] = (unsigned)(Rb * pitch + C) * 2u; }
    const size_t kstep = (size_t)(BK * 2);
    const size_t hstep = (size_t)HALF * pitch * 2;
    const unsigned ldsw = (unsigned)wid * 1024u;
    const int aoff = lds_byte(wr * 64 + fr, fq * 8), boff = lds_byte(wc * 32 + fr, fq * 8);
#define PG8_SA(b, h) (((b) * 2 + (h)) * HTB)
#define PG8_SB(b, h) ((4 + (b) * 2 + (h)) * HTB)
#define PG8_STAGE(bufoff, gbase, voff) do { _Pragma("unroll") for (int _i = 0; _i < 2; ++_i) \
        __builtin_amdgcn_global_load_lds((const unsigned*)((const char*)(gbase) + (voff)[_i]), (LAS unsigned*)(lds + (bufoff) + ldsw + _i * 8192), 16, 0, 0); } while (0)
#define PG8_LDA(dst, b, h) do { _Pragma("unroll") for (int m = 0; m < 4; ++m) _Pragma("unroll") for (int k = 0; k < 2; ++k) dst[m][k] = *(const LAS bf16x8*)(lds + PG8_SA(b, h) + aoff + m * 2048 + k * 1024); } while (0)
#define PG8_LDB(dst, b, h) do { _Pragma("unroll") for (int n = 0; n < 2; ++n) _Pragma("unroll") for (int k = 0; k < 2; ++k) dst[n][k] = *(const LAS bf16x8*)(lds + PG8_SB(b, h) + boff + n * 2048 + k * 1024); } while (0)
#define PG8_MMA(ai, bj, At, Bt) do { __builtin_amdgcn_s_setprio(1); _Pragma("unroll") for (int m = 0; m < 4; ++m) _Pragma("unroll") for (int n = 0; n < 2; ++n) _Pragma("unroll") for (int k = 0; k < 2; ++k) \
        acc[ai][bj][m][n] = __builtin_amdgcn_mfma_f32_16x16x32_bf16(Bt[n][k], At[m][k], acc[ai][bj][m][n], 0, 0, 0); __builtin_amdgcn_s_setprio(0); } while (0)
#define PG8_WAIT_V(n) asm volatile("s_waitcnt vmcnt(" #n ")" ::: "memory")
#define PG8_WAIT_L(n) asm volatile("s_waitcnt lgkmcnt(" #n ")" ::: "memory")
#define PG8_BAR __builtin_amdgcn_s_barrier()
#define PG8_SCHED __builtin_amdgcn_sched_barrier(0)
    Unit cur, nxt; int ui = 0;
    if (!S.next(0, cur)) return;
    f32x4 acc[2][2][4][2];
#pragma unroll
    for (int a = 0; a < 2; ++a)
#pragma unroll
        for (int b = 0; b < 2; ++b)
#pragma unroll
            for (int m = 0; m < 4; ++m)
#pragma unroll
                for (int n = 0; n < 2; ++n) acc[a][b][m][n] = (f32x4){0.f, 0.f, 0.f, 0.f};
    bf16x8 At[4][2], B0[2][2], B1[2][2];
    const char* cA = cur.A; const char* cB = cur.B;
    PG8_STAGE(PG8_SB(0, 0), cB, voffB); PG8_STAGE(PG8_SA(0, 0), cA, voffA); PG8_STAGE(PG8_SB(0, 1), cB + hstep, voffB); PG8_STAGE(PG8_SA(0, 1), cA + hstep, voffA);
    if (wr == 1) PG8_BAR;
    PG8_WAIT_V(4); PG8_BAR;
    PG8_STAGE(PG8_SB(1, 0), cB + kstep, voffB); PG8_STAGE(PG8_SA(1, 0), cA + kstep, voffA); PG8_STAGE(PG8_SB(1, 1), cB + hstep + kstep, voffB);
    PG8_WAIT_V(6); PG8_BAR;
    for (;;) {
        const bool has_next = S.next(ui + 1, nxt);
        const char* nA = has_next ? nxt.A : cA; const char* nB = has_next ? nxt.B : cB;
        for (int t = 0; t < nt; t += 2) {
            const bool last = (t == nt - 2);
            const char* a1 = cA + (size_t)(t + 1) * kstep;
            const char* a2 = last ? nA : cA + (size_t)(t + 2) * kstep; const char* b2 = last ? nB : cB + (size_t)(t + 2) * kstep;
            const char* a3 = a2 + kstep; const char* b3 = b2 + kstep;
            PG8_LDB(B0, 0, 0); PG8_SCHED; PG8_LDA(At, 0, 0); PG8_STAGE(PG8_SA(1, 1), a1 + hstep, voffA);
            PG8_WAIT_L(8); PG8_BAR; PG8_WAIT_L(0); PG8_MMA(0, 0, At, B0); PG8_BAR; PG8_SCHED;
            PG8_LDB(B1, 0, 1); PG8_STAGE(PG8_SB(0, 0), b2, voffB);
            PG8_BAR; PG8_WAIT_L(0); PG8_MMA(0, 1, At, B1); PG8_BAR;
            PG8_LDA(At, 0, 1); PG8_STAGE(PG8_SA(0, 0), a2, voffA);
            PG8_BAR; PG8_WAIT_L(0); PG8_MMA(1, 0, At, B0); PG8_BAR; PG8_SCHED;
            PG8_STAGE(PG8_SB(0, 1), b2 + hstep, voffB);
            PG8_WAIT_V(6); PG8_BAR; PG8_MMA(1, 1, At, B1); PG8_BAR;
            PG8_LDB(B0, 1, 0); PG8_SCHED; PG8_LDA(At, 1, 0); PG8_STAGE(PG8_SA(0, 1), a2 + hstep, voffA);
            PG8_WAIT_L(8); PG8_BAR; PG8_WAIT_L(0); PG8_MMA(0, 0, At, B0); PG8_BAR; PG8_SCHED;
            PG8_LDB(B1, 1, 1); PG8_STAGE(PG8_SB(1, 0), b3, voffB);
            PG8_BAR; PG8_WAIT_L(0); PG8_MMA(0, 1, At, B1); PG8_BAR;
            PG8_LDA(At, 1, 1); PG8_STAGE(PG8_SA(1, 0), a3, voffA);
            PG8_BAR; PG8_WAIT_L(0); PG8_MMA(1, 0, At, B0); PG8_BAR; PG8_SCHED;
            PG8_STAGE(PG8_SB(1, 1), b3 + hstep, voffB);
            PG8_WAIT_V(6); PG8_BAR; PG8_MMA(1, 1, At, B1); PG8_BAR;
        }
        E(acc, cur, wr, wc, fr, fq);
        if (!has_next) break;
        if (!Epi::KEEP || nxt.seg == 0) {
#pragma unroll
        for (int a = 0; a < 2; ++a)
#pragma unroll
            for (int b = 0; b < 2; ++b)
#pragma unroll
                for (int m = 0; m < 4; ++m)
#pragma unroll
                    for (int n = 0; n < 2; ++n) acc[a][b][m][n] = (f32x4){0.f, 0.f, 0.f, 0.f};
        }
        cur = nxt; cA = nA; cB = nB; ++ui;
    }
    PG8_WAIT_V(0);
    if (wr == 0) PG8_BAR;
    PG8_BAR;
#undef PG8_SA
#undef PG8_SB
#undef PG8_STAGE
#undef PG8_LDA
#undef PG8_LDB
#undef PG8_MMA
#undef PG8_WAIT_V
#undef PG8_WAIT_L
#undef PG8_BAR
#undef PG8_SCHED
}

struct EpiIn {
    static constexpr bool PERM = true, KEEP = false;
    unsigned char* ws;
    DI void operator()(const f32x4 (&acc)[2][2][4][2], const Unit& u, int wr, int wc, int fr, int fq) const {
        const int pn = u.pn; bf16_t* base; int ldc, colt, mode;
        if (pn < 4) { base = (bf16_t*)(ws + WS_ZA); ldc = 1024; colt = pn * 256; mode = 0; }
        else if (pn < 8) { base = (bf16_t*)(ws + WS_ZU); ldc = 1024; colt = (pn - 4) * 256; mode = 1; }
        else if (pn < 12) { base = (bf16_t*)(ws + WS_ZV); ldc = 1024; colt = (pn - 8) * 256; mode = 1; }
        else if (pn < 16) { base = (bf16_t*)(ws + WS_ZQ); ldc = 1024; colt = (pn - 12) * 256; mode = 0; }
        else if (pn == 16) { base = (bf16_t*)(ws + WS_ZK); ldc = 256; colt = 0; mode = 0; }
        else if (pn == 17) { base = (bf16_t*)(ws + WS_ZVV); ldc = 256; colt = 0; mode = 0; }
        else { base = (bf16_t*)(ws + WS_ZG); ldc = 3072; colt = (pn - 18) * 256; mode = 2; }
        const int row0 = u.pm * BM + wr * 64 + fr, col0 = colt + wc * 32 + 8 * fq;
#pragma unroll
        for (int ai = 0; ai < 2; ++ai)
#pragma unroll
            for (int m = 0; m < 4; ++m) { bf16_t* rowp = base + (size_t)(row0 + ai * HALF + m * 16) * ldc + col0;
#pragma unroll
                for (int bj = 0; bj < 2; ++bj) { f32x4 v0 = acc[ai][bj][m][0], v1 = acc[ai][bj][m][1];
                    if (mode == 1) {
#pragma unroll
                        for (int j = 0; j < 4; ++j) { v0[j] = gelu_tanh(v0[j]); v1[j] = gelu_tanh(v1[j]); } }
                    else if (mode == 2) {
#pragma unroll
                        for (int j = 0; j < 4; ++j) { v0[j] = sigmoidf_(v0[j]); v1[j] = sigmoidf_(v1[j]); } }
                    u32x4 w; w.x = pk2(v0[0], v0[1]); w.y = pk2(v0[2], v0[3]); w.z = pk2(v1[0], v1[1]); w.w = pk2(v1[2], v1[3]);
                    *(u32x4*)(rowp + bj * HALF) = w; } }
    }
};
struct EpiMerge {
    static constexpr bool PERM = true, KEEP = true;
    bf16_t* Mg; const bf16_t* ZG;
    DI void operator()(f32x4 (&acc)[2][2][4][2], const Unit& u, int wr, int wc, int fr, int fq) const {
        const int row0 = u.pm * BM + wr * 64 + fr, col0 = u.pn * BM + wc * 32 + 8 * fq, seg = u.seg;
#pragma unroll
        for (int ai = 0; ai < 2; ++ai)
#pragma unroll
            for (int m = 0; m < 4; ++m) { const size_t r = (size_t)(row0 + ai * HALF + m * 16);
#pragma unroll
                for (int bj = 0; bj < 2; ++bj) {
                    const bf16_t* gp = ZG + r * 3072 + seg * 1024 + col0 + bj * HALF;
                    float g[8]; unpack8(*(const u32x4*)gp, g);
#pragma unroll
                    for (int j = 0; j < 8; ++j) g[j] = fmaxf(g[j], 1e-6f);
                    if (seg < 2) { float gn[8]; unpack8(*(const u32x4*)(gp + 1024), gn);
#pragma unroll
                        for (int j = 0; j < 8; ++j) g[j] *= frcp(fmaxf(gn[j], 1e-6f)); }
                    f32x4& v0 = acc[ai][bj][m][0]; f32x4& v1 = acc[ai][bj][m][1];
                    v0[0] *= g[0]; v0[1] *= g[1]; v0[2] *= g[2]; v0[3] *= g[3]; v1[0] *= g[4]; v1[1] *= g[5]; v1[2] *= g[6]; v1[3] *= g[7];
                    if (seg == 2) { u32x4 w; w.x = pk2(v0[0], v0[1]); w.y = pk2(v0[2], v0[3]); w.z = pk2(v1[0], v1[1]); w.w = pk2(v1[2], v1[3]);
                        *(u32x4*)(Mg + r * 1024 + col0 + bj * HALF) = w; } } }
    }
};
struct EpiRes {
    static constexpr bool PERM = false, KEEP = false;
    const float* src_c; const float* src_l; float* dst_c; float* dst_l; const float* gate;
    DI void operator()(const f32x4 (&acc)[2][2][4][2], const Unit& u, int wr, int wc, int fr, int fq) const {
        const int rowt = u.pm * BM; const int grp = rowt < TC ? 4 : ((rowt - TC) >> 12);
        const float* src = rowt < TC ? src_c + (size_t)rowt * D : src_l + (size_t)(rowt - TC) * D;
        float* dst = rowt < TC ? dst_c + (size_t)rowt * D : dst_l + (size_t)(rowt - TC) * D;
        const int row0 = wr * 64 + fr, col0 = u.pn * BM + wc * 32 + 4 * fq;
        const float* gp = gate + grp * 6144 + col0;
        f32x4 gv[2][2];
#pragma unroll
        for (int bj = 0; bj < 2; ++bj)
#pragma unroll
            for (int n = 0; n < 2; ++n) gv[bj][n] = *(const f32x4*)(gp + bj * HALF + n * 16);
#pragma unroll
        for (int ai = 0; ai < 2; ++ai)
#pragma unroll
            for (int m = 0; m < 4; ++m) { const size_t off = (size_t)(row0 + ai * HALF + m * 16) * D + col0;
#pragma unroll
                for (int bj = 0; bj < 2; ++bj)
#pragma unroll
                    for (int n = 0; n < 2; ++n) { const f32x4 xs = *(const f32x4*)(src + off + bj * HALF + n * 16);
                        *(f32x4*)(dst + off + bj * HALF + n * 16) = xs + gv[bj][n] * acc[ai][bj][m][n]; } }
    }
};
struct EpiMergeCtx {
    static constexpr bool PERM = true, KEEP = false;
    bf16_t* Pc; const bf16_t* ZG;
    DI void operator()(const f32x4 (&acc)[2][2][4][2], const Unit& u, int wr, int wc, int fr, int fq) const {
        const int row0 = u.pm * BM + wr * 64 + fr, col0 = u.pn * BM + wc * 32 + 8 * fq, seg = u.seg;
#pragma unroll
        for (int ai = 0; ai < 2; ++ai)
#pragma unroll
            for (int m = 0; m < 4; ++m) { const size_t r = (size_t)(row0 + ai * HALF + m * 16);
#pragma unroll
                for (int bj = 0; bj < 2; ++bj) {
                    const u32x4 gw = *(const u32x4*)(ZG + r * 3072 + seg * 1024 + col0 + bj * HALF);
                    float g[8]; unpack8(gw, g);
                    const f32x4 v0 = acc[ai][bj][m][0], v1 = acc[ai][bj][m][1];
                    u32x4 w; w.x = pk2(g[0] * v0[0], g[1] * v0[1]); w.y = pk2(g[2] * v0[2], g[3] * v0[3]); w.z = pk2(g[4] * v1[0], g[5] * v1[1]); w.w = pk2(g[6] * v1[2], g[7] * v1[3]);
                    *(u32x4*)(Pc + (size_t)seg * TC * D + r * 1024 + col0 + bj * HALF) = w; } }
    }
};
struct EpiPartial {
    static constexpr bool PERM = false, KEEP = false;
    float* PX; int nq;
    DI void operator()(const f32x4 (&acc)[2][2][4][2], const Unit& u, int wr, int wc, int fr, int fq) const {
        const int row0 = u.pm * BM + wr * 64 + fr, col0 = u.pn * BM + wc * 32 + 4 * fq;
        float* base = PX + (size_t)(u.seg * nq + u.q) * TC * D;
#pragma unroll
        for (int ai = 0; ai < 2; ++ai)
#pragma unroll
            for (int m = 0; m < 4; ++m) { float* rp = base + (size_t)(row0 + ai * HALF + m * 16) * D + col0;
#pragma unroll
                for (int bj = 0; bj < 2; ++bj)
#pragma unroll
                    for (int n = 0; n < 2; ++n) *(f32x4*)(rp + bj * HALF + n * 16) = acc[ai][bj][m][n]; }
    }
};
struct EpiFF1 {
    static constexpr bool PERM = true, KEEP = false;
    bf16_t* O;
    DI void operator()(const f32x4 (&acc)[2][2][4][2], const Unit& u, int wr, int wc, int fr, int fq) const {
        const int row0 = u.pm * BM + wr * 64 + fr, col0 = u.pn * BM + wc * 32 + 8 * fq;
#pragma unroll
        for (int ai = 0; ai < 2; ++ai)
#pragma unroll
            for (int m = 0; m < 4; ++m) { bf16_t* rowp = O + (size_t)(row0 + ai * HALF + m * 16) * DFF + col0;
#pragma unroll
                for (int bj = 0; bj < 2; ++bj) { f32x4 v0 = acc[ai][bj][m][0], v1 = acc[ai][bj][m][1];
#pragma unroll
                    for (int j = 0; j < 4; ++j) { const float a = fmaxf(v0[j], 0.f), b = fmaxf(v1[j], 0.f); v0[j] = a * a; v1[j] = b * b; }
                    u32x4 w; w.x = pk2(v0[0], v0[1]); w.y = pk2(v0[2], v0[3]); w.z = pk2(v1[0], v1[1]); w.w = pk2(v1[2], v1[3]);
                    *(u32x4*)(rowp + bj * HALF) = w; } }
    }
};
}

DI void phase_prep(const Args& a, LAS unsigned char* lds) {
    const int tid = tidx(), bid = bidx(), G = gridDim.x;
    if (bid == (1 % G)) {
        float* cosT = (float*)(wsp() + WS_ROPE); float* sinT = cosT + 1024;
        for (int i = tid; i < 1024; i += 512) { const int pos = i >> 4, f = i & 15; const float inv = powf(10000.0f, -(float)f / 16.0f); const float ang = (float)pos * inv;
            cosT[i] = cosf(ang); sinT[i] = sinf(ang); }
    }
    LAS float* cond = (LAS float*)lds;
    LAS float* red = (LAS float*)(lds + 20480);
    for (int i = tid; i < 5 * 1024; i += 512) { const int g = i >> 10, k = i & 1023; const float v = g < 4 ? inp<1>()[g * 1024 + k] : inp<3>()[k]; cond[i] = v * sigmoidf_(v); }
    __syncthreads();
    float* mod = (float*)(wsp() + WS_MOD);
    for (int it = bid; it < DEPTH * 96; it += G) {
        const int l = it / 96, cb = it % 96, c = tid & 63, kg = tid >> 6, col = cb * 64 + c;
        const float* w = inp<4>() + (size_t)l * D * 6144 + col;
        float acc[5] = {0.f, 0.f, 0.f, 0.f, 0.f};
#pragma unroll 8
        for (int k = kg * 128; k < kg * 128 + 128; ++k) { const float wv = w[(size_t)k * 6144];
#pragma unroll
            for (int g = 0; g < 5; ++g) acc[g] += cond[g * 1024 + k] * wv; }
#pragma unroll
        for (int g = 0; g < 5; ++g) red[(kg * 5 + g) * 64 + c] = acc[g];
        __syncthreads();
        if (tid < 320) { const int g = tid >> 6; float s = inp<5>()[l * 6144 + col];
#pragma unroll
            for (int k2 = 0; k2 < 8; ++k2) s += red[(k2 * 5 + g) * 64 + c];
            mod[(size_t)(l * 5 + g) * 6144 + col] = s; }
        __syncthreads();
    }
}

DI void transpose_item(const float* W, int K, int N, bf16_t* WT, LAS float* scr, int item, int lane) {
    const int nblk = N / 32, kb = item / nblk, nb = item % nblk, k0 = 64 * kb, n0 = 32 * nb;
#pragma unroll 8
    for (int i = 0; i < 32; ++i) { const int kk = 2 * i + (lane >> 5); scr[kk * 33 + (lane & 31)] = W[(size_t)(k0 + kk) * N + n0 + (lane & 31)]; }
    asm volatile("s_waitcnt lgkmcnt(0)" ::: "memory");
    const int c = lane & 7;
#pragma unroll
    for (int j = 0; j < 4; ++j) { const int n = (lane >> 3) + 8 * j; const LAS float* s = scr + (8 * c) * 33 + n;
        u32x4 o; o.x = pk2(s[0 * 33], s[1 * 33]); o.y = pk2(s[2 * 33], s[3 * 33]); o.z = pk2(s[4 * 33], s[5 * 33]); o.w = pk2(s[6 * 33], s[7 * 33]);
        *(u32x4*)(WT + (size_t)(n0 + n) * K + k0 + 8 * c) = o; }
    asm volatile("s_waitcnt lgkmcnt(0)" ::: "memory");
}


DI void transpose_tile(const float* W, int K, int N, bf16_t* WT, LAS float* scr, int item, int tid) {
    const int nblk = N / 256, kb = item / nblk, nb = item % nblk, k0 = 64 * kb, n0 = 256 * nb;
#pragma unroll
    for (int it = 0; it < 8; ++it) { const int idx = it * 512 + tid, kk = idx >> 6, c4 = idx & 63;
        const f32x4 v = *(const f32x4*)(W + (size_t)(k0 + kk) * N + n0 + c4 * 4);
        LAS float* d = scr + kk * 257 + c4 * 4; d[0] = v.x; d[1] = v.y; d[2] = v.z; d[3] = v.w; }
    __syncthreads();
#pragma unroll
    for (int it = 0; it < 4; ++it) { const int idx = it * 512 + tid, n = idx >> 3, c = idx & 7; const LAS float* sp = scr + (8 * c) * 257 + n;
        u32x4 o; o.x = pk2(sp[0], sp[257]); o.y = pk2(sp[2 * 257], sp[3 * 257]); o.z = pk2(sp[4 * 257], sp[5 * 257]); o.w = pk2(sp[6 * 257], sp[7 * 257]);
        *(u32x4*)(WT + (size_t)(n0 + n) * K + k0 + 8 * c) = o; }
    __syncthreads();
}

DI void convert_weights(int l, size_t wtoff, LAS unsigned char* lds, int rank, int nranks, int tid) {
    LAS float* scr = (LAS float*)lds;
    unsigned char* wb = wsp() + wtoff;
    constexpr int I_IN = 16 * (INW / 256), I_BR = 16 * 4, I_FF1 = 16 * (DFF / 256), I_FF2 = 64 * 4;
    constexpr int NIT = I_IN + 4 * I_BR + I_FF1 + I_FF2;
    for (int it = rank; it < NIT; it += nranks) {
        int r = it;
        if (r < I_IN) { transpose_tile(inp<7>() + (size_t)l * D * INW, D, INW, (bf16_t*)(wb + WS_WIN), scr, r, tid); continue; } r -= I_IN;
        if (r < 3 * I_BR) { const int sg = r / I_BR; transpose_tile(inp<22>() + ((size_t)l * 3 + sg) * D * D, D, D, (bf16_t*)(wb + WS_WBR) + (size_t)sg * D * D, scr, r % I_BR, tid); continue; } r -= 3 * I_BR;
        if (r < I_BR) { transpose_tile(inp<23>() + (size_t)l * D * D, D, D, (bf16_t*)(wb + WS_WOUT), scr, r, tid); continue; } r -= I_BR;
        if (r < I_FF1) { transpose_tile(inp<25>() + (size_t)l * D * DFF, D, DFF, (bf16_t*)(wb + WS_WFF1), scr, r, tid); continue; } r -= I_FF1;
        transpose_tile(inp<26>() + (size_t)l * DFF * D, DFF, D, (bf16_t*)(wb + WS_WFF2), scr, r, tid);
    }
}

DI void phase_norm(const Args& a, LAS unsigned char* lds, int l, int which) {
    const int tid = tidx(), lane = tid & 63, wave = tid >> 6, G = gridDim.x;
    const int gw = bidx() * 8 + wave, NGW = G * 8;
    if (which == 0 && l == 0) convert_weights(0, 0, lds, bidx(), G, tid);
    const bool from_in = (l == 0 && which == 0);
    const float* xc_src = from_in ? inp<2>() : (const float*)(wsp() + WS_XC);
    const float* xl_src = from_in ? inp<0>() : (const float*)outp();
    const float* gn = (which == 0 ? inp<6>() : inp<24>()) + l * D;
    const float* mod = (const float*)(wsp() + WS_MOD) + (size_t)l * 5 * 6144 + (which ? 3 * 1024 : 0);
    bf16_t* H = (bf16_t*)(wsp() + WS_H);
    const int rstart = (which == 1 && l == DEPTH - 1) ? TC : 0;
    const int npart = which == 1 ? 12 : (l > 0 ? 4 : 0);
    const float* pgate = (const float*)(wsp() + WS_MOD) + (size_t)((which == 1 ? l : l - 1) * 5 + 4) * 6144 + (which == 1 ? 2 : 5) * 1024;
    for (int r = rstart + gw; r < T; r += NGW) {
        const float* xrow = r < TC ? xc_src + (size_t)r * D : xl_src + (size_t)(r - TC) * D;
        const int grp = r < TC ? 4 : ((r - TC) >> 12);
        const float* sh = mod + grp * 6144; const float* sc = sh + 1024;
        f32x4 v[4]; float ss = 0.f;
#pragma unroll
        for (int j = 0; j < 4; ++j) v[j] = *((const f32x4*)xrow + lane + 64 * j);
        if (r < TC && npart > 0) {
            const float* px = (const float*)(wsp() + WS_PX) + (size_t)r * D;
#pragma unroll
            for (int j = 0; j < 4; ++j) { f32x4 sum = *((const f32x4*)px + lane + 64 * j);
                for (int pi = 1; pi < npart; ++pi) sum += *((const f32x4*)(px + (size_t)pi * TC * D) + lane + 64 * j);
                v[j] += *((const f32x4*)pgate + lane + 64 * j) * sum;
                *((f32x4*)(wsp() + WS_XC + (size_t)r * D * 4) + lane + 64 * j) = v[j]; }
        }
#pragma unroll
        for (int j = 0; j < 4; ++j) ss += (v[j].x * v[j].x + v[j].y * v[j].y) + (v[j].z * v[j].z + v[j].w * v[j].w);
        const float rstd = 1.0f / sqrtf(wave_sum(ss) * (1.0f / D) + EPS);
        if (from_in && r < TC) {
#pragma unroll
            for (int j = 0; j < 4; ++j) *((f32x4*)(wsp() + WS_XC + (size_t)r * D * 4) + lane + 64 * j) = v[j]; }
#pragma unroll
        for (int j = 0; j < 4; ++j) { const int k = (lane + 64 * j) * 4; const f32x4 g = *(const f32x4*)(gn + k), s1 = *(const f32x4*)(sc + k), s0 = *(const f32x4*)(sh + k);
            const f32x4 y = (v[j] * rstd * g) * (s1 + 1.0f) + s0;
            u32x2 o; o.x = pk2(y.x, y.y); o.y = pk2(y.z, y.w);
            *(u32x2*)(H + (size_t)r * D + k) = o; }
    }
}

DI float neg_expm1(float x) {
    const float small = -x * (1.0f + x * (0.5f + x * (0.16666667f + x * 0.041666667f)));
    const float big = 1.0f - fexp2(x * LOG2E);
    return x > -0.1f ? small : big;
}
DI void scan_item(const Args& a, LAS unsigned char* lds, int l, int b, int cb, int hc) {
    const int tid = tidx(), half = tid >> 8, ht = tid & 255, lane = tid & 63, hw = (tid >> 6) & 3, l15 = lane & 15, l4 = lane >> 4;
    LAS unsigned char* hb = lds + half * 63488;
    LAS bf16_t* WaT = (LAS bf16_t*)hb;
    LAS bf16_t* WxT = (LAS bf16_t*)(hb + 4608);
    LAS bf16_t* xcb = (LAS bf16_t*)(hb + 9216);
    LAS float* As = (LAS float*)(hb + 27648);
    LAS float* Us = (LAS float*)(hb + 44032);
    LAS float* carry = (LAS float*)(hb + 60416);
    LAS float* segP = (LAS float*)(hb + 60672);
    LAS float* segH = (LAS float*)(hb + 61696);
    LAS float* prm = (LAS float*)(hb + 62720);
    const bf16_t* ZA = (const bf16_t*)(wsp() + WS_ZA); bf16_t* YA = (bf16_t*)(wsp() + WS_H);
    const int tokA = ht >> 2, c0A = (ht & 3) * 16;
    f32x2 cw2[4][8], cb2[8];
    {
        const size_t wofs = (((size_t)l * 2 + half) * 16 + cb) * 4096;
        const float* wa = inp<10>() + wofs; const float* wx = inp<12>() + wofs;
        for (int i = ht; i < 2048; i += 256) { const int ii = i >> 5, jj = i & 31; WaT[jj * 72 + ii] = f2bf(wa[ii * 64 + hc * 32 + jj]); WxT[jj * 72 + ii] = f2bf(wx[ii * 64 + hc * 32 + jj]); }
        if (ht < 32) { const int ch = cb * 64 + hc * 32 + ht; const size_t po = ((size_t)l * 2 + half) * D + ch;
            prm[ht] = inp<11>()[po]; prm[32 + ht] = inp<13>()[po];
            const float lam = inp<14>()[po]; prm[64 + ht] = 8.0f * log1pf(expf(-lam));
            carry[ht] = 0.f; }
        const float* cwp = inp<8>() + (size_t)l * 4 * D + cb * 64 + c0A; const float* cbp = inp<9>() + (size_t)l * D + cb * 64 + c0A;
#pragma unroll
        for (int j = 0; j < 8; ++j) { cb2[j] = (f32x2){cbp[2 * j], cbp[2 * j + 1]};
#pragma unroll
            for (int k = 0; k < 4; ++k) cw2[k][j] = (f32x2){cwp[(size_t)k * D + 2 * j], cwp[(size_t)k * D + 2 * j + 1]}; }
    }
    __syncthreads();
#define LBAR() do { asm volatile("s_waitcnt lgkmcnt(0)" ::: "memory"); __builtin_amdgcn_s_barrier(); asm volatile("" ::: "memory"); } while (0)
#define SCAN_GID(st_) ((half == 0) ? (st_) : ((st_) < 2 ? 1 - (st_) : 35 - (st_)))
#define SCAN_LOAD(st_) do { const int gid_ = SCAN_GID(st_); const bool ic_ = gid_ < 2; const int ck_ = ic_ ? gid_ : gid_ - 2; const int L_ = ic_ ? CTX : SEQ; const int rb_ = ic_ ? b * CTX : TC + b * SEQ; \
        _Pragma("unroll") for (int t2 = 0; t2 < 2; ++t2) _Pragma("unroll") for (int k = 0; k < 4; ++k) { const int ts = ck_ * 128 + tokA + 64 * t2 + k - 2; tp[t2][k][0] = (u32x4){0u, 0u, 0u, 0u}; tp[t2][k][1] = (u32x4){0u, 0u, 0u, 0u}; \
            if (ts >= 0 && ts < L_) { const bf16_t* p = ZA + (size_t)(rb_ + ts) * D + cb * 64 + c0A; tp[t2][k][0] = *(const u32x4*)p; tp[t2][k][1] = *(const u32x4*)(p + 8); } } } while (0)
    u32x4 tp[2][4][2];
    SCAN_LOAD(0);
    const int tokE = ht >> 1, c0E = (ht & 1) * 16;
    for (int step = 0; step < 34; ++step) {
        const int gid = SCAN_GID(step); const bool isctx = gid < 2; const int chunk = isctx ? gid : gid - 2; const int rowbase = isctx ? b * CTX : TC + b * SEQ;
        const bool fwd_first = isctx ? (gid == 0) : (gid <= 17);
        const bool second = (half == 0) ? !fwd_first : fwd_first;
#pragma unroll
        for (int t2 = 0; t2 < 2; ++t2) {
            f32x2 ac[8];
#pragma unroll
            for (int j = 0; j < 8; ++j) ac[j] = cb2[j];
#pragma unroll
            for (int k = 0; k < 4; ++k) { const u32x4 w0 = tp[t2][k][0], w1 = tp[t2][k][1];
                const unsigned ww[8] = {w0.x, w0.y, w0.z, w0.w, w1.x, w1.y, w1.z, w1.w};
#pragma unroll
                for (int j = 0; j < 8; ++j) { const f32x2 xv = {bflo(ww[j]), bfhi(ww[j])}; ac[j] = cw2[k][j] * xv + ac[j]; } }
            u32x4 o0, o1; o0.x = pk2(ac[0].x, ac[0].y); o0.y = pk2(ac[1].x, ac[1].y); o0.z = pk2(ac[2].x, ac[2].y); o0.w = pk2(ac[3].x, ac[3].y);
            o1.x = pk2(ac[4].x, ac[4].y); o1.y = pk2(ac[5].x, ac[5].y); o1.z = pk2(ac[6].x, ac[6].y); o1.w = pk2(ac[7].x, ac[7].y);
            *(LAS u32x4*)(xcb + (tokA + 64 * t2) * 72 + c0A) = o0; *(LAS u32x4*)(xcb + (tokA + 64 * t2) * 72 + c0A + 8) = o1;
        }
        LBAR();
#pragma unroll
        for (int mt = 0; mt < 2; ++mt) {
            f32x4 ar[2], ai[2];
#pragma unroll
            for (int nt = 0; nt < 2; ++nt) { ar[nt] = (f32x4){0.f, 0.f, 0.f, 0.f}; ai[nt] = (f32x4){0.f, 0.f, 0.f, 0.f}; }
#pragma unroll
            for (int s = 0; s < 2; ++s) { const bf16x8 xa = *(const LAS bf16x8*)(xcb + (32 * hw + 16 * mt + l15) * 72 + 32 * s + 8 * l4);
#pragma unroll
                for (int nt = 0; nt < 2; ++nt) { const bf16x8 wa = *(const LAS bf16x8*)(WaT + (16 * nt + l15) * 72 + 32 * s + 8 * l4), wx = *(const LAS bf16x8*)(WxT + (16 * nt + l15) * 72 + 32 * s + 8 * l4);
                    ar[nt] = __builtin_amdgcn_mfma_f32_16x16x32_bf16(xa, wa, ar[nt], 0, 0, 0); ai[nt] = __builtin_amdgcn_mfma_f32_16x16x32_bf16(xa, wx, ai[nt], 0, 0, 0); } }
#pragma unroll
            for (int nt = 0; nt < 2; ++nt) { const int j = 16 * nt + l15; const float ba = prm[j], bx = prm[32 + j], sp8 = prm[64 + j];
#pragma unroll
                for (int i = 0; i < 4; i += 2) { const int tok = 32 * hw + 16 * mt + 4 * l4 + i;
                    const f32x2 zr = ((f32x2){ar[nt][i], ar[nt][i + 1]} + ba) * (-LOG2E), zi = ((f32x2){ai[nt][i], ai[nt][i + 1]} + bx) * (-LOG2E);
                    const f32x2 dr = (f32x2){fexp2(zr.x), fexp2(zr.y)} + 1.0f, di = (f32x2){fexp2(zi.x), fexp2(zi.y)} + 1.0f;
                    const f32x2 r = {frcp(dr.x), frcp(dr.y)}, ig = {frcp(di.x), frcp(di.y)};
                    const f32x2 la = r * (-sp8), le = la * LOG2E;
                    const f32x2 av = {fexp2(le.x), fexp2(le.y)};
                    const f32x2 x2 = la * 2.0f;
                    const f32x2 sm = -x2 * (x2 * (x2 * (x2 * 0.041666667f + 0.16666667f) + 0.5f) + 1.0f), bg = 1.0f - av * av;
                    const f32x2 m2 = {x2.x > -0.1f ? sm.x : bg.x, x2.y > -0.1f ? sm.y : bg.y};
                    const f32x2 mult = {__builtin_amdgcn_sqrtf(fmaxf(m2.x, 0.f)), __builtin_amdgcn_sqrtf(fmaxf(m2.y, 0.f))};
                    const f32x2 xv = {bf1(xcb[tok * 72 + hc * 32 + j]), bf1(xcb[(tok + 1) * 72 + hc * 32 + j])};
                    const f32x2 uv = xv * ig * mult;
                    As[tok * 32 + j] = av.x; As[(tok + 1) * 32 + j] = av.y; Us[tok * 32 + j] = uv.x; Us[(tok + 1) * 32 + j] = uv.y; } }
        }
        asm volatile("s_waitcnt vmcnt(0)" ::: "memory");
        LBAR();
        bf16_t* outp_ = YA + (size_t)(rowbase + chunk * 128 + tokE) * D + cb * 64 + hc * 32 + c0E;
        unsigned long long q0 = 0, q1 = 0, q2 = 0, q3 = 0;
        if (second) { const unsigned long long* pq = (const unsigned long long*)outp_;
            q0 = __hip_atomic_load(pq, __ATOMIC_RELAXED, __HIP_MEMORY_SCOPE_AGENT); q1 = __hip_atomic_load(pq + 1, __ATOMIC_RELAXED, __HIP_MEMORY_SCOPE_AGENT);
            q2 = __hip_atomic_load(pq + 2, __ATOMIC_RELAXED, __HIP_MEMORY_SCOPE_AGENT); q3 = __hip_atomic_load(pq + 3, __ATOMIC_RELAXED, __HIP_MEMORY_SCOPE_AGENT); }
        if (step + 1 < 34) SCAN_LOAD(step + 1);
        const int c = ht & 31, seg = ht >> 5;
        {
            float h = 0.f, P = 1.f;
#pragma unroll 8
            for (int p = seg * 16; p < seg * 16 + 16; ++p) { const int tok = half ? 127 - p : p; const float av = As[tok * 32 + c], uv = Us[tok * 32 + c];
                h = av * h + uv; P *= av; }
            segH[seg * 32 + c] = h; segP[seg * 32 + c] = P;
        }
        LBAR();
        {
            float cin = carry[(step & 1) * 32 + c];
            float sp_[7], sh_[7];
#pragma unroll
            for (int s2 = 0; s2 < 7; ++s2) { sp_[s2] = segP[s2 * 32 + c]; sh_[s2] = segH[s2 * 32 + c]; }
#pragma unroll
            for (int s2 = 0; s2 < 7; ++s2) cin = s2 < seg ? sp_[s2] * cin + sh_[s2] : cin;
            float hl = cin;
#pragma unroll 8
            for (int p = seg * 16; p < seg * 16 + 16; ++p) { const int tok = half ? 127 - p : p; hl = As[tok * 32 + c] * hl + Us[tok * 32 + c]; Us[tok * 32 + c] = hl; }
            if (seg == 7) carry[((step + 1) & 1) * 32 + c] = hl;
        }
        LBAR();
        {
            float o0[8], o1[8];
#pragma unroll
            for (int j = 0; j < 8; ++j) { o0[j] = Us[tokE * 32 + c0E + j]; o1[j] = Us[tokE * 32 + c0E + 8 + j]; }
            if (second) { float e0[8], e1[8]; u32x4 wA, wB; wA.x = (unsigned)q0; wA.y = (unsigned)(q0 >> 32); wA.z = (unsigned)q1; wA.w = (unsigned)(q1 >> 32); wB.x = (unsigned)q2; wB.y = (unsigned)(q2 >> 32); wB.z = (unsigned)q3; wB.w = (unsigned)(q3 >> 32);
                unpack8(wA, e0); unpack8(wB, e1);
#pragma unroll
                for (int j = 0; j < 8; ++j) { o0[j] += e0[j]; o1[j] += e1[j]; } }
            *(u32x4*)outp_ = pack8(o0); *(u32x4*)(outp_ + 8) = pack8(o1);
        }
    }
    asm volatile("s_waitcnt vmcnt(0)" ::: "memory");
#undef SCAN_GID
#undef SCAN_LOAD
}

DI void sgu_item(const Args& a, LAS unsigned char* lds, int l, int tc) {
    const int tid = tidx(), lane = tid & 63, w = tid >> 6, hh = lane >> 5, r32 = lane & 31;
    const int row0 = tc < 8 ? (tc >> 1) * CTX + (tc & 1) * 128 : TC + ((tc - 8) >> 5) * SEQ + ((tc - 8) & 31) * 128;
    LAS bf16_t* Wl = (LAS bf16_t*)lds;
    LAS bf16_t* Vn = (LAS bf16_t*)(lds + 34816);
    LAS float* st = (LAS float*)(lds + 75776);
    const bf16_t* ZV = (const bf16_t*)(wsp() + WS_ZV); bf16_t* ZU = (bf16_t*)(wsp() + WS_ZU);
    for (int t = w * 16; t < w * 16 + 16; ++t) {
        const bf16_t* p = ZV + (size_t)(row0 + t) * D + lane * 16;
        float x0[8], x1[8]; unpack8(*(const u32x4*)p, x0); unpack8(*(const u32x4*)(p + 8), x1);
        float s = 0.f;
#pragma unroll
        for (int j = 0; j < 8; ++j) s += x0[j] + x1[j];
        const float mean = wave_sum(s) * (1.0f / D); float q = 0.f;
#pragma unroll
        for (int j = 0; j < 8; ++j) { const float d0 = x0[j] - mean, d1 = x1[j] - mean; q += d0 * d0 + d1 * d1; }
        const float var = wave_sum(q) * (1.0f / D);
        if (lane == 0) { st[t * 2] = mean; st[t * 2 + 1] = 1.0f / sqrtf(var + EPS); }
    }
    __syncthreads();
    const int tokS = tid >> 2, cS = (tid & 3) * 32;
    const float meanS = st[tokS * 2], rstdS = st[tokS * 2 + 1];
    f32x4 wreg[8]; u32x4 vreg[4], ureg[4];
#define SGU_LOAD(g_) do { const float* ws_ = inp<17>() + ((size_t)l * 8 + (g_)) * 16384; \
        _Pragma("unroll") for (int it = 0; it < 8; ++it) wreg[it] = *(const f32x4*)(ws_ + (it * 512 + tid) * 4); \
        const bf16_t* vp_ = ZV + (size_t)(row0 + tokS) * D + (g_) * 128 + cS; const bf16_t* up_ = ZU + (size_t)(row0 + tokS) * D + (g_) * 128 + cS; \
        _Pragma("unroll") for (int q4 = 0; q4 < 4; ++q4) { vreg[q4] = *(const u32x4*)(vp_ + q4 * 8); ureg[q4] = *(const u32x4*)(up_ + q4 * 8); } } while (0)
    SGU_LOAD(0);
    for (int g = 0; g < 8; ++g) {
        u32x4 ucur[4];
        {
#pragma unroll
            for (int it = 0; it < 8; ++it) { const int idx = (it * 512 + tid) * 4; const f32x4 v = wreg[it]; const int p = idx >> 7, q = idx & 127;
                u32x2 o; o.x = pk2(v.x, v.y); o.y = pk2(v.z, v.w); *(LAS u32x2*)(Wl + p * 136 + q) = o; }
            const float* lg = inp<15>() + (size_t)l * D + g * 128 + cS; const float* lb = inp<16>() + (size_t)l * D + g * 128 + cS;
#pragma unroll
            for (int q4 = 0; q4 < 4; ++q4) { float x[8]; unpack8(vreg[q4], x);
                const f32x4 g0 = *(const f32x4*)(lg + q4 * 8), g1 = *(const f32x4*)(lg + q4 * 8 + 4), b0 = *(const f32x4*)(lb + q4 * 8), b1 = *(const f32x4*)(lb + q4 * 8 + 4);
#pragma unroll
                for (int j = 0; j < 8; ++j) { const float gg = j < 4 ? g0[j & 3] : g1[j & 3], bb = j < 4 ? b0[j & 3] : b1[j & 3]; x[j] = (x[j] - meanS) * rstdS * gg + bb; }
                *(LAS u32x4*)(Vn + tokS * 160 + cS + q4 * 8) = pack8(x); ucur[q4] = ureg[q4]; }
        }
        if (g + 1 < 8) SGU_LOAD(g + 1);
        LBAR();
        {
            const int pt = w >> 1, ch = w & 1;
            f32x16 acc[2];
#pragma unroll
            for (int i = 0; i < 16; ++i) { acc[0][i] = 0.f; acc[1][i] = 0.f; }
#pragma unroll
            for (int s = 0; s < 8; ++s) { const bf16x8 af = *(const LAS bf16x8*)(Wl + (32 * pt + r32) * 136 + 16 * s + 8 * hh);
#pragma unroll
                for (int nt = 0; nt < 2; ++nt) { const LAS bf16_t* bp = Vn + (16 * s + 8 * hh + ((lane & 15) >> 2)) * 160 + 64 * ch + 32 * nt + 16 * ((lane >> 4) & 1) + 4 * (lane & 3);
                    const bf16x8 bfr = tr_read2(bp, bp + 4 * 160); acc[nt] = MFMA32(af, bfr, acc[nt]); } }
            const float* sb = inp<18>() + ((size_t)l * 8 + g) * 128 + 32 * pt + 4 * hh;
            f32x4 sbv[4];
#pragma unroll
            for (int i4 = 0; i4 < 4; ++i4) sbv[i4] = *(const f32x4*)(sb + 8 * i4);
            LBAR();
            LAS bf16_t* Mx = Wl;
#pragma unroll
            for (int nt = 0; nt < 2; ++nt)
#pragma unroll
                for (int i = 0; i < 16; ++i) { const int pp = 32 * pt + (i & 3) + 8 * (i >> 2) + 4 * hh, c = 64 * ch + 32 * nt + r32;
                    Mx[pp * 136 + c] = f2bf(acc[nt][i] + sbv[i >> 2][i & 3]); }
            LBAR();
            bf16_t* up = ZU + (size_t)(row0 + tokS) * D + g * 128 + cS;
#pragma unroll
            for (int q4 = 0; q4 < 4; ++q4) { float uu[8], mm[8]; unpack8(ucur[q4], uu); unpack8(*(const LAS u32x4*)(Mx + tokS * 136 + cS + q4 * 8), mm);
#pragma unroll
                for (int j = 0; j < 8; ++j) uu[j] *= mm[j];
                *(u32x4*)(up + q4 * 8) = pack8(uu); }
        }
        LBAR();
    }
#undef SGU_LOAD
}

DI void attn_tile(const LAS bf16_t* Ks, const LAS bf16_t* Vt, int kb, const bf16x8 (&qf)[2][4], float (&m)[2], float (&ls)[2], f32x16 (&o)[2][2],
                  int r32, int hh, bool masked, int qloc0, int kv_lo, int kv_hi) {
    bf16x8 kf[4];
#pragma unroll
    for (int s = 0; s < 4; ++s) kf[s] = *(const LAS bf16x8*)(Ks + (kb + r32) * 72 + 16 * s + 8 * hh);
    bf16x8 pf[2][2];
#pragma unroll
    for (int qt = 0; qt < 2; ++qt) {
        f32x16 sc;
#pragma unroll
        for (int i = 0; i < 16; ++i) sc[i] = 0.f;
#pragma unroll
        for (int s = 0; s < 4; ++s) sc = MFMA32(kf[s], qf[qt][s], sc);
        if (masked) { const int ql = qloc0 + 32 * qt + r32;
#pragma unroll
            for (int i = 0; i < 16; ++i) { const int key = kb + (i & 3) + 8 * (i >> 2) + 4 * hh; const int df = key - 128 - ql;
                const bool ok = (df >= -128) && (df <= 128) && (key >= kv_lo) && (key < kv_hi); sc[i] = ok ? sc[i] : -1e30f; } }
        float mx = sc[0];
#pragma unroll
        for (int i = 1; i < 16; ++i) mx = fmaxf(mx, sc[i]);
        mx = fmaxf(mx, __shfl_xor(mx, 32));
        const float mn = fmaxf(m[qt], mx); const float alpha = fexp2(m[qt] - mn); m[qt] = mn;
        float p[16]; float rs = 0.f;
#pragma unroll
        for (int i = 0; i < 16; ++i) { p[i] = fexp2(sc[i] - mn); rs += p[i]; }
        ls[qt] = ls[qt] * alpha + rs;
        if (__any(alpha != 1.0f)) {
#pragma unroll
            for (int i = 0; i < 16; ++i) { o[qt][0][i] *= alpha; o[qt][1][i] *= alpha; } }
#pragma unroll
        for (int ks = 0; ks < 2; ++ks) { u32x4 w; w.x = pk2(p[8 * ks], p[8 * ks + 1]); w.y = pk2(p[8 * ks + 2], p[8 * ks + 3]); w.z = pk2(p[8 * ks + 4], p[8 * ks + 5]); w.w = pk2(p[8 * ks + 6], p[8 * ks + 7]);
            pf[qt][ks] = __builtin_bit_cast(bf16x8, w); }
    }
#pragma unroll
    for (int dt = 0; dt < 2; ++dt)
#pragma unroll
        for (int ks = 0; ks < 2; ++ks) { const LAS bf16_t* vp = Vt + (kb + 16 * ks + 4 * hh + ((r32 & 15) >> 2)) * 72 + 32 * dt + 16 * (r32 >> 4) + 4 * (r32 & 3);
            const bf16x8 vf = tr_read2(vp, vp + 8 * 72);
#pragma unroll
            for (int qt = 0; qt < 2; ++qt) o[qt][dt] = MFMA32(vf, pf[qt][ks], o[qt][dt]); }
}

template <bool ctxstage> DI void attn_stage(const Args& a, LAS bf16_t* Ks, LAS bf16_t* Vt, int l, int b, int n, int kvh) {
    const int tid = tidx(), e = tid & 7;
    const bf16_t* ZK = (const bf16_t*)(wsp() + WS_ZK); const bf16_t* ZVV = (const bf16_t*)(wsp() + WS_ZVV);
    const float* cosT = (const float*)(wsp() + WS_ROPE); const float* sinT = cosT + 1024;
    const float* kg = inp<20>() + l * 64 + e * 8;
    float kgv[8];
#pragma unroll
    for (int j = 0; j < 8; ++j) kgv[j] = kg[j];
    constexpr int NP = 2;
    for (int pg = 0; pg < (ctxstage ? 2 : 3); ++pg) {
    u32x4 kwa[NP], vwa[NP];
#pragma unroll
    for (int ps = 0; ps < NP; ++ps) {
        const int key = (pg * NP + ps) * 64 + (tid >> 3);
        int kt = 0, row; bool valid = true;
        if (ctxstage) row = b * CTX + key; else { kt = n * 128 - 128 + key; valid = (kt >= 0) && (kt < SEQ); kt = kt < 0 ? 0 : (kt >= SEQ ? SEQ - 1 : kt); row = TC + b * SEQ + kt; }
        kwa[ps] = (u32x4){0u, 0u, 0u, 0u}; vwa[ps] = (u32x4){0u, 0u, 0u, 0u};
        if (valid) { kwa[ps] = *(const u32x4*)(ZK + (size_t)row * 256 + kvh * 64 + e * 8); vwa[ps] = *(const u32x4*)(ZVV + (size_t)row * 256 + kvh * 64 + e * 8); }
    }
#pragma unroll
    for (int ps = 0; ps < NP; ++ps) {
        const int key = (pg * NP + ps) * 64 + (tid >> 3);
        int kt = 0;
        if (!ctxstage) { kt = n * 128 - 128 + key; kt = kt < 0 ? 0 : (kt >= SEQ ? SEQ - 1 : kt); }
        const u32x4 kw = kwa[ps], vw = vwa[ps];
        float x[8]; unpack8(kw, x);
        float ss = 0.f;
#pragma unroll
        for (int j = 0; j < 8; ++j) ss += x[j] * x[j];
        ss += __shfl_xor(ss, 1); ss += __shfl_xor(ss, 2); ss += __shfl_xor(ss, 4);
        const float rstd = 1.0f / sqrtf(ss * (1.0f / 64.0f) + EPS);
#pragma unroll
        for (int j = 0; j < 8; ++j) x[j] = x[j] * rstd * kgv[j];
        if (!ctxstage) {
            const int pos = (e >> 2) ? (kt & 63) : (kt >> 6); const bool second = (e >> 1) & 1; const int f0 = 8 * (e & 1);
#pragma unroll
            for (int j = 0; j < 8; ++j) { const float pr = __shfl_xor(x[j], 2); const float cs = cosT[pos * 16 + f0 + j], sn = sinT[pos * 16 + f0 + j];
                x[j] = second ? (x[j] * cs + pr * sn) : (x[j] * cs - pr * sn); }
        }
        *(LAS u32x4*)(Ks + key * 72 + e * 8) = pack8(x);
        *(LAS u32x4*)(Vt + key * 72 + e * 8) = vw;
    }
    }
}

DI void attn_item(const Args& a, LAS unsigned char* lds, int l, int kind, int b, int n, int kvh) {
    const int tid = tidx(), lane = tid & 63, w = tid >> 6, hh = lane >> 5, r32 = lane & 31;
    const int g = w >> 1, qhalf = w & 1, h = kvh * 4 + g, qloc0 = qhalf * 64;
    LAS bf16_t* Ks = (LAS bf16_t*)lds;
    LAS bf16_t* Vt = (LAS bf16_t*)(lds + 55296);
    bf16_t* ZQ = (bf16_t*)(wsp() + WS_ZQ);
    const float* cosT = (const float*)(wsp() + WS_ROPE); const float* sinT = cosT + 1024;
    const float* qg = inp<19>() + l * 64;
    const float SCL = 0.125f * LOG2E;
    bf16x8 qf[2][4];
#pragma unroll
    for (int qt = 0; qt < 2; ++qt) {
        const int qtok = n * 128 + qloc0 + 32 * qt + r32; const int row = kind ? b * CTX + qtok : TC + b * SEQ + qtok;
        const bf16_t* qp = ZQ + (size_t)row * D + h * 64 + 8 * hh;
        float v[4][8]; float ss = 0.f;
#pragma unroll
        for (int s = 0; s < 4; ++s) { unpack8(*(const u32x4*)(qp + 16 * s), v[s]);
#pragma unroll
            for (int j = 0; j < 8; ++j) ss += v[s][j] * v[s][j]; }
        ss += __shfl_xor(ss, 32);
        const float rstd = 1.0f / sqrtf(ss * (1.0f / 64.0f) + EPS);
#pragma unroll
        for (int s = 0; s < 4; ++s)
#pragma unroll
            for (int j = 0; j < 8; ++j) v[s][j] = v[s][j] * rstd * qg[16 * s + 8 * hh + j];
        if (!kind) { const int prow = qtok >> 6, pcol = qtok & 63;
#pragma unroll
            for (int j = 0; j < 8; ++j) { const int f = 8 * hh + j;
                const float c0 = cosT[prow * 16 + f], s0 = sinT[prow * 16 + f], c1 = cosT[pcol * 16 + f], s1 = sinT[pcol * 16 + f];
                const float t1 = v[0][j], t2 = v[1][j]; v[0][j] = t1 * c0 - t2 * s0; v[1][j] = t2 * c0 + t1 * s0;
                const float t3 = v[2][j], t4 = v[3][j]; v[2][j] = t3 * c1 - t4 * s1; v[3][j] = t4 * c1 + t3 * s1; } }
#pragma unroll
        for (int s = 0; s < 4; ++s) {
#pragma unroll
            for (int j = 0; j < 8; ++j) v[s][j] *= SCL;
            qf[qt][s] = __builtin_bit_cast(bf16x8, pack8(v[s])); }
    }
    const float sk = inp<21>()[l * 16 + h] * LOG2E;
    float m[2] = {sk, sk}; float ls[2]; ls[0] = ls[1] = (hh == 0) ? 1.0f : 0.0f;
    f32x16 o[2][2];
#pragma unroll
    for (int i = 0; i < 16; ++i) { o[0][0][i] = 0.f; o[0][1][i] = 0.f; o[1][0][i] = 0.f; o[1][1][i] = 0.f; }
    if (!kind) {
        attn_stage<false>(a, Ks, Vt, l, b, n, kvh);
        __syncthreads();
        const int kv_lo = 128 - n * 128 > 0 ? 128 - n * 128 : 0; const int kv_hi = (SEQ - n * 128 + 128) < 384 ? (SEQ - n * 128 + 128) : 384;
        int t_lo = qhalf ? 2 : 0, t_hi = qhalf ? 12 : 10;
        if (t_lo < (kv_lo >> 5)) t_lo = kv_lo >> 5;
        if (t_hi > (kv_hi >> 5)) t_hi = kv_hi >> 5;
        for (int t = t_lo; t < t_hi; ++t) { const int kb = 32 * t; const bool interior = (kb >= qloc0 + 63) && (kb <= qloc0 + 225) && (kb >= kv_lo) && (kb + 32 <= kv_hi);
            attn_tile(Ks, Vt, kb, qf, m, ls, o, r32, hh, !interior, qloc0, kv_lo, kv_hi); }
        __syncthreads();
    }
    attn_stage<true>(a, Ks, Vt, l, b, n, kvh);
    __syncthreads();
    for (int t = 0; t < 8; ++t) attn_tile(Ks, Vt, 32 * t, qf, m, ls, o, r32, hh, false, qloc0, 0, 256);
#pragma unroll
    for (int qt = 0; qt < 2; ++qt) {
        const float lt = ls[qt] + __shfl_xor(ls[qt], 32); const float inv = 1.0f / lt;
        const int qtok = n * 128 + qloc0 + 32 * qt + r32; const int row = kind ? b * CTX + qtok : TC + b * SEQ + qtok;
        bf16_t* op = ZQ + (size_t)row * D + h * 64 + 4 * hh;
#pragma unroll
        for (int dt = 0; dt < 2; ++dt)
#pragma unroll
            for (int q4 = 0; q4 < 4; ++q4) { u32x2 wv; wv.x = pk2(o[qt][dt][4 * q4] * inv, o[qt][dt][4 * q4 + 1] * inv); wv.y = pk2(o[qt][dt][4 * q4 + 2] * inv, o[qt][dt][4 * q4 + 3] * inv);
                *(u32x2*)(op + 32 * dt + 8 * q4) = wv; }
    }
}

DI void phase_mix(const Args& a, LAS unsigned char* lds, int l) {
    const int tid = tidx();
    const bool last = (l == DEPTH - 1);
    unsigned* ctr = (unsigned*)(wsp() + WS_CTL) + l;
    LAS int* slot = (LAS int*)(lds + LDS_MISC);
    const int n_scan = 128, n_attl = 512, n_attc = last ? 0 : 32, n_sgu = last ? 128 : 136;
    const int total = n_scan + n_attl + n_attc + n_sgu;
    for (;;) {
        __syncthreads();
        if (tid == 0) *slot = (int)atomicAdd(ctr, 1u);
        __syncthreads();
        int it = *slot;
        if (it >= total) break;
#ifndef NO_SCAN
#ifdef PROBE_K
        const unsigned long long pt0 = __builtin_amdgcn_s_memrealtime();
#define PT_END(k, mx) do { if (tid == 0) { const unsigned dt = (unsigned)(__builtin_amdgcn_s_memrealtime() - pt0); if (mx) atomicMax((unsigned*)(wsp() + WS_CTL) + 128 + (k), dt); else atomicAdd((unsigned*)(wsp() + WS_CTL) + 128 + (k), dt); } } while (0)
#else
#define PT_END(k, mx) do {} while (0)
#endif
        if (it < n_scan) { scan_item(a, lds, l, it >> 5, (it >> 1) & 15, it & 1); PT_END(0, 1); continue; }
#endif
        it -= n_scan;
#ifndef NO_ATT
        if (it < n_attl) { attn_item(a, lds, l, 0, it >> 7, (it >> 2) & 31, it & 3); PT_END(1, 0); continue; }
#endif
        it -= n_attl;
#ifndef NO_ATT
        if (it < n_attc) { attn_item(a, lds, l, 1, it >> 3, (it >> 2) & 1, it & 3); PT_END(3, 0); continue; }
#endif
        it -= n_attc;
#ifndef NO_SGU
        sgu_item(a, lds, l, last ? it + 8 : it);
#endif
        PT_END(2, 0);
    }
}


DI void grid_barrier(unsigned* bar, unsigned target) {
    asm volatile("s_waitcnt vmcnt(0) lgkmcnt(0)" ::: "memory");
    __syncthreads();
    if (threadIdx.x == 0) {
        __builtin_amdgcn_fence(__ATOMIC_RELEASE, "agent");
        __hip_atomic_fetch_add(bar, 1u, __ATOMIC_RELAXED, __HIP_MEMORY_SCOPE_AGENT);
        while (__hip_atomic_load(bar, __ATOMIC_RELAXED, __HIP_MEMORY_SCOPE_AGENT) < target) __builtin_amdgcn_s_sleep(2);
        __builtin_amdgcn_fence(__ATOMIC_ACQUIRE, "agent");
    }
    __syncthreads();
}


#ifdef DBG_STOP
DI void dbg_dump(int which) {
    unsigned char* ws = wsp(); float* out = outp();
    const size_t n = (size_t)TL * D, stride = (size_t)gridDim.x * 512;
    const bf16_t* H = (const bf16_t*)(ws + WS_H); const bf16_t* MG = (const bf16_t*)(ws + WS_MG);
    const bf16_t* ZA = (const bf16_t*)(ws + WS_ZA); const bf16_t* ZU = (const bf16_t*)(ws + WS_ZU); const bf16_t* ZV = (const bf16_t*)(ws + WS_ZV); const bf16_t* ZQ = (const bf16_t*)(ws + WS_ZQ);
    const bf16_t* ZK = (const bf16_t*)(ws + WS_ZK); const bf16_t* ZVV = (const bf16_t*)(ws + WS_ZVV); const bf16_t* ZG = (const bf16_t*)(ws + WS_ZG);
    for (size_t i = (size_t)blockIdx.x * 512 + threadIdx.x; i < n; i += stride) {
        float v = 0.f;
        if (which == 1) v = bf1(H[i]) + bf1(H[i + (size_t)TC * D]);
        if (which == 2) v = bf1(ZA[i]) + bf1(ZU[i]) + bf1(ZV[i]) + bf1(ZQ[i]) + bf1(ZG[i]) + bf1(ZG[i + n]) + bf1(ZG[i + 2 * n]) + bf1(ZK[i % ((size_t)T * 256)]) + bf1(ZVV[i % ((size_t)T * 256)]) + bf1(ZA[i + (size_t)TC * D]);
        if (which == 3) v = bf1(H[i + (size_t)TC * D]);
        if (which == 4) v = bf1(ZU[i + (size_t)TC * D]);
        if (which == 5) v = bf1(ZQ[i + (size_t)TC * D]);
        if (which == 6) v = bf1(MG[i + (size_t)TC * D]);
        if (which == 7) v = bf1(H[i]) + bf1(ZU[i]) + bf1(ZQ[i]);
        out[i] = v;
    }
}
#endif

__global__ void __launch_bounds__(512, 2) fwd_megakernel(Args a) {
    extern __shared__ __attribute__((aligned(16))) unsigned char shm[];
    LAS unsigned char* lds = (LAS unsigned char*)shm;
    unsigned* gbar = (unsigned*)(wsp() + WS_CTL) + 64; unsigned nbar = 0;
#define GRID_SYNC() do { ++nbar; grid_barrier(gbar, nbar * (unsigned)G); } while (0)
#ifdef PROBE_K
    unsigned long long pr_prev = __builtin_amdgcn_s_memrealtime(), pr_acc = 0;
#define PROBE(k) do { const unsigned long long now_ = __builtin_amdgcn_s_memrealtime(); if ((k) == PROBE_K || PROBE_K == 99) pr_acc += now_ - pr_prev; pr_prev = now_; } while (0)
#else
#define PROBE(k) do {} while (0)
#endif
    const int G = gridDim.x;
    unsigned char* ws = wsp();

#if !defined(ONLY) || ONLY == 0
    phase_prep(a, lds);
#endif
    GRID_SYNC();
    PROBE(0);
    for (int l = 0; l < DEPTH; ++l) {
        const bool last = (l == DEPTH - 1);
        const int pm0 = last ? 4 : 0, nM = last ? 64 : 68;
        const float* modl = (const float*)(ws + WS_MOD) + (size_t)l * 5 * 6144;
        const size_t wto = (size_t)(l & 1) * WT_BYTES;
#if !defined(ONLY) || ONLY == 1
        phase_norm(a, lds, l, 0);
#endif
        GRID_SYNC();
    PROBE(1);
#if defined(DBG_STOP) && DBG_STOP == 1
        dbg_dump(1); return;
#endif
        {
            pg8::Sched S; S.nM = 68; S.nN = INW / 256; S.nwg = S.nM * S.nN; S.G = G; S.c = bidx(); S.nseg = 1; S.pm0 = 0;
            S.A0 = (const char*)(ws + WS_H); S.d1 = 0; S.d2 = 0; S.B0 = (const char*)(ws + wto + WS_WIN); S.bseg = 0; S.tstep = (size_t)256 * D * 2;
            pg8::EpiIn E{ws};
            pg8::gemm_phase<pg8::EpiIn, pg8::Sched>(lds, D, D, S, E);
        }
        GRID_SYNC();
    PROBE(2);
#if defined(DBG_STOP) && DBG_STOP == 2
        dbg_dump(2); return;
#endif
        phase_mix(a, lds, l);
        GRID_SYNC();
    PROBE(3);
#if defined(DBG_STOP) && DBG_STOP >= 3 && DBG_STOP <= 5
        dbg_dump(DBG_STOP); return;
#endif
#if defined(DBG_STOP) && DBG_STOP == 7
        dbg_dump(7); return;
#endif
        {
            pg8::Sched S; S.nM = 64; S.nN = 4; S.nwg = S.nM * S.nN; S.G = G; S.c = bidx(); S.nseg = 3; S.pm0 = 4;
            S.A0 = (const char*)(ws + WS_H); S.d1 = 2 * SLOT; S.d2 = 2 * SLOT; S.B0 = (const char*)(ws + wto + WS_WBR); S.bseg = (size_t)D * D * 2; S.tstep = (size_t)256 * D * 2;
            pg8::EpiMerge E{(bf16_t*)(ws + WS_MG), (const bf16_t*)(ws + WS_ZG)};
            pg8::gemm_phase<pg8::EpiMerge, pg8::Sched>(lds, D, D, S, E);
        }
        if (!last) {
            pg8::SchedList S; S.n = 48; S.G = G; S.c = bidx(); S.nN = 4; S.nS = 3; S.nQ = 1;
            S.A0 = (const char*)(ws + WS_H); S.a_pm = (size_t)256 * D * 2; S.a_s = 2 * SLOT; S.a_q = 0;
            S.B0 = (const char*)(ws + wto + WS_WBR); S.b_pn = (size_t)256 * D * 2; S.b_s = (size_t)D * D * 2; S.b_q = 0;
            pg8::EpiMergeCtx E{(bf16_t*)(ws + WS_PC), (const bf16_t*)(ws + WS_ZG)};
            pg8::gemm_phase<pg8::EpiMergeCtx, pg8::SchedList>(lds, D, D, S, E);
        }
        GRID_SYNC();
    PROBE(4);
#if defined(DBG_STOP) && DBG_STOP == 6
        dbg_dump(6); return;
#endif
        {
            pg8::Sched S; S.nM = 64; S.nN = 4; S.nwg = S.nM * S.nN; S.G = G; S.c = bidx(); S.nseg = 1; S.pm0 = 4;
            S.A0 = (const char*)(ws + WS_MG); S.d1 = 0; S.d2 = 0; S.B0 = (const char*)(ws + wto + WS_WOUT); S.bseg = 0; S.tstep = (size_t)256 * D * 2;
            pg8::EpiRes E{(const float*)(ws + WS_XC), l == 0 ? inp<0>() : (const float*)outp(), (float*)(ws + WS_XC), outp(), modl + 2 * 1024};
            pg8::gemm_phase<pg8::EpiRes, pg8::Sched>(lds, D, D, S, E);
        }
        if (!last) {
            pg8::SchedList S; S.n = 192; S.G = G; S.c = bidx(); S.nN = 4; S.nS = 3; S.nQ = 4;
            S.A0 = (const char*)(ws + WS_PC); S.a_pm = (size_t)256 * D * 2; S.a_s = (size_t)TC * D * 2; S.a_q = 256 * 2;
            S.B0 = (const char*)(ws + wto + WS_WOUT); S.b_pn = (size_t)256 * D * 2; S.b_s = 0; S.b_q = 256 * 2;
            pg8::EpiPartial E{(float*)(ws + WS_PX), 4};
            pg8::gemm_phase<pg8::EpiPartial, pg8::SchedList>(lds, 256, D, S, E);
        }
        GRID_SYNC();
    PROBE(5);
        phase_norm(a, lds, l, 1);
        GRID_SYNC();
    PROBE(6);
        {
            pg8::Sched S; S.nM = nM; S.nN = DFF / 256; S.nwg = S.nM * S.nN; S.G = G; S.c = bidx(); S.nseg = 1; S.pm0 = pm0;
            S.A0 = (const char*)(ws + WS_H); S.d1 = 0; S.d2 = 0; S.B0 = (const char*)(ws + wto + WS_WFF1); S.bseg = 0; S.tstep = (size_t)256 * D * 2;
            pg8::EpiFF1 E{(bf16_t*)(ws + WS_HID)};
            pg8::gemm_phase<pg8::EpiFF1, pg8::Sched>(lds, D, D, S, E);
        }
        GRID_SYNC();
    PROBE(7);
        {
            pg8::Sched S; S.nM = 64; S.nN = 4; S.nwg = S.nM * S.nN; S.G = G; S.c = bidx(); S.nseg = 1; S.pm0 = 4;
            S.A0 = (const char*)(ws + WS_HID); S.d1 = 0; S.d2 = 0; S.B0 = (const char*)(ws + wto + WS_WFF2); S.bseg = 0; S.tstep = (size_t)256 * DFF * 2;
            pg8::EpiRes E{(const float*)(ws + WS_XC), (const float*)outp(), (float*)(ws + WS_XC), outp(), modl + 5 * 1024};
            pg8::gemm_phase<pg8::EpiRes, pg8::Sched>(lds, DFF, DFF, S, E);
        }
        if (!last) {
            pg8::SchedList S; S.n = 64; S.G = G; S.c = bidx(); S.nN = 4; S.nS = 1; S.nQ = 4;
            S.A0 = (const char*)(ws + WS_HID); S.a_pm = (size_t)256 * DFF * 2; S.a_s = 0; S.a_q = 1024 * 2;
            S.B0 = (const char*)(ws + wto + WS_WFF2); S.b_pn = (size_t)256 * DFF * 2; S.b_s = 0; S.b_q = 1024 * 2;
            pg8::EpiPartial E{(float*)(ws + WS_PX), 4};
            pg8::gemm_phase<pg8::EpiPartial, pg8::SchedList>(lds, 1024, DFF, S, E);
        }
        if (!last && G > 64) { const int bq = bidx(); if (bq >= 64) convert_weights(l + 1, (size_t)((l + 1) & 1) * WT_BYTES, lds, bq - 64, G - 64, tidx()); }
        else if (!last) convert_weights(l + 1, (size_t)((l + 1) & 1) * WT_BYTES, lds, bidx(), G, tidx());
#ifdef PROBE_K
        GRID_SYNC();
#else
        if (!last) GRID_SYNC();
#endif
    PROBE(8);
    }
#ifdef PROBE_K
    if (blockIdx.x == 0 && threadIdx.x == 0) { float pv = (float)pr_acc * 0.01f; if (PROBE_K >= 30 && PROBE_K < 40) pv = (float)(((unsigned*)(wsp() + WS_CTL))[128 + PROBE_K - 30]) * 0.01f; { const float sc_ = exp10f(floorf(log10f(fmaxf(pv, 1.0f))) - 1.0f); pv = floorf(pv / sc_ + 0.5f) * sc_; } outp()[0] += pv; }
#endif
}

extern "C" void kernel_launch(void* const* d_in, const int* in_sizes, int n_in, void* d_out, int out_size, void* d_ws, size_t ws_size, hipStream_t stream) {
    static int grid = 0;
    if (grid == 0) {
        if (n_in != 27 || out_size != TL * D || ws_size < WS_END) { fprintf(stderr, "kernel_launch: unexpected shapes (n_in %d out %d ws %zu need %zu)\n", n_in, out_size, ws_size, (size_t)WS_END); grid = -1; return; }
        int dev = 0, cus = 0, per_cu = 0;
        hipGetDevice(&dev);
        hipDeviceGetAttribute(&cus, hipDeviceAttributeMultiprocessorCount, dev);
        hipFuncSetAttribute((const void*)fwd_megakernel, hipFuncAttributeMaxDynamicSharedMemorySize, LDS_BYTES);
        hipOccupancyMaxActiveBlocksPerMultiprocessor(&per_cu, (const void*)fwd_megakernel, 512, LDS_BYTES);
        if (per_cu < 1) { fprintf(stderr, "kernel_launch: occupancy query says %d blocks/CU\n", per_cu); per_cu = 1; }
        (void)hipGetLastError();
        grid = cus;
    }
    if (grid < 0) return;
    if (hipMemsetAsync((char*)d_ws + WS_CTL, 0, 4096, stream) != hipSuccess) { fprintf(stderr, "memset failed\n"); return; }
    Args a{};
    for (int i = 0; i < 27; ++i) a.in[i] = (const float*)d_in[i];
    a.out = (float*)d_out; a.ws = (unsigned char*)d_ws;
    void* args[] = {&a};
    hipError_t e = hipLaunchCooperativeKernel((const void*)fwd_megakernel, dim3(grid), dim3(512), args, LDS_BYTES, stream);
    if (e != hipSuccess) fprintf(stderr, "cooperative launch failed: %s (grid %d)\n", hipGetErrorString(e), grid);
}
```

```cpp
#define DBG_NOADD 0
#include <hip/hip_runtime.h>
#include <hip/hip_cooperative_groups.h>
#include <cstdio>
#include <cstdint>
namespace cg = cooperative_groups;

#define LAS __attribute__((address_space(3)))
#define DI __device__ __forceinline__
typedef unsigned short bf16_t;
typedef short bf16x8 __attribute__((ext_vector_type(8)));
typedef short s16x4 __attribute__((ext_vector_type(4)));
typedef float f32x2 __attribute__((ext_vector_type(2)));
typedef float f32x4 __attribute__((ext_vector_type(4)));
typedef float f32x16 __attribute__((ext_vector_type(16)));
typedef unsigned u32x2 __attribute__((ext_vector_type(2)));
typedef unsigned u32x4 __attribute__((ext_vector_type(4)));
typedef __bf16 bf16x2_t __attribute__((ext_vector_type(2)));

constexpr int D = 1024, NB = 4, SEQ = 4096, CTX = 256, DEPTH = 4, DFF = 4096;
constexpr int TC = NB * CTX;
constexpr int TL = NB * SEQ;
constexpr int T = TC + TL;
constexpr int INW = 7680;
constexpr float EPS = 1e-6f;
constexpr float LOG2E = 1.4426950408889634f;

constexpr size_t WS_CTL = 0;
constexpr size_t WS_ROPE = 4096;
constexpr size_t WS_MOD = 65536;
constexpr size_t WS_XC = 1u << 20;
constexpr size_t WS_WIN = 5u << 20;
constexpr size_t WS_WBR = WS_WIN + (size_t)INW * D * 2;
constexpr size_t WS_WOUT = WS_WBR + (size_t)3 * D * D * 2;
constexpr size_t WS_WFF1 = WS_WOUT + (size_t)D * D * 2;
constexpr size_t WS_WFF2 = WS_WFF1 + (size_t)DFF * D * 2;
constexpr size_t SLOT = (size_t)T * D * 2;
constexpr size_t WT_BYTES = WS_WFF2 + (size_t)DFF * D * 2 - WS_WIN;
constexpr size_t WS_H = WS_WIN + 2 * WT_BYTES;
constexpr size_t WS_ZV = WS_H + SLOT;
constexpr size_t WS_ZU = WS_H + 2 * SLOT;
constexpr size_t WS_ZA = WS_H + 3 * SLOT;
constexpr size_t WS_ZQ = WS_H + 4 * SLOT;
constexpr size_t WS_ZK = WS_H + 5 * SLOT;
constexpr size_t WS_ZVV = WS_ZK + (size_t)T * 256 * 2;
constexpr size_t WS_ZG = WS_ZVV + (size_t)T * 256 * 2;
constexpr size_t WS_MG = WS_ZG + (size_t)T * 3072 * 2;
constexpr size_t WS_PC = WS_MG + SLOT;
constexpr size_t WS_PX = WS_PC + (size_t)3 * TC * D * 2;
constexpr size_t WS_END = WS_PX + (size_t)12 * TC * D * 4;
constexpr size_t WS_HID = WS_ZV;

constexpr int LDS_BYTES = 147456;
constexpr int LDS_MISC = 143360;

struct Args { const float* in[27]; float* out; unsigned char* ws; };


template <int OFF> DI const void* kargp() { const unsigned long long k = (unsigned long long)__builtin_amdgcn_kernarg_segment_ptr(); const void* p;
    asm volatile("s_load_dwordx2 %0, %1, %2\n\ts_waitcnt lgkmcnt(0)" : "=s"(p) : "s"(k), "n"(OFF) : "memory"); return p; }
template <int I> DI const float* inp() { return (const float*)kargp<I * 8>(); }
DI float* outp() { return (float*)kargp<27 * 8>(); }
DI unsigned char* wsp() { return (unsigned char*)kargp<28 * 8>(); }
DI int tidx() { int t = threadIdx.x; asm volatile("" : "+v"(t)); return t; }
DI int bidx() { int b = blockIdx.x; asm volatile("" : "+s"(b)); return b; }

DI unsigned pk2(float lo, float hi) { f32x2 v = {lo, hi}; bf16x2_t b = __builtin_convertvector(v, bf16x2_t); return __builtin_bit_cast(unsigned, b); }
DI float bflo(unsigned w) { return __uint_as_float(w << 16); }
DI float bfhi(unsigned w) { return __uint_as_float(w & 0xffff0000u); }
DI float bf1(bf16_t h) { return __uint_as_float(((unsigned)h) << 16); }
DI bf16_t f2bf(float f) { return (bf16_t)(pk2(f, 0.f) & 0xffffu); }
DI float fexp2(float x) { return __builtin_amdgcn_exp2f(x); }
DI float frcp(float x) { return __builtin_amdgcn_rcpf(x); }
DI float sigmoidf_(float x) { return frcp(1.0f + fexp2(-x * LOG2E)); }
DI float gelu_tanh(float x) { const float u = x + 0.044715f * x * x * x; return x * frcp(1.0f + fexp2(-1.5957691216f * LOG2E * u)); }
DI float wave_sum(float v) {
#pragma unroll
    for (int o = 1; o < 64; o <<= 1) v += __shfl_xor(v, o);
    return v;
}
DI void unpack8(const u32x4 w, float (&v)[8]) { v[0] = bflo(w.x); v[1] = bfhi(w.x); v[2] = bflo(w.y); v[3] = bfhi(w.y); v[4] = bflo(w.z); v[5] = bfhi(w.z); v[6] = bflo(w.w); v[7] = bfhi(w.w); }
DI u32x4 pack8(const float (&v)[8]) { u32x4 w; w.x = pk2(v[0], v[1]); w.y = pk2(v[2], v[3]); w.z = pk2(v[4], v[5]); w.w = pk2(v[6], v[7]); return w; }
typedef short v4i16_t __attribute__((ext_vector_type(4)));
DI bf16x8 tr_read2(const LAS bf16_t* p0, const LAS bf16_t* p1) {
    const v4i16_t a = __builtin_amdgcn_ds_read_tr16_b64_v4i16((LAS v4i16_t*)p0), b = __builtin_amdgcn_ds_read_tr16_b64_v4i16((LAS v4i16_t*)p1);
    bf16x8 r; r[0] = a[0]; r[1] = a[1]; r[2] = a[2]; r[3] = a[3]; r[4] = b[0]; r[5] = b[1]; r[6] = b[2]; r[7] = b[3]; return r;
}
#define MFMA32(a, b, c) __builtin_amdgcn_mfma_f32_32x32x16_bf16((a), (b), (c), 0, 0, 0)

namespace pg8 {
constexpr int BM = 256, BK = 64, HALF = 128, HTB = HALF * BK * 2, STAGE_BYTES = 8 * HTB, NXCD = 8, WGM = 8;
DI int lds_byte(int r, int c) { const int st = (r >> 4) * 2 + (c >> 5), rr = r & 15, cc = c & 31, ob = rr * 64 + cc * 2; return st * 1024 + (ob ^ (((ob >> 9) & 1) << 5)); }
DI void stage_rc(int b, int& R, int& C) { const int st = b / 1024, sb = b % 1024, swz = sb ^ (((sb >> 9) & 1) << 5); R = (st >> 1) * 16 + swz / 64; C = (st & 1) * 32 + (swz % 64) / 2; }
DI int perm32(int rho) { const int n = rho >> 4, i = rho & 15; return 8 * (i >> 2) + 4 * n + (i & 3); }

struct Unit { int pm, pn, seg, q; const char* A; const char* B; };

struct Sched {
    int nM, nN, nwg, G, c, nseg, pm0;
    const char *A0, *B0; size_t d1, d2, bseg, tstep;
    DI bool next(int i, Unit& u) const {
        int ti = i, seg = 0;
        if (nseg == 3) { ti = i / 3; seg = i - 3 * ti; }
        const long L = (long)ti * G + c; if (L >= nwg) return false;
        int wgid = (int)L; { const int q = nwg / NXCD, r = nwg % NXCD, xcd = wgid % NXCD, off = wgid / NXCD; wgid = (xcd < r ? xcd * (q + 1) : r * (q + 1) + (xcd - r) * q) + off; }
        const int nig = WGM * nN, gid = wgid / nig, fm = gid * WGM, gsz = (nM - fm) < WGM ? (nM - fm) : WGM;
        u.pm = pm0 + fm + ((wgid % nig) % gsz); u.pn = (wgid % nig) / gsz; u.seg = seg; u.q = 0;
        const size_t ao = (seg >= 1 ? d1 : (size_t)0) + (seg >= 2 ? d2 : (size_t)0);
        u.A = A0 + ao + (size_t)u.pm * tstep; u.B = B0 + (size_t)seg * bseg + (size_t)u.pn * tstep;
        return true;
    }
};

struct SchedList {
    int n, G, c, nN, nS, nQ; const char *A0, *B0; size_t a_pm, a_s, a_q, b_pn, b_s, b_q;
    DI bool next(int i, Unit& u) const {
        const int idx = i * G + c; if (idx >= n) return false;
        const int q = idx % nQ; int t = idx / nQ; const int sg = t % nS; t /= nS; const int pn = t % nN, pm = t / nN;
        u.pm = pm; u.pn = pn; u.seg = sg; u.q = q;
        u.A = A0 + (size_t)pm * a_pm + (size_t)sg * a_s + (size_t)q * a_q; u.B = B0 + (size_t)pn * b_pn + (size_t)sg * b_s + (size_t)q * b_q;
        return true;
    }
};

template <class Epi, class SchedT>
DI void gemm_phase(LAS unsigned char* lds, const int K, const int pitch, const SchedT& S, const Epi& E) {
    const int tid = tidx(), wid = __builtin_amdgcn_readfirstlane(tid >> 6), lane = tid & 63, wr = wid >> 2, wc = wid & 3, fr = lane & 15, fq = lane >> 4;
    const int nt = K / BK;
    unsigned voffA[2], voffB[2];
#pragma unroll
    for (int i = 0; i < 2; ++i) { int R, C; stage_rc(tid * 16 + i * 8192, R, C); const int Rb = Epi::PERM ? ((R & ~31) + perm32(R & 31)) : R;
        voffA[i] = (unsigned)(R * pitch + C) * 2u; voffB[i] = (unsigned)(Rb * pitch + C) * 2u; }
    const size_t kstep = (size_t)(BK * 2);
    const size_t hstep = (size_t)HALF * pitch * 2;
    const unsigned ldsw = (unsigned)wid * 1024u;
    const int aoff = lds_byte(wr * 64 + fr, fq * 8), boff = lds_byte(wc * 32 + fr, fq * 8);
#define PG8_SA(b, h) (((b) * 2 + (h)) * HTB)
#define PG8_SB(b, h) ((4 + (b) * 2 + (h)) * HTB)
#define PG8_STAGE(bufoff, gbase, voff) do { _Pragma("unroll") for (int _i = 0; _i < 2; ++_i) \
        __builtin_amdgcn_global_load_lds((const unsigned*)((const char*)(gbase) + (voff)[_i]), (LAS unsigned*)(lds + (bufoff) + ldsw + _i * 8192), 16, 0, 0); } while (0)
#define PG8_LDA(dst, b, h) do { _Pragma("unroll") for (int m = 0; m < 4; ++m) _Pragma("unroll") for (int k = 0; k < 2; ++k) dst[m][k] = *(const LAS bf16x8*)(lds + PG8_SA(b, h) + aoff + m * 2048 + k * 1024); } while (0)
#define PG8_LDB(dst, b, h) do { _Pragma("unroll") for (int n = 0; n < 2; ++n) _Pragma("unroll") for (int k = 0; k < 2; ++k) dst[n][k] = *(const LAS bf16x8*)(lds + PG8_SB(b, h) + boff + n * 2048 + k * 1024); } while (0)
#define PG8_MMA(ai, bj, At, Bt) do { __builtin_amdgcn_s_setprio(1); _Pragma("unroll") for (int m = 0; m < 4; ++m) _Pragma("unroll") for (int n = 0; n < 2; ++n) _Pragma("unroll") for (int k = 0; k < 2; ++k) \
        acc[ai][bj][m][n] = __builtin_amdgcn_mfma_f32_16x16x32_bf16(Bt[n][k], At[m][k], acc[ai][bj][m][n], 0, 0, 0); __builtin_amdgcn_s_setprio(0); } while (0)
#define PG8_WAIT_V(n) asm volatile("s_waitcnt vmcnt(" #n ")" ::: "memory")
#define PG8_WAIT_L(n) asm volatile("s_waitcnt lgkmcnt(" #n ")" ::: "memory")
#define PG8_BAR __builtin_amdgcn_s_barrier()
#define PG8_SCHED __builtin_amdgcn_sched_barrier(0)
    Unit cur, nxt; int ui = 0;
    if (!S.next(0, cur)) return;
    f32x4 acc[2][2][4][2];
#pragma unroll
    for (int a = 0; a < 2; ++a)
#pragma unroll
        for (int b = 0; b < 2; ++b)
#pragma unroll
            for (int m = 0; m < 4; ++m)
#pragma unroll
                for (int n = 0; n < 2; ++n) acc[a][b][m][n] = (f32x4){0.f, 0.f, 0.f, 0.f};
    bf16x8 At[4][2], B0[2][2], B1[2][2];
    const char* cA = cur.A; const char* cB = cur.B;
    PG8_STAGE(PG8_SB(0, 0), cB, voffB); PG8_STAGE(PG8_SA(0, 0), cA, voffA); PG8_STAGE(PG8_SB(0, 1), cB + hstep, voffB); PG8_STAGE(PG8_SA(0, 1), cA + hstep, voffA);
    if (wr == 1) PG8_BAR;
    PG8_WAIT_V(4); PG8_BAR;
    PG8_STAGE(PG8_SB(1, 0), cB + kstep, voffB); PG8_STAGE(PG8_SA(1, 0), cA + kstep, voffA); PG8_STAGE(PG8_SB(1, 1), cB + hstep + kstep, voffB);
    PG8_WAIT_V(6); PG8_BAR;
    for (;;) {
        const bool has_next = S.next(ui + 1, nxt);
        const char* nA = has_next ? nxt.A : cA; const char* nB = has_next ? nxt.B : cB;
        for (int t = 0; t < nt; t += 2) {
            const bool last = (t == nt - 2);
            const char* a1 = cA + (size_t)(t + 1) * kstep;
            const char* a2 = last ? nA : cA + (size_t)(t + 2) * kstep; const char* b2 = last ? nB : cB + (size_t)(t + 2) * kstep;
            const char* a3 = a2 + kstep; const char* b3 = b2 + kstep;
            PG8_LDB(B0, 0, 0); PG8_SCHED; PG8_LDA(At, 0, 0); PG8_STAGE(PG8_SA(1, 1), a1 + hstep, voffA);
            PG8_WAIT_L(8); PG8_BAR; PG8_WAIT_L(0); PG8_MMA(0, 0, At, B0); PG8_BAR; PG8_SCHED;
            PG8_LDB(B1, 0, 1); PG8_STAGE(PG8_SB(0, 0), b2, voffB);
            PG8_BAR; PG8_WAIT_L(0); PG8_MMA(0, 1, At, B1); PG8_BAR;
            PG8_LDA(At, 0, 1); PG8_STAGE(PG8_SA(0, 0), a2, voffA);
            PG8_BAR; PG8_WAIT_L(0); PG8_MMA(1, 0, At, B0); PG8_BAR; PG8_SCHED;
            PG8_STAGE(PG8_SB(0, 1), b2 + hstep, voffB);
            PG8_WAIT_V(6); PG8_BAR; PG8_MMA(1, 1, At, B1); PG8_BAR;
            PG8_LDB(B0, 1, 0); PG8_SCHED; PG8_LDA(At, 1, 0); PG8_STAGE(PG8_SA(0, 1), a2 + hstep, voffA);
            PG8_WAIT_L(8); PG8_BAR; PG8_WAIT_L(0); PG8_MMA(0, 0, At, B0); PG8_BAR; PG8_SCHED;
            PG8_LDB(B1, 1, 1); PG8_STAGE(PG8_SB(1, 0), b3, voffB);
            PG8_BAR; PG8_WAIT_L(0); PG8_MMA(0, 1, At, B1); PG8_BAR;
            PG8_LDA(At, 1, 1); PG8_STAGE(PG8_SA(1, 0), a3, voffA);
            PG8_BAR; PG8_WAIT_L(0); PG8_MMA(1, 0, At, B0); PG8_BAR; PG8_SCHED;
            PG8_STAGE(PG8_SB(1, 1), b3 + hstep, voffB);
            PG8_WAIT_V(6); PG8_BAR; PG8_MMA(1, 1, At, B1); PG8_BAR;
        }
        E(acc, cur, wr, wc, fr, fq);
        if (!has_next) break;
        if (!Epi::KEEP || nxt.seg == 0) {
#pragma unroll
        for (int a = 0; a < 2; ++a)
#pragma unroll
            for (int b = 0; b < 2; ++b)
#pragma unroll
                for (int m = 0; m < 4; ++m)
#pragma unroll
                    for (int n = 0; n < 2; ++n) acc[a][b][m][n] = (f32x4){0.f, 0.f, 0.f, 0.f};
        }
        cur = nxt; cA = nA; cB = nB; ++ui;
    }
    PG8_WAIT_V(0);
    if (wr == 0) PG8_BAR;
    PG8_BAR;
#undef PG8_SA
#undef PG8_SB
#undef PG8_STAGE
#undef PG8_LDA
#undef PG8_LDB
#undef PG8_MMA
#undef PG8_WAIT_V
#undef PG8_WAIT_L
#undef PG8_BAR
#undef PG8_SCHED
}

struct EpiIn {
    static constexpr bool PERM = true, KEEP = false;
    unsigned char* ws;
    DI void operator()(const f32x4 (&acc)[2][2][4][2], const Unit& u, int wr, int wc, int fr, int fq) const {
        const int pn = u.pn; bf16_t* base; int ldc, colt, mode;
        if (pn < 4) { base = (bf16_t*)(ws + WS_ZA); ldc = 1024; colt = pn * 256; mode = 0; }
        else if (pn < 8) { base = (bf16_t*)(ws + WS_ZU); ldc = 1024; colt = (pn - 4) * 256; mode = 1; }
        else if (pn < 12) { base = (bf16_t*)(ws + WS_ZV); ldc = 1024; colt = (pn - 8) * 256; mode = 1; }
        else if (pn < 16) { base = (bf16_t*)(ws + WS_ZQ); ldc = 1024; colt = (pn - 12) * 256; mode = 0; }
        else if (pn == 16) { base = (bf16_t*)(ws + WS_ZK); ldc = 256; colt = 0; mode = 0; }
        else if (pn == 17) { base = (bf16_t*)(ws + WS_ZVV); ldc = 256; colt = 0; mode = 0; }
        else { base = (bf16_t*)(ws + WS_ZG); ldc = 3072; colt = (pn - 18) * 256; mode = 2; }
        const int row0 = u.pm * BM + wr * 64 + fr, col0 = colt + wc * 32 + 8 * fq;
#pragma unroll
        for (int ai = 0; ai < 2; ++ai)
#pragma unroll
            for (int m = 0; m < 4; ++m) { bf16_t* rowp = base + (size_t)(row0 + ai * HALF + m * 16) * ldc + col0;
#pragma unroll
                for (int bj = 0; bj < 2; ++bj) { f32x4 v0 = acc[ai][bj][m][0], v1 = acc[ai][bj][m][1];
                    if (mode == 1) {
#pragma unroll
                        for (int j = 0; j < 4; ++j) { v0[j] = gelu_tanh(v0[j]); v1[j] = gelu_tanh(v1[j]); } }
                    else if (mode == 2) {
#pragma unroll
                        for (int j = 0; j < 4; ++j) { v0[j] = sigmoidf_(v0[j]); v1[j] = sigmoidf_(v1[j]); } }
                    u32x4 w; w.x = pk2(v0[0], v0[1]); w.y = pk2(v0[2], v0[3]); w.z = pk2(v1[0], v1[1]); w.w = pk2(v1[2], v1[3]);
                    *(u32x4*)(rowp + bj * HALF) = w; } }
    }
};
struct EpiMerge {
    static constexpr bool PERM = true, KEEP = true;
    bf16_t* Mg; const bf16_t* ZG;
    DI void operator()(f32x4 (&acc)[2][2][4][2], const Unit& u, int wr, int wc, int fr, int fq) const {
        const int row0 = u.pm * BM + wr * 64 + fr, col0 = u.pn * BM + wc * 32 + 8 * fq, seg = u.seg;
#pragma unroll
        for (int ai = 0; ai < 2; ++ai)
#pragma unroll
            for (int m = 0; m < 4; ++m) { const size_t r = (size_t)(row0 + ai * HALF + m * 16);
#pragma unroll
                for (int bj = 0; bj < 2; ++bj) {
                    const bf16_t* gp = ZG + r * 3072 + seg * 1024 + col0 + bj * HALF;
                    float g[8]; unpack8(*(const u32x4*)gp, g);
#pragma unroll
                    for (int j = 0; j < 8; ++j) g[j] = fmaxf(g[j], 1e-6f);
                    if (seg < 2) { float gn[8]; unpack8(*(const u32x4*)(gp + 1024), gn);
#pragma unroll
                        for (int j = 0; j < 8; ++j) g[j] *= frcp(fmaxf(gn[j], 1e-6f)); }
                    f32x4& v0 = acc[ai][bj][m][0]; f32x4& v1 = acc[ai][bj][m][1];
                    v0[0] *= g[0]; v0[1] *= g[1]; v0[2] *= g[2]; v0[3] *= g[3]; v1[0] *= g[4]; v1[1] *= g[5]; v1[2] *= g[6]; v1[3] *= g[7];
                    if (seg == 2) { u32x4 w; w.x = pk2(v0[0], v0[1]); w.y = pk2(v0[2], v0[3]); w.z = pk2(v1[0], v1[1]); w.w = pk2(v1[2], v1[3]);
                        *(u32x4*)(Mg + r * 1024 + col0 + bj * HALF) = w; } } }
    }
};
struct EpiRes {
    static constexpr bool PERM = false, KEEP = false;
    const float* src_c; const float* src_l; float* dst_c; float* dst_l; const float* gate;
    DI void operator()(const f32x4 (&acc)[2][2][4][2], const Unit& u, int wr, int wc, int fr, int fq) const {
        const int rowt = u.pm * BM; const int grp = rowt < TC ? 4 : ((rowt - TC) >> 12);
        const float* src = rowt < TC ? src_c + (size_t)rowt * D : src_l + (size_t)(rowt - TC) * D;
        float* dst = rowt < TC ? dst_c + (size_t)rowt * D : dst_l + (size_t)(rowt - TC) * D;
        const int row0 = wr * 64 + fr, col0 = u.pn * BM + wc * 32 + 4 * fq;
        const float* gp = gate + grp * 6144 + col0;
        f32x4 gv[2][2];
#pragma unroll
        for (int bj = 0; bj < 2; ++bj)
#pragma unroll
            for (int n = 0; n < 2; ++n) gv[bj][n] = *(const f32x4*)(gp + bj * HALF + n * 16);
#pragma unroll
        for (int ai = 0; ai < 2; ++ai)
#pragma unroll
            for (int m = 0; m < 4; ++m) { const size_t off = (size_t)(row0 + ai * HALF + m * 16) * D + col0;
#pragma unroll
                for (int bj = 0; bj < 2; ++bj)
#pragma unroll
                    for (int n = 0; n < 2; ++n) { const f32x4 xs = *(const f32x4*)(src + off + bj * HALF + n * 16);
                        *(f32x4*)(dst + off + bj * HALF + n * 16) = xs + gv[bj][n] * acc[ai][bj][m][n]; } }
    }
};
struct EpiMergeCtx {
    static constexpr bool PERM = true, KEEP = false;
    bf16_t* Pc; const bf16_t* ZG;
    DI void operator()(const f32x4 (&acc)[2][2][4][2], const Unit& u, int wr, int wc, int fr, int fq) const {
        const int row0 = u.pm * BM + wr * 64 + fr, col0 = u.pn * BM + wc * 32 + 8 * fq, seg = u.seg;
#pragma unroll
        for (int ai = 0; ai < 2; ++ai)
#pragma unroll
            for (int m = 0; m < 4; ++m) { const size_t r = (size_t)(row0 + ai * HALF + m * 16);
#pragma unroll
                for (int bj = 0; bj < 2; ++bj) {
                    const u32x4 gw = *(const u32x4*)(ZG + r * 3072 + seg * 1024 + col0 + bj * HALF);
                    float g[8]; unpack8(gw, g);
                    const f32x4 v0 = acc[ai][bj][m][0], v1 = acc[ai][bj][m][1];
                    u32x4 w; w.x = pk2(g[0] * v0[0], g[1] * v0[1]); w.y = pk2(g[2] * v0[2], g[3] * v0[3]); w.z = pk2(g[4] * v1[0], g[5] * v1[1]); w.w = pk2(g[6] * v1[2], g[7] * v1[3]);
                    *(u32x4*)(Pc + (size_t)seg * TC * D + r * 1024 + col0 + bj * HALF) = w; } }
    }
};
struct EpiPartial {
    static constexpr bool PERM = false, KEEP = false;
    float* PX; int nq;
    DI void operator()(const f32x4 (&acc)[2][2][4][2], const Unit& u, int wr, int wc, int fr, int fq) const {
        const int row0 = u.pm * BM + wr * 64 + fr, col0 = u.pn * BM + wc * 32 + 4 * fq;
        float* base = PX + (size_t)(u.seg * nq + u.q) * TC * D;
#pragma unroll
        for (int ai = 0; ai < 2; ++ai)
#pragma unroll
            for (int m = 0; m < 4; ++m) { float* rp = base + (size_t)(row0 + ai * HALF + m * 16) * D + col0;
#pragma unroll
                for (int bj = 0; bj < 2; ++bj)
#pragma unroll
                    for (int n = 0; n < 2; ++n) *(f32x4*)(rp + bj * HALF + n * 16) = acc[ai][bj][m][n]; }
    }
};
struct EpiFF1 {
    static constexpr bool PERM = true, KEEP = false;
    bf16_t* O;
    DI void operator()(const f32x4 (&acc)[2][2][4][2], const Unit& u, int wr, int wc, int fr, int fq) const {
        const int row0 = u.pm * BM + wr * 64 + fr, col0 = u.pn * BM + wc * 32 + 8 * fq;
#pragma unroll
        for (int ai = 0; ai < 2; ++ai)
#pragma unroll
            for (int m = 0; m < 4; ++m) { bf16_t* rowp = O + (size_t)(row0 + ai * HALF + m * 16) * DFF + col0;
#pragma unroll
                for (int bj = 0; bj < 2; ++bj) { f32x4 v0 = acc[ai][bj][m][0], v1 = acc[ai][bj][m][1];
#pragma unroll
                    for (int j = 0; j < 4; ++j) { const float a = fmaxf(v0[j], 0.f), b = fmaxf(v1[j], 0.f); v0[j] = a * a; v1[j] = b * b; }
                    u32x4 w; w.x = pk2(v0[0], v0[1]); w.y = pk2(v0[2], v0[3]); w.z = pk2(v1[0], v1[1]); w.w = pk2(v1[2], v1[3]);
                    *(u32x4*)(rowp + bj * HALF) = w; } }
    }
};
}

DI void phase_prep(const Args& a, LAS unsigned char* lds) {
    const int tid = tidx(), bid = bidx(), G = gridDim.x;
    if (bid == (1 % G)) {
        float* cosT = (float*)(wsp() + WS_ROPE); float* sinT = cosT + 1024;
        for (int i = tid; i < 1024; i += 512) { const int pos = i >> 4, f = i & 15; const float inv = powf(10000.0f, -(float)f / 16.0f); const float ang = (float)pos * inv;
            cosT[i] = cosf(ang); sinT[i] = sinf(ang); }
    }
    LAS float* cond = (LAS float*)lds;
    LAS float* red = (LAS float*)(lds + 20480);
    for (int i = tid; i < 5 * 1024; i += 512) { const int g = i >> 10, k = i & 1023; const float v = g < 4 ? inp<1>()[g * 1024 + k] : inp<3>()[k]; cond[i] = v * sigmoidf_(v); }
    __syncthreads();
    float* mod = (float*)(wsp() + WS_MOD);
    for (int it = bid; it < DEPTH * 96; it += G) {
        const int l = it / 96, cb = it % 96, c = tid & 63, kg = tid >> 6, col = cb * 64 + c;
        const float* w = inp<4>() + (size_t)l * D * 6144 + col;
        float acc[5] = {0.f, 0.f, 0.f, 0.f, 0.f};
#pragma unroll 8
        for (int k = kg * 128; k < kg * 128 + 128; ++k) { const float wv = w[(size_t)k * 6144];
#pragma unroll
            for (int g = 0; g < 5; ++g) acc[g] += cond[g * 1024 + k] * wv; }
#pragma unroll
        for (int g = 0; g < 5; ++g) red[(kg * 5 + g) * 64 + c] = acc[g];
        __syncthreads();
        if (tid < 320) { const int g = tid >> 6; float s = inp<5>()[l * 6144 + col];
#pragma unroll
            for (int k2 = 0; k2 < 8; ++k2) s += red[(k2 * 5 + g) * 64 + c];
            mod[(size_t)(l * 5 + g) * 6144 + col] = s; }
        __syncthreads();
    }
}

DI void transpose_item(const float* W, int K, int N, bf16_t* WT, LAS float* scr, int item, int lane) {
    const int nblk = N / 32, kb = item / nblk, nb = item % nblk, k0 = 64 * kb, n0 = 32 * nb;
#pragma unroll 8
    for (int i = 0; i < 32; ++i) { const int kk = 2 * i + (lane >> 5); scr[kk * 33 + (lane & 31)] = W[(size_t)(k0 + kk) * N + n0 + (lane & 31)]; }
    asm volatile("s_waitcnt lgkmcnt(0)" ::: "memory");
    const int c = lane & 7;
#pragma unroll
    for (int j = 0; j < 4; ++j) { const int n = (lane >> 3) + 8 * j; const LAS float* s = scr + (8 * c) * 33 + n;
        u32x4 o; o.x = pk2(s[0 * 33], s[1 * 33]); o.y = pk2(s[2 * 33], s[3 * 33]); o.z = pk2(s[4 * 33], s[5 * 33]); o.w = pk2(s[6 * 33], s[7 * 33]);
        *(u32x4*)(WT + (size_t)(n0 + n) * K + k0 + 8 * c) = o; }
    asm volatile("s_waitcnt lgkmcnt(0)" ::: "memory");
}


DI void transpose_tile(const float* W, int K, int N, bf16_t* WT, LAS float* scr, int item, int tid) {
    const int nblk = N / 256, kb = item / nblk, nb = item % nblk, k0 = 64 * kb, n0 = 256 * nb;
#pragma unroll
    for (int it = 0; it < 8; ++it) { const int idx = it * 512 + tid, kk = idx >> 6, c4 = idx & 63;
        const f32x4 v = *(const f32x4*)(W + (size_t)(k0 + kk) * N + n0 + c4 * 4);
        LAS float* d = scr + kk * 257 + c4 * 4; d[0] = v.x; d[1] = v.y; d[2] = v.z; d[3] = v.w; }
    __syncthreads();
#pragma unroll
    for (int it = 0; it < 4; ++it) { const int idx = it * 512 + tid, n = idx >> 3, c = idx & 7; const LAS float* sp = scr + (8 * c) * 257 + n;
        u32x4 o; o.x = pk2(sp[0], sp[257]); o.y = pk2(sp[2 * 257], sp[3 * 257]); o.z = pk2(sp[4 * 257], sp[5 * 257]); o.w = pk2(sp[6 * 257], sp[7 * 257]);
        *(u32x4*)(WT + (size_t)(n0 + n) * K + k0 + 8 * c) = o; }
    __syncthreads();
}

DI void convert_weights(int l, size_t wtoff, LAS unsigned char* lds, int rank, int nranks, int tid) {
    LAS float* scr = (LAS float*)lds;
    unsigned char* wb = wsp() + wtoff;
    constexpr int I_IN = 16 * (INW / 256), I_BR = 16 * 4, I_FF1 = 16 * (DFF / 256), I_FF2 = 64 * 4;
    constexpr int NIT = I_IN + 4 * I_BR + I_FF1 + I_FF2;
    for (int it = rank; it < NIT; it += nranks) {
        int r = it;
        if (r < I_IN) { transpose_tile(inp<7>() + (size_t)l * D * INW, D, INW, (bf16_t*)(wb + WS_WIN), scr, r, tid); continue; } r -= I_IN;
        if (r < 3 * I_BR) { const int sg = r / I_BR; transpose_tile(inp<22>() + ((size_t)l * 3 + sg) * D * D, D, D, (bf16_t*)(wb + WS_WBR) + (size_t)sg * D * D, scr, r % I_BR, tid); continue; } r -= 3 * I_BR;
        if (r < I_BR) { transpose_tile(inp<23>() + (size_t)l * D * D, D, D, (bf16_t*)(wb + WS_WOUT), scr, r, tid); continue; } r -= I_BR;
        if (r < I_FF1) { transpose_tile(inp<25>() + (size_t)l * D * DFF, D, DFF, (bf16_t*)(wb + WS_WFF1), scr, r, tid); continue; } r -= I_FF1;
        transpose_tile(inp<26>() + (size_t)l * DFF * D, DFF, D, (bf16_t*)(wb + WS_WFF2), scr, r, tid);
    }
}

DI void phase_norm(const Args& a, LAS unsigned char* lds, int l, int which) {
    const int tid = tidx(), lane = tid & 63, wave = tid >> 6, G = gridDim.x;
    const int gw = bidx() * 8 + wave, NGW = G * 8;
    if (which == 0 && l == 0) convert_weights(0, 0, lds, bidx(), G, tid);
    const bool from_in = (l == 0 && which == 0);
    const float* xc_src = from_in ? inp<2>() : (const float*)(wsp() + WS_XC);
    const float* xl_src = from_in ? inp<0>() : (const float*)outp();
    const float* gn = (which == 0 ? inp<6>() : inp<24>()) + l * D;
    const float* mod = (const float*)(wsp() + WS_MOD) + (size_t)l * 5 * 6144 + (which ? 3 * 1024 : 0);
    bf16_t* H = (bf16_t*)(wsp() + WS_H);
    const int rstart = (which == 1 && l == DEPTH - 1) ? TC : 0;
    const int npart = which == 1 ? 12 : (l > 0 ? 4 : 0);
    const float* pgate = (const float*)(wsp() + WS_MOD) + (size_t)((which == 1 ? l : l - 1) * 5 + 4) * 6144 + (which == 1 ? 2 : 5) * 1024;
    f32x4 vnx[4];
    {   const int r0 = rstart + gw;
        if (r0 < T) { const float* xr0 = r0 < TC ? xc_src + (size_t)r0 * D : xl_src + (size_t)(r0 - TC) * D;
#pragma unroll
            for (int j = 0; j < 4; ++j) vnx[j] = *((const f32x4*)xr0 + lane + 64 * j); } }
    for (int r = rstart + gw; r < T; r += NGW) {
        const int grp = r < TC ? 4 : ((r - TC) >> 12);
        const float* sh = mod + grp * 6144; const float* sc = sh + 1024;
        f32x4 v[4]; float ss = 0.f;
#pragma unroll
        for (int j = 0; j < 4; ++j) v[j] = vnx[j];
        {   const int rn = r + NGW;
            if (rn < T) { const float* xrn = rn < TC ? xc_src + (size_t)rn * D : xl_src + (size_t)(rn - TC) * D;
#pragma unroll
                for (int j = 0; j < 4; ++j) vnx[j] = *((const f32x4*)xrn + lane + 64 * j); } }
        if (r < TC && npart > 0) {
            const float* px = (const float*)(wsp() + WS_PX) + (size_t)r * D;
#pragma unroll
            for (int j = 0; j < 4; ++j) { f32x4 sum = *((const f32x4*)px + lane + 64 * j);
                for (int pi = 1; pi < npart; ++pi) sum += *((const f32x4*)(px + (size_t)pi * TC * D) + lane + 64 * j);
                v[j] += *((const f32x4*)pgate + lane + 64 * j) * sum;
                *((f32x4*)(wsp() + WS_XC + (size_t)r * D * 4) + lane + 64 * j) = v[j]; }
        }
#pragma unroll
        for (int j = 0; j < 4; ++j) ss += (v[j].x * v[j].x + v[j].y * v[j].y) + (v[j].z * v[j].z + v[j].w * v[j].w);
        const float rstd = 1.0f / sqrtf(wave_sum(ss) * (1.0f / D) + EPS);
        if (from_in && r < TC) {
#pragma unroll
            for (int j = 0; j < 4; ++j) *((f32x4*)(wsp() + WS_XC + (size_t)r * D * 4) + lane + 64 * j) = v[j]; }
#pragma unroll
        for (int j = 0; j < 4; ++j) { const int k = (lane + 64 * j) * 4; const f32x4 g = *(const f32x4*)(gn + k), s1 = *(const f32x4*)(sc + k), s0 = *(const f32x4*)(sh + k);
            const f32x4 y = (v[j] * rstd * g) * (s1 + 1.0f) + s0;
            u32x2 o; o.x = pk2(y.x, y.y); o.y = pk2(y.z, y.w);
            *(u32x2*)(H + (size_t)r * D + k) = o; }
    }
}

DI float neg_expm1(float x) {
    const float small = -x * (1.0f + x * (0.5f + x * (0.16666667f + x * 0.041666667f)));
    const float big = 1.0f - fexp2(x * LOG2E);
    return x > -0.1f ? small : big;
}
DI void scan_item(const Args& a, LAS unsigned char* lds, int l, int b, int cb, int hc) {
    const int tid = tidx(), half = tid >> 8, ht = tid & 255, lane = tid & 63, hw = (tid >> 6) & 3, l15 = lane & 15, l4 = lane >> 4;
    LAS unsigned char* hb = lds + half * 63488;
    LAS bf16_t* WaT = (LAS bf16_t*)hb;
    LAS bf16_t* WxT = (LAS bf16_t*)(hb + 4608);
    LAS bf16_t* xcb = (LAS bf16_t*)(hb + 9216);
    LAS float* As = (LAS float*)(hb + 27648);
    LAS float* Us = (LAS float*)(hb + 44032);
    LAS float* carry = (LAS float*)(hb + 60416);
    LAS float* segP = (LAS float*)(hb + 60672);
    LAS float* segH = (LAS float*)(hb + 61696);
    LAS float* prm = (LAS float*)(hb + 62720);
    const bf16_t* ZA = (const bf16_t*)(wsp() + WS_ZA); bf16_t* YA = (bf16_t*)(wsp() + WS_H);
    const int tokA = ht >> 2, c0A = (ht & 3) * 16;
    f32x2 cw2[4][8], cb2[8];
    {
        const size_t wofs = (((size_t)l * 2 + half) * 16 + cb) * 4096;
        const float* wa = inp<10>() + wofs; const float* wx = inp<12>() + wofs;
        for (int i = ht; i < 2048; i += 256) { const int ii = i >> 5, jj = i & 31; WaT[jj * 72 + ii] = f2bf(wa[ii * 64 + hc * 32 + jj]); WxT[jj * 72 + ii] = f2bf(wx[ii * 64 + hc * 32 + jj]); }
        if (ht < 32) { const int ch = cb * 64 + hc * 32 + ht; const size_t po = ((size_t)l * 2 + half) * D + ch;
            prm[ht] = inp<11>()[po]; prm[32 + ht] = inp<13>()[po];
            const float lam = inp<14>()[po]; prm[64 + ht] = 8.0f * log1pf(expf(-lam));
            carry[ht] = 0.f; }
        const float* cwp = inp<8>() + (size_t)l * 4 * D + cb * 64 + c0A; const float* cbp = inp<9>() + (size_t)l * D + cb * 64 + c0A;
#pragma unroll
        for (int j = 0; j < 8; ++j) { cb2[j] = (f32x2){cbp[2 * j], cbp[2 * j + 1]};
#pragma unroll
            for (int k = 0; k < 4; ++k) cw2[k][j] = (f32x2){cwp[(size_t)k * D + 2 * j], cwp[(size_t)k * D + 2 * j + 1]}; }
    }
    __syncthreads();
#define LBAR() do { asm volatile("s_waitcnt lgkmcnt(0)" ::: "memory"); __builtin_amdgcn_s_barrier(); asm volatile("" ::: "memory"); } while (0)
#define SCAN_GID(st_) ((half == 0) ? (st_) : ((st_) < 2 ? 1 - (st_) : 35 - (st_)))
#define SCAN_LOAD(st_) do { const int gid_ = SCAN_GID(st_); const bool ic_ = gid_ < 2; const int ck_ = ic_ ? gid_ : gid_ - 2; const int L_ = ic_ ? CTX : SEQ; const int rb_ = ic_ ? b * CTX : TC + b * SEQ; \
        _Pragma("unroll") for (int t2 = 0; t2 < 2; ++t2) _Pragma("unroll") for (int k = 0; k < 4; ++k) { const int ts = ck_ * 128 + tokA + 64 * t2 + k - 2; tp[t2][k][0] = (u32x4){0u, 0u, 0u, 0u}; tp[t2][k][1] = (u32x4){0u, 0u, 0u, 0u}; \
            if (ts >= 0 && ts < L_) { const bf16_t* p = ZA + (size_t)(rb_ + ts) * D + cb * 64 + c0A; tp[t2][k][0] = *(const u32x4*)p; tp[t2][k][1] = *(const u32x4*)(p + 8); } } } while (0)
    u32x4 tp[2][4][2];
    SCAN_LOAD(0);
    const int tokE = ht >> 1, c0E = (ht & 1) * 16;
    for (int step = 0; step < 34; ++step) {
        const int gid = SCAN_GID(step); const bool isctx = gid < 2; const int chunk = isctx ? gid : gid - 2; const int rowbase = isctx ? b * CTX : TC + b * SEQ;
        const bool fwd_first = isctx ? (gid == 0) : (gid <= 17);
        const bool second = (half == 0) ? !fwd_first : fwd_first;
#pragma unroll
        for (int t2 = 0; t2 < 2; ++t2) {
            f32x2 ac[8];
#pragma unroll
            for (int j = 0; j < 8; ++j) ac[j] = cb2[j];
#pragma unroll
            for (int k = 0; k < 4; ++k) { const u32x4 w0 = tp[t2][k][0], w1 = tp[t2][k][1];
                const unsigned ww[8] = {w0.x, w0.y, w0.z, w0.w, w1.x, w1.y, w1.z, w1.w};
#pragma unroll
                for (int j = 0; j < 8; ++j) { const f32x2 xv = {bflo(ww[j]), bfhi(ww[j])}; ac[j] = cw2[k][j] * xv + ac[j]; } }
            u32x4 o0, o1; o0.x = pk2(ac[0].x, ac[0].y); o0.y = pk2(ac[1].x, ac[1].y); o0.z = pk2(ac[2].x, ac[2].y); o0.w = pk2(ac[3].x, ac[3].y);
            o1.x = pk2(ac[4].x, ac[4].y); o1.y = pk2(ac[5].x, ac[5].y); o1.z = pk2(ac[6].x, ac[6].y); o1.w = pk2(ac[7].x, ac[7].y);
            *(LAS u32x4*)(xcb + (tokA + 64 * t2) * 72 + c0A) = o0; *(LAS u32x4*)(xcb + (tokA + 64 * t2) * 72 + c0A + 8) = o1;
        }
        LBAR();
#pragma unroll
        for (int mt = 0; mt < 2; ++mt) {
            f32x4 ar[2], ai[2];
#pragma unroll
            for (int nt = 0; nt < 2; ++nt) { ar[nt] = (f32x4){0.f, 0.f, 0.f, 0.f}; ai[nt] = (f32x4){0.f, 0.f, 0.f, 0.f}; }
#pragma unroll
            for (int s = 0; s < 2; ++s) { const bf16x8 xa = *(const LAS bf16x8*)(xcb + (32 * hw + 16 * mt + l15) * 72 + 32 * s + 8 * l4);
#pragma unroll
                for (int nt = 0; nt < 2; ++nt) { const bf16x8 wa = *(const LAS bf16x8*)(WaT + (16 * nt + l15) * 72 + 32 * s + 8 * l4), wx = *(const LAS bf16x8*)(WxT + (16 * nt + l15) * 72 + 32 * s + 8 * l4);
                    ar[nt] = __builtin_amdgcn_mfma_f32_16x16x32_bf16(xa, wa, ar[nt], 0, 0, 0); ai[nt] = __builtin_amdgcn_mfma_f32_16x16x32_bf16(xa, wx, ai[nt], 0, 0, 0); } }
#pragma unroll
            for (int nt = 0; nt < 2; ++nt) { const int j = 16 * nt + l15; const float ba = prm[j], bx = prm[32 + j], sp8 = prm[64 + j];
#pragma unroll
                for (int i = 0; i < 4; i += 2) { const int tok = 32 * hw + 16 * mt + 4 * l4 + i;
                    const f32x2 zr = ((f32x2){ar[nt][i], ar[nt][i + 1]} + ba) * (-LOG2E), zi = ((f32x2){ai[nt][i], ai[nt][i + 1]} + bx) * (-LOG2E);
                    const f32x2 dr = (f32x2){fexp2(zr.x), fexp2(zr.y)} + 1.0f, di = (f32x2){fexp2(zi.x), fexp2(zi.y)} + 1.0f;
                    const f32x2 r = {frcp(dr.x), frcp(dr.y)}, ig = {frcp(di.x), frcp(di.y)};
                    const f32x2 la = r * (-sp8), le = la * LOG2E;
                    const f32x2 av = {fexp2(le.x), fexp2(le.y)};
                    const f32x2 x2 = la * 2.0f;
                    const f32x2 sm = -x2 * (x2 * (x2 * (x2 * 0.041666667f + 0.16666667f) + 0.5f) + 1.0f), bg = 1.0f - av * av;
                    const f32x2 m2 = {x2.x > -0.1f ? sm.x : bg.x, x2.y > -0.1f ? sm.y : bg.y};
                    const f32x2 mult = {__builtin_amdgcn_sqrtf(fmaxf(m2.x, 0.f)), __builtin_amdgcn_sqrtf(fmaxf(m2.y, 0.f))};
                    const f32x2 xv = {bf1(xcb[tok * 72 + hc * 32 + j]), bf1(xcb[(tok + 1) * 72 + hc * 32 + j])};
                    const f32x2 uv = xv * ig * mult;
                    As[tok * 32 + j] = av.x; As[(tok + 1) * 32 + j] = av.y; Us[tok * 32 + j] = uv.x; Us[(tok + 1) * 32 + j] = uv.y; } }
        }
        asm volatile("s_waitcnt vmcnt(0)" ::: "memory");
        LBAR();
        bf16_t* outp_ = YA + (size_t)(rowbase + chunk * 128 + tokE) * D + cb * 64 + hc * 32 + c0E;
        unsigned long long q0 = 0, q1 = 0, q2 = 0, q3 = 0;
        if (second) { const unsigned long long* pq = (const unsigned long long*)outp_;
            q0 = __hip_atomic_load(pq, __ATOMIC_RELAXED, __HIP_MEMORY_SCOPE_AGENT); q1 = __hip_atomic_load(pq + 1, __ATOMIC_RELAXED, __HIP_MEMORY_SCOPE_AGENT);
            q2 = __hip_atomic_load(pq + 2, __ATOMIC_RELAXED, __HIP_MEMORY_SCOPE_AGENT); q3 = __hip_atomic_load(pq + 3, __ATOMIC_RELAXED, __HIP_MEMORY_SCOPE_AGENT); }
        if (step + 1 < 34) SCAN_LOAD(step + 1);
        const int c = ht & 31, seg = ht >> 5;
        {
            float h = 0.f, P = 1.f;
#pragma unroll 8
            for (int p = seg * 16; p < seg * 16 + 16; ++p) { const int tok = half ? 127 - p : p; const float av = As[tok * 32 + c], uv = Us[tok * 32 + c];
                h = av * h + uv; P *= av; }
            segH[seg * 32 + c] = h; segP[seg * 32 + c] = P;
        }
        LBAR();
        {
            float cin = carry[(step & 1) * 32 + c];
            float sp_[7], sh_[7];
#pragma unroll
            for (int s2 = 0; s2 < 7; ++s2) { sp_[s2] = segP[s2 * 32 + c]; sh_[s2] = segH[s2 * 32 + c]; }
#pragma unroll
            for (int s2 = 0; s2 < 7; ++s2) cin = s2 < seg ? sp_[s2] * cin + sh_[s2] : cin;
            float hl = cin;
#pragma unroll 8
            for (int p = seg * 16; p < seg * 16 + 16; ++p) { const int tok = half ? 127 - p : p; hl = As[tok * 32 + c] * hl + Us[tok * 32 + c]; Us[tok * 32 + c] = hl; }
            if (seg == 7) carry[((step + 1) & 1) * 32 + c] = hl;
        }
        LBAR();
        {
            float o0[8], o1[8];
#pragma unroll
            for (int j = 0; j < 8; ++j) { o0[j] = Us[tokE * 32 + c0E + j]; o1[j] = Us[tokE * 32 + c0E + 8 + j]; }
            if (second) { float e0[8], e1[8]; u32x4 wA, wB; wA.x = (unsigned)q0; wA.y = (unsigned)(q0 >> 32); wA.z = (unsigned)q1; wA.w = (unsigned)(q1 >> 32); wB.x = (unsigned)q2; wB.y = (unsigned)(q2 >> 32); wB.z = (unsigned)q3; wB.w = (unsigned)(q3 >> 32);
                unpack8(wA, e0); unpack8(wB, e1);
#pragma unroll
                for (int j = 0; j < 8; ++j) { o0[j] += e0[j]; o1[j] += e1[j]; } }
            *(u32x4*)outp_ = pack8(o0); *(u32x4*)(outp_ + 8) = pack8(o1);
        }
    }
    asm volatile("s_waitcnt vmcnt(0)" ::: "memory");
#undef SCAN_GID
#undef SCAN_LOAD
}

DI void sgu_item(const Args& a, LAS unsigned char* lds, int l, int tc) {
    const int tid = tidx(), lane = tid & 63, w = tid >> 6, hh = lane >> 5, r32 = lane & 31;
    const int row0 = tc < 8 ? (tc >> 1) * CTX + (tc & 1) * 128 : TC + ((tc - 8) >> 5) * SEQ + ((tc - 8) & 31) * 128;
    LAS bf16_t* Wl = (LAS bf16_t*)lds;
    LAS bf16_t* Vn = (LAS bf16_t*)(lds + 34816);
    LAS float* st = (LAS float*)(lds + 75776);
    const bf16_t* ZV = (const bf16_t*)(wsp() + WS_ZV); bf16_t* ZU = (bf16_t*)(wsp() + WS_ZU);
    for (int t = w * 16; t < w * 16 + 16; ++t) {
        const bf16_t* p = ZV + (size_t)(row0 + t) * D + lane * 16;
        float x0[8], x1[8]; unpack8(*(const u32x4*)p, x0); unpack8(*(const u32x4*)(p + 8), x1);
        float s = 0.f;
#pragma unroll
        for (int j = 0; j < 8; ++j) s += x0[j] + x1[j];
        const float mean = wave_sum(s) * (1.0f / D); float q = 0.f;
#pragma unroll
        for (int j = 0; j < 8; ++j) { const float d0 = x0[j] - mean, d1 = x1[j] - mean; q += d0 * d0 + d1 * d1; }
        const float var = wave_sum(q) * (1.0f / D);
        if (lane == 0) { st[t * 2] = mean; st[t * 2 + 1] = 1.0f / sqrtf(var + EPS); }
    }
    __syncthreads();
    const int tokS = tid >> 2, cS = (tid & 3) * 32;
    const float meanS = st[tokS * 2], rstdS = st[tokS * 2 + 1];
    f32x4 wreg[8]; u32x4 vreg[4], ureg[4];
#define SGU_LOAD(g_) do { const float* ws_ = inp<17>() + ((size_t)l * 8 + (g_)) * 16384; \
        _Pragma("unroll") for (int it = 0; it < 8; ++it) wreg[it] = *(const f32x4*)(ws_ + (it * 512 + tid) * 4); \
        const bf16_t* vp_ = ZV + (size_t)(row0 + tokS) * D + (g_) * 128 + cS; const bf16_t* up_ = ZU + (size_t)(row0 + tokS) * D + (g_) * 128 + cS; \
        _Pragma("unroll") for (int q4 = 0; q4 < 4; ++q4) { vreg[q4] = *(const u32x4*)(vp_ + q4 * 8); ureg[q4] = *(const u32x4*)(up_ + q4 * 8); } } while (0)
    SGU_LOAD(0);
    for (int g = 0; g < 8; ++g) {
        u32x4 ucur[4];
        {
#pragma unroll
            for (int it = 0; it < 8; ++it) { const int idx = (it * 512 + tid) * 4; const f32x4 v = wreg[it]; const int p = idx >> 7, q = idx & 127;
                u32x2 o; o.x = pk2(v.x, v.y); o.y = pk2(v.z, v.w); *(LAS u32x2*)(Wl + p * 136 + q) = o; }
            const float* lg = inp<15>() + (size_t)l * D + g * 128 + cS; const float* lb = inp<16>() + (size_t)l * D + g * 128 + cS;
#pragma unroll
            for (int q4 = 0; q4 < 4; ++q4) { float x[8]; unpack8(vreg[q4], x);
                const f32x4 g0 = *(const f32x4*)(lg + q4 * 8), g1 = *(const f32x4*)(lg + q4 * 8 + 4), b0 = *(const f32x4*)(lb + q4 * 8), b1 = *(const f32x4*)(lb + q4 * 8 + 4);
#pragma unroll
                for (int j = 0; j < 8; ++j) { const float gg = j < 4 ? g0[j & 3] : g1[j & 3], bb = j < 4 ? b0[j & 3] : b1[j & 3]; x[j] = (x[j] - meanS) * rstdS * gg + bb; }
                *(LAS u32x4*)(Vn + tokS * 160 + cS + q4 * 8) = pack8(x); ucur[q4] = ureg[q4]; }
        }
        if (g + 1 < 8) SGU_LOAD(g + 1);
        LBAR();
        {
            const int pt = w >> 1, ch = w & 1;
            f32x16 acc[2];
#pragma unroll
            for (int i = 0; i < 16; ++i) { acc[0][i] = 0.f; acc[1][i] = 0.f; }
#pragma unroll
            for (int s = 0; s < 8; ++s) { const bf16x8 af = *(const LAS bf16x8*)(Wl + (32 * pt + r32) * 136 + 16 * s + 8 * hh);
#pragma unroll
                for (int nt = 0; nt < 2; ++nt) { const LAS bf16_t* bp = Vn + (16 * s + 8 * hh + ((lane & 15) >> 2)) * 160 + 64 * ch + 32 * nt + 16 * ((lane >> 4) & 1) + 4 * (lane & 3);
                    const bf16x8 bfr = tr_read2(bp, bp + 4 * 160); acc[nt] = MFMA32(af, bfr, acc[nt]); } }
            const float* sb = inp<18>() + ((size_t)l * 8 + g) * 128 + 32 * pt + 4 * hh;
            f32x4 sbv[4];
#pragma unroll
            for (int i4 = 0; i4 < 4; ++i4) sbv[i4] = *(const f32x4*)(sb + 8 * i4);
            LBAR();
            LAS bf16_t* Mx = Wl;
#pragma unroll
            for (int nt = 0; nt < 2; ++nt)
#pragma unroll
                for (int i = 0; i < 16; ++i) { const int pp = 32 * pt + (i & 3) + 8 * (i >> 2) + 4 * hh, c = 64 * ch + 32 * nt + r32;
                    Mx[pp * 136 + c] = f2bf(acc[nt][i] + sbv[i >> 2][i & 3]); }
            LBAR();
            bf16_t* up = ZU + (size_t)(row0 + tokS) * D + g * 128 + cS;
#pragma unroll
            for (int q4 = 0; q4 < 4; ++q4) { float uu[8], mm[8]; unpack8(ucur[q4], uu); unpack8(*(const LAS u32x4*)(Mx + tokS * 136 + cS + q4 * 8), mm);
#pragma unroll
                for (int j = 0; j < 8; ++j) uu[j] *= mm[j];
                *(u32x4*)(up + q4 * 8) = pack8(uu); }
        }
        LBAR();
    }
#undef SGU_LOAD
}

DI void attn_tile(const LAS bf16_t* Ks, const LAS bf16_t* Vt, int kb, const bf16x8 (&qf)[2][4], float (&m)[2], float (&ls)[2], f32x16 (&o)[2][2],
                  int r32, int hh, bool masked, int qloc0, int kv_lo, int kv_hi) {
    bf16x8 kf[4];
#pragma unroll
    for (int s = 0; s < 4; ++s) kf[s] = *(const LAS bf16x8*)(Ks + (kb + r32) * 72 + 16 * s + 8 * hh);
    bf16x8 pf[2][2];
#pragma unroll
    for (int qt = 0; qt < 2; ++qt) {
        f32x16 sc;
#pragma unroll
        for (int i = 0; i < 16; ++i) sc[i] = 0.f;
#pragma unroll
        for (int s = 0; s < 4; ++s) sc = MFMA32(kf[s], qf[qt][s], sc);
        if (masked) { const int ql = qloc0 + 32 * qt + r32;
#pragma unroll
            for (int i = 0; i < 16; ++i) { const int key = kb + (i & 3) + 8 * (i >> 2) + 4 * hh; const int df = key - 128 - ql;
                const bool ok = (df >= -128) && (df <= 128) && (key >= kv_lo) && (key < kv_hi); sc[i] = ok ? sc[i] : -1e30f; } }
        float mx = sc[0];
#pragma unroll
        for (int i = 1; i < 16; ++i) mx = fmaxf(mx, sc[i]);
        mx = fmaxf(mx, __shfl_xor(mx, 32));
        const float mn = fmaxf(m[qt], mx); const float alpha = fexp2(m[qt] - mn); m[qt] = mn;
        float p[16]; float rs = 0.f;
#pragma unroll
        for (int i = 0; i < 16; ++i) { p[i] = fexp2(sc[i] - mn); rs += p[i]; }
        ls[qt] = ls[qt] * alpha + rs;
        if (__any(alpha != 1.0f)) {
#pragma unroll
            for (int i = 0; i < 16; ++i) { o[qt][0][i] *= alpha; o[qt][1][i] *= alpha; } }
#pragma unroll
        for (int ks = 0; ks < 2; ++ks) { u32x4 w; w.x = pk2(p[8 * ks], p[8 * ks + 1]); w.y = pk2(p[8 * ks + 2], p[8 * ks + 3]); w.z = pk2(p[8 * ks + 4], p[8 * ks + 5]); w.w = pk2(p[8 * ks + 6], p[8 * ks + 7]);
            pf[qt][ks] = __builtin_bit_cast(bf16x8, w); }
    }
#pragma unroll
    for (int dt = 0; dt < 2; ++dt)
#pragma unroll
        for (int ks = 0; ks < 2; ++ks) { const LAS bf16_t* vp = Vt + (kb + 16 * ks + 4 * hh + ((r32 & 15) >> 2)) * 72 + 32 * dt + 16 * (r32 >> 4) + 4 * (r32 & 3);
            const bf16x8 vf = tr_read2(vp, vp + 8 * 72);
#pragma unroll
            for (int qt = 0; qt < 2; ++qt) o[qt][dt] = MFMA32(vf, pf[qt][ks], o[qt][dt]); }
}

template <bool ctxstage> DI void attn_stage(const Args& a, LAS bf16_t* Ks, LAS bf16_t* Vt, int l, int b, int n, int kvh) {
    const int tid = tidx(), e = tid & 7;
    const bf16_t* ZK = (const bf16_t*)(wsp() + WS_ZK); const bf16_t* ZVV = (const bf16_t*)(wsp() + WS_ZVV);
    const float* cosT = (const float*)(wsp() + WS_ROPE); const float* sinT = cosT + 1024;
    const float* kg = inp<20>() + l * 64 + e * 8;
    float kgv[8];
#pragma unroll
    for (int j = 0; j < 8; ++j) kgv[j] = kg[j];
    constexpr int NP = 2;
    for (int pg = 0; pg < (ctxstage ? 2 : 3); ++pg) {
    u32x4 kwa[NP], vwa[NP];
#pragma unroll
    for (int ps = 0; ps < NP; ++ps) {
        const int key = (pg * NP + ps) * 64 + (tid >> 3);
        int kt = 0, row; bool valid = true;
        if (ctxstage) row = b * CTX + key; else { kt = n * 128 - 128 + key; valid = (kt >= 0) && (kt < SEQ); kt = kt < 0 ? 0 : (kt >= SEQ ? SEQ - 1 : kt); row = TC + b * SEQ + kt; }
        kwa[ps] = (u32x4){0u, 0u, 0u, 0u}; vwa[ps] = (u32x4){0u, 0u, 0u, 0u};
        if (valid) { kwa[ps] = *(const u32x4*)(ZK + (size_t)row * 256 + kvh * 64 + e * 8); vwa[ps] = *(const u32x4*)(ZVV + (size_t)row * 256 + kvh * 64 + e * 8); }
    }
#pragma unroll
    for (int ps = 0; ps < NP; ++ps) {
        const int key = (pg * NP + ps) * 64 + (tid >> 3);
        int kt = 0;
        if (!ctxstage) { kt = n * 128 - 128 + key; kt = kt < 0 ? 0 : (kt >= SEQ ? SEQ - 1 : kt); }
        const u32x4 kw = kwa[ps], vw = vwa[ps];
        float x[8]; unpack8(kw, x);
        float ss = 0.f;
#pragma unroll
        for (int j = 0; j < 8; ++j) ss += x[j] * x[j];
        ss += __shfl_xor(ss, 1); ss += __shfl_xor(ss, 2); ss += __shfl_xor(ss, 4);
        const float rstd = 1.0f / sqrtf(ss * (1.0f / 64.0f) + EPS);
#pragma unroll
        for (int j = 0; j < 8; ++j) x[j] = x[j] * rstd * kgv[j];
        if (!ctxstage) {
            const int pos = (e >> 2) ? (kt & 63) : (kt >> 6); const bool second = (e >> 1) & 1; const int f0 = 8 * (e & 1);
#pragma unroll
            for (int j = 0; j < 8; ++j) { const float pr = __shfl_xor(x[j], 2); const float cs = cosT[pos * 16 + f0 + j], sn = sinT[pos * 16 + f0 + j];
                x[j] = second ? (x[j] * cs + pr * sn) : (x[j] * cs - pr * sn); }
        }
        *(LAS u32x4*)(Ks + key * 72 + e * 8) = pack8(x);
        *(LAS u32x4*)(Vt + key * 72 + e * 8) = vw;
    }
    }
}

DI void attn_item(const Args& a, LAS unsigned char* lds, int l, int kind, int b, int n, int kvh) {
    const int tid = tidx(), lane = tid & 63, w = tid >> 6, hh = lane >> 5, r32 = lane & 31;
    const int g = w >> 1, qhalf = w & 1, h = kvh * 4 + g, qloc0 = qhalf * 64;
    LAS bf16_t* Ks = (LAS bf16_t*)lds;
    LAS bf16_t* Vt = (LAS bf16_t*)(lds + 55296);
    bf16_t* ZQ = (bf16_t*)(wsp() + WS_ZQ);
    const float* cosT = (const float*)(wsp() + WS_ROPE); const float* sinT = cosT + 1024;
    const float* qg = inp<19>() + l * 64;
    const float SCL = 0.125f * LOG2E;
    bf16x8 qf[2][4];
#pragma unroll
    for (int qt = 0; qt < 2; ++qt) {
        const int qtok = n * 128 + qloc0 + 32 * qt + r32; const int row = kind ? b * CTX + qtok : TC + b * SEQ + qtok;
        const bf16_t* qp = ZQ + (size_t)row * D + h * 64 + 8 * hh;
        float v[4][8]; float ss = 0.f;
#pragma unroll
        for (int s = 0; s < 4; ++s) { unpack8(*(const u32x4*)(qp + 16 * s), v[s]);
#pragma unroll
            for (int j = 0; j < 8; ++j) ss += v[s][j] * v[s][j]; }
        ss += __shfl_xor(ss, 32);
        const float rstd = 1.0f / sqrtf(ss * (1.0f / 64.0f) + EPS);
#pragma unroll
        for (int s = 0; s < 4; ++s)
#pragma unroll
            for (int j = 0; j < 8; ++j) v[s][j] = v[s][j] * rstd * qg[16 * s + 8 * hh + j];
        if (!kind) { const int prow = qtok >> 6, pcol = qtok & 63;
#pragma unroll
            for (int j = 0; j < 8; ++j) { const int f = 8 * hh + j;
                const float c0 = cosT[prow * 16 + f], s0 = sinT[prow * 16 + f], c1 = cosT[pcol * 16 + f], s1 = sinT[pcol * 16 + f];
                const float t1 = v[0][j], t2 = v[1][j]; v[0][j] = t1 * c0 - t2 * s0; v[1][j] = t2 * c0 + t1 * s0;
                const float t3 = v[2][j], t4 = v[3][j]; v[2][j] = t3 * c1 - t4 * s1; v[3][j] = t4 * c1 + t3 * s1; } }
#pragma unroll
        for (int s = 0; s < 4; ++s) {
#pragma unroll
            for (int j = 0; j < 8; ++j) v[s][j] *= SCL;
            qf[qt][s] = __builtin_bit_cast(bf16x8, pack8(v[s])); }
    }
    const float sk = inp<21>()[l * 16 + h] * LOG2E;
    float m[2] = {sk, sk}; float ls[2]; ls[0] = ls[1] = (hh == 0) ? 1.0f : 0.0f;
    f32x16 o[2][2];
#pragma unroll
    for (int i = 0; i < 16; ++i) { o[0][0][i] = 0.f; o[0][1][i] = 0.f; o[1][0][i] = 0.f; o[1][1][i] = 0.f; }
    if (!kind) {
        attn_stage<false>(a, Ks, Vt, l, b, n, kvh);
        __syncthreads();
        const int kv_lo = 128 - n * 128 > 0 ? 128 - n * 128 : 0; const int kv_hi = (SEQ - n * 128 + 128) < 384 ? (SEQ - n * 128 + 128) : 384;
        int t_lo = qhalf ? 2 : 0, t_hi = qhalf ? 12 : 10;
        if (t_lo < (kv_lo >> 5)) t_lo = kv_lo >> 5;
        if (t_hi > (kv_hi >> 5)) t_hi = kv_hi >> 5;
        for (int t = t_lo; t < t_hi; ++t) { const int kb = 32 * t; const bool interior = (kb >= qloc0 + 63) && (kb <= qloc0 + 225) && (kb >= kv_lo) && (kb + 32 <= kv_hi);
            attn_tile(Ks, Vt, kb, qf, m, ls, o, r32, hh, !interior, qloc0, kv_lo, kv_hi); }
        __syncthreads();
    }
    attn_stage<true>(a, Ks, Vt, l, b, n, kvh);
    __syncthreads();
    for (int t = 0; t < 8; ++t) attn_tile(Ks, Vt, 32 * t, qf, m, ls, o, r32, hh, false, qloc0, 0, 256);
#pragma unroll
    for (int qt = 0; qt < 2; ++qt) {
        const float lt = ls[qt] + __shfl_xor(ls[qt], 32); const float inv = 1.0f / lt;
        const int qtok = n * 128 + qloc0 + 32 * qt + r32; const int row = kind ? b * CTX + qtok : TC + b * SEQ + qtok;
        bf16_t* op = ZQ + (size_t)row * D + h * 64 + 4 * hh;
#pragma unroll
        for (int dt = 0; dt < 2; ++dt)
#pragma unroll
            for (int q4 = 0; q4 < 4; ++q4) { u32x2 wv; wv.x = pk2(o[qt][dt][4 * q4] * inv, o[qt][dt][4 * q4 + 1] * inv); wv.y = pk2(o[qt][dt][4 * q4 + 2] * inv, o[qt][dt][4 * q4 + 3] * inv);
                *(u32x2*)(op + 32 * dt + 8 * q4) = wv; }
    }
}

DI void phase_mix(const Args& a, LAS unsigned char* lds, int l) {
    const int tid = tidx();
    const bool last = (l == DEPTH - 1);
    unsigned* ctr = (unsigned*)(wsp() + WS_CTL) + l;
    LAS int* slot = (LAS int*)(lds + LDS_MISC);
    const int n_scan = 128, n_attl = 512, n_attc = last ? 0 : 32, n_sgu = last ? 128 : 136;
    const int total = n_scan + n_attl + n_attc + n_sgu;
    for (;;) {
        __syncthreads();
        if (tid == 0) *slot = (int)atomicAdd(ctr, 1u);
        __syncthreads();
        int it = *slot;
        if (it >= total) break;
#ifndef NO_SCAN
#ifdef PROBE_K
        const unsigned long long pt0 = __builtin_amdgcn_s_memrealtime();
#define PT_END(k, mx) do { if (tid == 0) { const unsigned dt = (unsigned)(__builtin_amdgcn_s_memrealtime() - pt0); if (mx) atomicMax((unsigned*)(wsp() + WS_CTL) + 128 + (k), dt); else atomicAdd((unsigned*)(wsp() + WS_CTL) + 128 + (k), dt); } } while (0)
#else
#define PT_END(k, mx) do {} while (0)
#endif
        if (it < n_scan) { scan_item(a, lds, l, it >> 5, (it >> 1) & 15, it & 1); PT_END(0, 1); continue; }
#endif
        it -= n_scan;
#ifndef NO_ATT
        if (it < n_attl) { attn_item(a, lds, l, 0, it >> 7, (it >> 2) & 31, it & 3); PT_END(1, 0); continue; }
#endif
        it -= n_attl;
#ifndef NO_ATT
        if (it < n_attc) { attn_item(a, lds, l, 1, it >> 3, (it >> 2) & 1, it & 3); PT_END(3, 0); continue; }
#endif
        it -= n_attc;
#ifndef NO_SGU
        sgu_item(a, lds, l, last ? it + 8 : it);
#endif
        PT_END(2, 0);
    }
}


DI void grid_barrier(unsigned* bar, unsigned target) {
    asm volatile("s_waitcnt vmcnt(0) lgkmcnt(0)" ::: "memory");
    __syncthreads();
    if (threadIdx.x == 0) {
        __builtin_amdgcn_fence(__ATOMIC_RELEASE, "agent");
        __hip_atomic_fetch_add(bar, 1u, __ATOMIC_RELAXED, __HIP_MEMORY_SCOPE_AGENT);
        while (__hip_atomic_load(bar, __ATOMIC_RELAXED, __HIP_MEMORY_SCOPE_AGENT) < target) __builtin_amdgcn_s_sleep(2);
        __builtin_amdgcn_fence(__ATOMIC_ACQUIRE, "agent");
    }
    __syncthreads();
}


#ifdef DBG_STOP
DI void dbg_dump(int which) {
    unsigned char* ws = wsp(); float* out = outp();
    const size_t n = (size_t)TL * D, stride = (size_t)gridDim.x * 512;
    const bf16_t* H = (const bf16_t*)(ws + WS_H); const bf16_t* MG = (const bf16_t*)(ws + WS_MG);
    const bf16_t* ZA = (const bf16_t*)(ws + WS_ZA); const bf16_t* ZU = (const bf16_t*)(ws + WS_ZU); const bf16_t* ZV = (const bf16_t*)(ws + WS_ZV); const bf16_t* ZQ = (const bf16_t*)(ws + WS_ZQ);
    const bf16_t* ZK = (const bf16_t*)(ws + WS_ZK); const bf16_t* ZVV = (const bf16_t*)(ws + WS_ZVV); const bf16_t* ZG = (const bf16_t*)(ws + WS_ZG);
    for (size_t i = (size_t)blockIdx.x * 512 + threadIdx.x; i < n; i += stride) {
        float v = 0.f;
        if (which == 1) v = bf1(H[i]) + bf1(H[i + (size_t)TC * D]);
        if (which == 2) v = bf1(ZA[i]) + bf1(ZU[i]) + bf1(ZV[i]) + bf1(ZQ[i]) + bf1(ZG[i]) + bf1(ZG[i + n]) + bf1(ZG[i + 2 * n]) + bf1(ZK[i % ((size_t)T * 256)]) + bf1(ZVV[i % ((size_t)T * 256)]) + bf1(ZA[i + (size_t)TC * D]);
        if (which == 3) v = bf1(H[i + (size_t)TC * D]);
        if (which == 4) v = bf1(ZU[i + (size_t)TC * D]);
        if (which == 5) v = bf1(ZQ[i + (size_t)TC * D]);
        if (which == 6) v = bf1(MG[i + (size_t)TC * D]);
        if (which == 7) v = bf1(H[i]) + bf1(ZU[i]) + bf1(ZQ[i]);
        out[i] = v;
    }
}
#endif

__global__ void __launch_bounds__(512, 2) fwd_megakernel(Args a) {
    extern __shared__ __attribute__((aligned(16))) unsigned char shm[];
    LAS unsigned char* lds = (LAS unsigned char*)shm;
    unsigned* gbar = (unsigned*)(wsp() + WS_CTL) + 64; unsigned nbar = 0;
#define GRID_SYNC() do { ++nbar; grid_barrier(gbar, nbar * (unsigned)G); } while (0)
#ifdef PROBE_K
    unsigned long long pr_prev = __builtin_amdgcn_s_memrealtime(), pr_acc = 0;
#define PROBE(k) do { const unsigned long long now_ = __builtin_amdgcn_s_memrealtime(); if ((k) == PROBE_K || PROBE_K == 99) pr_acc += now_ - pr_prev; pr_prev = now_; } while (0)
#else
#define PROBE(k) do {} while (0)
#endif
    const int G = gridDim.x;
    unsigned char* ws = wsp();

#if !defined(ONLY) || ONLY == 0
    phase_prep(a, lds);
#endif
    GRID_SYNC();
    PROBE(0);
    for (int l = 0; l < DEPTH; ++l) {
        const bool last = (l == DEPTH - 1);
        const int pm0 = last ? 4 : 0, nM = last ? 64 : 68;
        const float* modl = (const float*)(ws + WS_MOD) + (size_t)l * 5 * 6144;
        const size_t wto = (size_t)(l & 1) * WT_BYTES;
#if !defined(ONLY) || ONLY == 1
        phase_norm(a, lds, l, 0);
#endif
        GRID_SYNC();
    PROBE(1);
#if defined(DBG_STOP) && DBG_STOP == 1
        dbg_dump(1); return;
#endif
        {
            pg8::Sched S; S.nM = 68; S.nN = INW / 256; S.nwg = S.nM * S.nN; S.G = G; S.c = bidx(); S.nseg = 1; S.pm0 = 0;
            S.A0 = (const char*)(ws + WS_H); S.d1 = 0; S.d2 = 0; S.B0 = (const char*)(ws + wto + WS_WIN); S.bseg = 0; S.tstep = (size_t)256 * D * 2;
            pg8::EpiIn E{ws};
            pg8::gemm_phase<pg8::EpiIn, pg8::Sched>(lds, D, D, S, E);
        }
        GRID_SYNC();
    PROBE(2);
#if defined(DBG_STOP) && DBG_STOP == 2
        dbg_dump(2); return;
#endif
        phase_mix(a, lds, l);
        GRID_SYNC();
    PROBE(3);
#if defined(DBG_STOP) && DBG_STOP >= 3 && DBG_STOP <= 5
        dbg_dump(DBG_STOP); return;
#endif
#if defined(DBG_STOP) && DBG_STOP == 7
        dbg_dump(7); return;
#endif
        {
            pg8::Sched S; S.nM = 64; S.nN = 4; S.nwg = S.nM * S.nN; S.G = G; S.c = bidx(); S.nseg = 3; S.pm0 = 4;
            S.A0 = (const char*)(ws + WS_H); S.d1 = 2 * SLOT; S.d2 = 2 * SLOT; S.B0 = (const char*)(ws + wto + WS_WBR); S.bseg = (size_t)D * D * 2; S.tstep = (size_t)256 * D * 2;
            pg8::EpiMerge E{(bf16_t*)(ws + WS_MG), (const bf16_t*)(ws + WS_ZG)};
            pg8::gemm_phase<pg8::EpiMerge, pg8::Sched>(lds, D, D, S, E);
        }
        if (!last) {
            pg8::SchedList S; S.n = 48; S.G = G; S.c = bidx(); S.nN = 4; S.nS = 3; S.nQ = 1;
            S.A0 = (const char*)(ws + WS_H); S.a_pm = (size_t)256 * D * 2; S.a_s = 2 * SLOT; S.a_q = 0;
            S.B0 = (const char*)(ws + wto + WS_WBR); S.b_pn = (size_t)256 * D * 2; S.b_s = (size_t)D * D * 2; S.b_q = 0;
            pg8::EpiMergeCtx E{(bf16_t*)(ws + WS_PC), (const bf16_t*)(ws + WS_ZG)};
            pg8::gemm_phase<pg8::EpiMergeCtx, pg8::SchedList>(lds, D, D, S, E);
        }
        GRID_SYNC();
    PROBE(4);
#if defined(DBG_STOP) && DBG_STOP == 6
        dbg_dump(6); return;
#endif
        {
            pg8::Sched S; S.nM = 64; S.nN = 4; S.nwg = S.nM * S.nN; S.G = G; S.c = bidx(); S.nseg = 1; S.pm0 = 4;
            S.A0 = (const char*)(ws + WS_MG); S.d1 = 0; S.d2 = 0; S.B0 = (const char*)(ws + wto + WS_WOUT); S.bseg = 0; S.tstep = (size_t)256 * D * 2;
            pg8::EpiRes E{(const float*)(ws + WS_XC), l == 0 ? inp<0>() : (const float*)outp(), (float*)(ws + WS_XC), outp(), modl + 2 * 1024};
            pg8::gemm_phase<pg8::EpiRes, pg8::Sched>(lds, D, D, S, E);
        }
        if (!last) {
            pg8::SchedList S; S.n = 192; S.G = G; S.c = bidx(); S.nN = 4; S.nS = 3; S.nQ = 4;
            S.A0 = (const char*)(ws + WS_PC); S.a_pm = (size_t)256 * D * 2; S.a_s = (size_t)TC * D * 2; S.a_q = 256 * 2;
            S.B0 = (const char*)(ws + wto + WS_WOUT); S.b_pn = (size_t)256 * D * 2; S.b_s = 0; S.b_q = 256 * 2;
            pg8::EpiPartial E{(float*)(ws + WS_PX), 4};
            pg8::gemm_phase<pg8::EpiPartial, pg8::SchedList>(lds, 256, D, S, E);
        }
        GRID_SYNC();
    PROBE(5);
        phase_norm(a, lds, l, 1);
        GRID_SYNC();
    PROBE(6);
        {
            pg8::Sched S; S.nM = nM; S.nN = DFF / 256; S.nwg = S.nM * S.nN; S.G = G; S.c = bidx(); S.nseg = 1; S.pm0 = pm0;
            S.A0 = (const char*)(ws + WS_H); S.d1 = 0; S.d2 = 0; S.B0 = (const char*)(ws + wto + WS_WFF1); S.bseg = 0; S.tstep = (size_t)256 * D * 2;
            pg8::EpiFF1 E{(bf16_t*)(ws + WS_HID)};
            pg8::gemm_phase<pg8::EpiFF1, pg8::Sched>(lds, D, D, S, E);
        }
        GRID_SYNC();
    PROBE(7);
        {
            pg8::Sched S; S.nM = 64; S.nN = 4; S.nwg = S.nM * S.nN; S.G = G; S.c = bidx(); S.nseg = 1; S.pm0 = 4;
            S.A0 = (const char*)(ws + WS_HID); S.d1 = 0; S.d2 = 0; S.B0 = (const char*)(ws + wto + WS_WFF2); S.bseg = 0; S.tstep = (size_t)256 * DFF * 2;
            pg8::EpiRes E{(const float*)(ws + WS_XC), (const float*)outp(), (float*)(ws + WS_XC), outp(), modl + 5 * 1024};
            pg8::gemm_phase<pg8::EpiRes, pg8::Sched>(lds, DFF, DFF, S, E);
        }
        if (!last) {
            pg8::SchedList S; S.n = 64; S.G = G; S.c = bidx(); S.nN = 4; S.nS = 1; S.nQ = 4;
            S.A0 = (const char*)(ws + WS_HID); S.a_pm = (size_t)256 * DFF * 2; S.a_s = 0; S.a_q = 1024 * 2;
            S.B0 = (const char*)(ws + wto + WS_WFF2); S.b_pn = (size_t)256 * DFF * 2; S.b_s = 0; S.b_q = 1024 * 2;
            pg8::EpiPartial E{(float*)(ws + WS_PX), 4};
            pg8::gemm_phase<pg8::EpiPartial, pg8::SchedList>(lds, 1024, DFF, S, E);
        }
        if (!last && G > 64) { const int bq = bidx(); if (bq >= 64) convert_weights(l + 1, (size_t)((l + 1) & 1) * WT_BYTES, lds, bq - 64, G - 64, tidx()); }
        else if (!last) convert_weights(l + 1, (size_t)((l + 1) & 1) * WT_BYTES, lds, bidx(), G, tidx());
#ifdef PROBE_K
        GRID_SYNC();
#else
        if (!last) GRID_SYNC();
#endif
    PROBE(8);
    }
#ifdef PROBE_K
    if (blockIdx.x == 0 && threadIdx.x == 0) { float pv = (float)pr_acc * 0.01f; if (PROBE_K >= 30 && PROBE_K < 40) pv = (float)(((unsigned*)(wsp() + WS_CTL))[128 + PROBE_K - 30]) * 0.01f; { const float sc_ = exp10f(floorf(log10f(fmaxf(pv, 1.0f))) - 1.0f); pv = floorf(pv / sc_ + 0.5f) * sc_; } outp()[0] += pv; }
#endif
}

extern "C" void kernel_launch(void* const* d_in, const int* in_sizes, int n_in, void* d_out, int out_size, void* d_ws, size_t ws_size, hipStream_t stream) {
    static int grid = 0;
    if (grid == 0) {
        if (n_in != 27 || out_size != TL * D || ws_size < WS_END) { fprintf(stderr, "kernel_launch: unexpected shapes (n_in %d out %d ws %zu need %zu)\n", n_in, out_size, ws_size, (size_t)WS_END); grid = -1; return; }
        int dev = 0, cus = 0, per_cu = 0;
        hipGetDevice(&dev);
        hipDeviceGetAttribute(&cus, hipDeviceAttributeMultiprocessorCount, dev);
        hipFuncSetAttribute((const void*)fwd_megakernel, hipFuncAttributeMaxDynamicSharedMemorySize, LDS_BYTES);
        hipOccupancyMaxActiveBlocksPerMultiprocessor(&per_cu, (const void*)fwd_megakernel, 512, LDS_BYTES);
        if (per_cu < 1) { fprintf(stderr, "kernel_launch: occupancy query says %d blocks/CU\n", per_cu); per_cu = 1; }
        (void)hipGetLastError();
        grid = cus;
    }
    if (grid < 0) return;
    if (hipMemsetAsync((char*)d_ws + WS_CTL, 0, 4096, stream) != hipSuccess) { fprintf(stderr, "memset failed\n"); return; }
    Args a{};
    for (int i = 0; i < 27; ++i) a.in[i] = (const float*)d_in[i];
    a.out = (float*)d_out; a.ws = (unsigned char*)d_ws;
    void* args[] = {&a};
    hipError_t e = hipLaunchCooperativeKernel((const void*)fwd_megakernel, dim3(grid), dim3(512), args, LDS_BYTES, stream);
    if (e != hipSuccess) fprintf(stderr, "cooperative launch failed: %s (grid %d)\n", hipGetErrorString(e), grid);
}
```

```cpp
#define DBG_NOADD 0
#include <hip/hip_runtime.h>
#include <hip/hip_cooperative_groups.h>
#include <cstdio>
#include <cstdint>
namespace cg = cooperative_groups;

#define LAS __attribute__((address_space(3)))
#define DI __device__ __forceinline__
typedef unsigned short bf16_t;
typedef short bf16x8 __attribute__((ext_vector_type(8)));
typedef short s16x4 __attribute__((ext_vector_type(4)));
typedef float f32x2 __attribute__((ext_vector_type(2)));
typedef float f32x4 __attribute__((ext_vector_type(4)));
typedef float f32x16 __attribute__((ext_vector_type(16)));
typedef unsigned u32x2 __attribute__((ext_vector_type(2)));
typedef unsigned u32x4 __attribute__((ext_vector_type(4)));
typedef __bf16 bf16x2_t __attribute__((ext_vector_type(2)));

constexpr int D = 1024, NB = 4, SEQ = 4096, CTX = 256, DEPTH = 4, DFF = 4096;
constexpr int TC = NB * CTX;
constexpr int TL = NB * SEQ;
constexpr int T = TC + TL;
constexpr int INW = 7680;
constexpr float EPS = 1e-6f;
constexpr float LOG2E = 1.4426950408889634f;

constexpr size_t WS_CTL = 0;
constexpr size_t WS_BAR = 16384;
constexpr size_t WS_ROPE = 4096;
constexpr size_t WS_MOD = 65536;
constexpr size_t WS_XC = 1u << 20;
constexpr size_t WS_WIN = 5u << 20;
constexpr size_t WS_WBR = WS_WIN + (size_t)INW * D * 2;
constexpr size_t WS_WOUT = WS_WBR + (size_t)3 * D * D * 2;
constexpr size_t WS_WFF1 = WS_WOUT + (size_t)D * D * 2;
constexpr size_t WS_WFF2 = WS_WFF1 + (size_t)DFF * D * 2;
constexpr size_t SLOT = (size_t)T * D * 2;
constexpr size_t WT_BYTES = WS_WFF2 + (size_t)DFF * D * 2 - WS_WIN;
constexpr size_t WS_H = WS_WIN + 2 * WT_BYTES;
constexpr size_t WS_ZV = WS_H + SLOT;
constexpr size_t WS_ZU = WS_H + 2 * SLOT;
constexpr size_t WS_ZA = WS_H + 3 * SLOT;
constexpr size_t WS_ZQ = WS_H + 4 * SLOT;
constexpr size_t WS_ZK = WS_H + 5 * SLOT;
constexpr size_t WS_ZVV = WS_ZK + (size_t)T * 256 * 2;
constexpr size_t WS_ZG = WS_ZVV + (size_t)T * 256 * 2;
constexpr size_t WS_MG = WS_ZG + (size_t)T * 3072 * 2;
constexpr size_t WS_PC = WS_MG + SLOT;
constexpr size_t WS_PX = WS_PC + (size_t)3 * TC * D * 2;
constexpr size_t WS_END = WS_PX + (size_t)12 * TC * D * 4;
constexpr size_t WS_HID = WS_ZV;

constexpr int LDS_BYTES = 147456;
constexpr int LDS_MISC = 143360;

struct Args { const float* in[27]; float* out; unsigned char* ws; };


template <int OFF> DI const void* kargp() { const unsigned long long k = (unsigned long long)__builtin_amdgcn_kernarg_segment_ptr(); const void* p;
    asm volatile("s_load_dwordx2 %0, %1, %2\n\ts_waitcnt lgkmcnt(0)" : "=s"(p) : "s"(k), "n"(OFF) : "memory"); return p; }
template <int I> DI const float* inp() { return (const float*)kargp<I * 8>(); }
DI float* outp() { return (float*)kargp<27 * 8>(); }
DI unsigned char* wsp() { return (unsigned char*)kargp<28 * 8>(); }
DI int tidx() { int t = threadIdx.x; asm volatile("" : "+v"(t)); return t; }
DI int bidx() { int b = blockIdx.x; asm volatile("" : "+s"(b)); return b; }

DI unsigned pk2(float lo, float hi) { f32x2 v = {lo, hi}; bf16x2_t b = __builtin_convertvector(v, bf16x2_t); return __builtin_bit_cast(unsigned, b); }
DI float bflo(unsigned w) { return __uint_as_float(w << 16); }
DI float bfhi(unsigned w) { return __uint_as_float(w & 0xffff0000u); }
DI float bf1(bf16_t h) { return __uint_as_float(((unsigned)h) << 16); }
DI bf16_t f2bf(float f) { return (bf16_t)(pk2(f, 0.f) & 0xffffu); }
DI float fexp2(float x) { return __builtin_amdgcn_exp2f(x); }
DI float frcp(float x) { return __builtin_amdgcn_rcpf(x); }
DI float sigmoidf_(float x) { return frcp(1.0f + fexp2(-x * LOG2E)); }
DI float gelu_tanh(float x) { const float u = x + 0.044715f * x * x * x; return x * frcp(1.0f + fexp2(-1.5957691216f * LOG2E * u)); }
DI float wave_sum(float v) {
#pragma unroll
    for (int o = 1; o < 64; o <<= 1) v += __shfl_xor(v, o);
    return v;
}
DI void unpack8(const u32x4 w, float (&v)[8]) { v[0] = bflo(w.x); v[1] = bfhi(w.x); v[2] = bflo(w.y); v[3] = bfhi(w.y); v[4] = bflo(w.z); v[5] = bfhi(w.z); v[6] = bflo(w.w); v[7] = bfhi(w.w); }
DI u32x4 pack8(const float (&v)[8]) { u32x4 w; w.x = pk2(v[0], v[1]); w.y = pk2(v[2], v[3]); w.z = pk2(v[4], v[5]); w.w = pk2(v[6], v[7]); return w; }
typedef short v4i16_t __attribute__((ext_vector_type(4)));
DI bf16x8 tr_read2(const LAS bf16_t* p0, const LAS bf16_t* p1) {
    const v4i16_t a = __builtin_amdgcn_ds_read_tr16_b64_v4i16((LAS v4i16_t*)p0), b = __builtin_amdgcn_ds_read_tr16_b64_v4i16((LAS v4i16_t*)p1);
    bf16x8 r; r[0] = a[0]; r[1] = a[1]; r[2] = a[2]; r[3] = a[3]; r[4] = b[0]; r[5] = b[1]; r[6] = b[2]; r[7] = b[3]; return r;
}
#define MFMA32(a, b, c) __builtin_amdgcn_mfma_f32_32x32x16_bf16((a), (b), (c), 0, 0, 0)

namespace pg8 {
constexpr int BM = 256, BK = 64, HALF = 128, HTB = HALF * BK * 2, STAGE_BYTES = 8 * HTB, NXCD = 8, WGM = 8;
DI int lds_byte(int r, int c) { const int st = (r >> 4) * 2 + (c >> 5), rr = r & 15, cc = c & 31, ob = rr * 64 + cc * 2; return st * 1024 + (ob ^ (((ob >> 9) & 1) << 5)); }
DI void stage_rc(int b, int& R, int& C) { const int st = b / 1024, sb = b % 1024, swz = sb ^ (((sb >> 9) & 1) << 5); R = (st >> 1) * 16 + swz / 64; C = (st & 1) * 32 + (swz % 64) / 2; }
DI int perm32(int rho) { const int n = rho >> 4, i = rho & 15; return 8 * (i >> 2) + 4 * n + (i & 3); }

struct Unit { int pm, pn, seg, q; const char* A; const char* B; };

struct Sched {
    int nM, nN, nwg, G, c, nseg, pm0;
    const char *A0, *B0; size_t d1, d2, bseg, tstep;
    DI bool next(int i, Unit& u) const {
        int ti = i, seg = 0;
        if (nseg == 3) { ti = i / 3; seg = i - 3 * ti; }
        const long L = (long)ti * G + c; if (L >= nwg) return false;
        int wgid = (int)L; { const int q = nwg / NXCD, r = nwg % NXCD, xcd = wgid % NXCD, off = wgid / NXCD; wgid = (xcd < r ? xcd * (q + 1) : r * (q + 1) + (xcd - r) * q) + off; }
        const int nig = WGM * nN, gid = wgid / nig, fm = gid * WGM, gsz = (nM - fm) < WGM ? (nM - fm) : WGM;
        u.pm = pm0 + fm + ((wgid % nig) % gsz); u.pn = (wgid % nig) / gsz; u.seg = seg; u.q = 0;
        const size_t ao = (seg >= 1 ? d1 : (size_t)0) + (seg >= 2 ? d2 : (size_t)0);
        u.A = A0 + ao + (size_t)u.pm * tstep; u.B = B0 + (size_t)seg * bseg + (size_t)u.pn * tstep;
        return true;
    }
};

struct SchedList {
    int n, G, c, nN, nS, nQ; const char *A0, *B0; size_t a_pm, a_s, a_q, b_pn, b_s, b_q;
    DI bool next(int i, Unit& u) const {
        const int idx = i * G + c; if (idx >= n) return false;
        const int q = idx % nQ; int t = idx / nQ; const int sg = t % nS; t /= nS; const int pn = t % nN, pm = t / nN;
        u.pm = pm; u.pn = pn; u.seg = sg; u.q = q;
        u.A = A0 + (size_t)pm * a_pm + (size_t)sg * a_s + (size_t)q * a_q; u.B = B0 + (size_t)pn * b_pn + (size_t)sg * b_s + (size_t)q * b_q;
        return true;
    }
};

template <class Epi, class SchedT>
DI void gemm_phase(LAS unsigned char* lds, const int K, const int pitch, const SchedT& S, const Epi& E) {
    const int tid = tidx(), wid = __builtin_amdgcn_readfirstlane(tid >> 6), lane = tid & 63, wr = wid >> 2, wc = wid & 3, fr = lane & 15, fq = lane >> 4;
    const int nt = K / BK;
    unsigned voffA[2], voffB[2];
#pragma unroll
    for (int i = 0; i < 2; ++i) { int R, C; stage_rc(tid * 16 + i * 8192, R, C); const int Rb = Epi::PERM ? ((R & ~31) + perm32(R & 31)) : R;
        voffA[i] = (unsigned)(R * pitch + C) * 2u; voffB[i] = (unsigned)(Rb * pitch + C) * 2u; }
    const size_t kstep = (size_t)(BK * 2);
    const size_t hstep = (size_t)HALF * pitch * 2;
    const unsigned ldsw = (unsigned)wid * 1024u;
    const int aoff = lds_byte(wr * 64 + fr, fq * 8), boff = lds_byte(wc * 32 + fr, fq * 8);
#define PG8_SA(b, h) (((b) * 2 + (h)) * HTB)
#define PG8_SB(b, h) ((4 + (b) * 2 + (h)) * HTB)
#define PG8_STAGE(bufoff, gbase, voff) do { _Pragma("unroll") for (int _i = 0; _i < 2; ++_i) \
        __builtin_amdgcn_global_load_lds((const unsigned*)((const char*)(gbase) + (voff)[_i]), (LAS unsigned*)(lds + (bufoff) + ldsw + _i * 8192), 16, 0, 0); } while (0)
#define PG8_LDA(dst, b, h) do { _Pragma("unroll") for (int m = 0; m < 4; ++m) _Pragma("unroll") for (int k = 0; k < 2; ++k) dst[m][k] = *(const LAS bf16x8*)(lds + PG8_SA(b, h) + aoff + m * 2048 + k * 1024); } while (0)
#define PG8_LDB(dst, b, h) do { _Pragma("unroll") for (int n = 0; n < 2; ++n) _Pragma("unroll") for (int k = 0; k < 2; ++k) dst[n][k] = *(const LAS bf16x8*)(lds + PG8_SB(b, h) + boff + n * 2048 + k * 1024); } while (0)
#define PG8_MMA(ai, bj, At, Bt) do { __builtin_amdgcn_s_setprio(1); _Pragma("unroll") for (int m = 0; m < 4; ++m) _Pragma("unroll") for (int n = 0; n < 2; ++n) _Pragma("unroll") for (int k = 0; k < 2; ++k) \
        acc[ai][bj][m][n] = __builtin_amdgcn_mfma_f32_16x16x32_bf16(Bt[n][k], At[m][k], acc[ai][bj][m][n], 0, 0, 0); __builtin_amdgcn_s_setprio(0); } while (0)
#define PG8_WAIT_V(n) asm volatile("s_waitcnt vmcnt(" #n ")" ::: "memory")
#define PG8_WAIT_L(n) asm volatile("s_waitcnt lgkmcnt(" #n ")" ::: "memory")
#define PG8_BAR __builtin_amdgcn_s_barrier()
#define PG8_SCHED __builtin_amdgcn_sched_barrier(0)
    Unit cur, nxt; int ui = 0;
    if (!S.next(0, cur)) return;
    f32x4 acc[2][2][4][2];
#pragma unroll
    for (int a = 0; a < 2; ++a)
#pragma unroll
        for (int b = 0; b < 2; ++b)
#pragma unroll
            for (int m = 0; m < 4; ++m)
#pragma unroll
                for (int n = 0; n < 2; ++n) acc[a][b][m][n] = (f32x4){0.f, 0.f, 0.f, 0.f};
    bf16x8 At[4][2], B0[2][2], B1[2][2];
    const char* cA = cur.A; const char* cB = cur.B;
    PG8_STAGE(PG8_SB(0, 0), cB, voffB); PG8_STAGE(PG8_SA(0, 0), cA, voffA); PG8_STAGE(PG8_SB(0, 1), cB + hstep, voffB); PG8_STAGE(PG8_SA(0, 1), cA + hstep, voffA);
    if (wr == 1) PG8_BAR;
    PG8_WAIT_V(4); PG8_BAR;
    PG8_STAGE(PG8_SB(1, 0), cB + kstep, voffB); PG8_STAGE(PG8_SA(1, 0), cA + kstep, voffA); PG8_STAGE(PG8_SB(1, 1), cB + hstep + kstep, voffB);
    PG8_WAIT_V(6); PG8_BAR;
    for (;;) {
        const bool has_next = S.next(ui + 1, nxt);
        const char* nA = has_next ? nxt.A : cA; const char* nB = has_next ? nxt.B : cB;
        for (int t = 0; t < nt; t += 2) {
            const bool last = (t == nt - 2);
            const char* a1 = cA + (size_t)(t + 1) * kstep;
            const char* a2 = last ? nA : cA + (size_t)(t + 2) * kstep; const char* b2 = last ? nB : cB + (size_t)(t + 2) * kstep;
            const char* a3 = a2 + kstep; const char* b3 = b2 + kstep;
            PG8_LDB(B0, 0, 0); PG8_SCHED; PG8_LDA(At, 0, 0); PG8_STAGE(PG8_SA(1, 1), a1 + hstep, voffA);
            PG8_WAIT_L(8); PG8_BAR; PG8_WAIT_L(0); PG8_MMA(0, 0, At, B0); PG8_BAR; PG8_SCHED;
            PG8_LDB(B1, 0, 1); PG8_STAGE(PG8_SB(0, 0), b2, voffB);
            PG8_BAR; PG8_WAIT_L(0); PG8_MMA(0, 1, At, B1); PG8_BAR;
            PG8_LDA(At, 0, 1); PG8_STAGE(PG8_SA(0, 0), a2, voffA);
            PG8_BAR; PG8_WAIT_L(0); PG8_MMA(1, 0, At, B0); PG8_BAR; PG8_SCHED;
            PG8_STAGE(PG8_SB(0, 1), b2 + hstep, voffB);
            PG8_WAIT_V(6); PG8_BAR; PG8_MMA(1, 1, At, B1); PG8_BAR;
            PG8_LDB(B0, 1, 0); PG8_SCHED; PG8_LDA(At, 1, 0); PG8_STAGE(PG8_SA(0, 1), a2 + hstep, voffA);
            PG8_WAIT_L(8); PG8_BAR; PG8_WAIT_L(0); PG8_MMA(0, 0, At, B0); PG8_BAR; PG8_SCHED;
            PG8_LDB(B1, 1, 1); PG8_STAGE(PG8_SB(1, 0), b3, voffB);
            PG8_BAR; PG8_WAIT_L(0); PG8_MMA(0, 1, At, B1); PG8_BAR;
            PG8_LDA(At, 1, 1); PG8_STAGE(PG8_SA(1, 0), a3, voffA);
            PG8_BAR; PG8_WAIT_L(0); PG8_MMA(1, 0, At, B0); PG8_BAR; PG8_SCHED;
            PG8_STAGE(PG8_SB(1, 1), b3 + hstep, voffB);
            PG8_WAIT_V(6); PG8_BAR; PG8_MMA(1, 1, At, B1); PG8_BAR;
        }
        E(acc, cur, wr, wc, fr, fq);
        if (!has_next) break;
        if (!Epi::KEEP || nxt.seg == 0) {
#pragma unroll
        for (int a = 0; a < 2; ++a)
#pragma unroll
            for (int b = 0; b < 2; ++b)
#pragma unroll
                for (int m = 0; m < 4; ++m)
#pragma unroll
                    for (int n = 0; n < 2; ++n) acc[a][b][m][n] = (f32x4){0.f, 0.f, 0.f, 0.f};
        }
        cur = nxt; cA = nA; cB = nB; ++ui;
    }
    PG8_WAIT_V(0);
    if (wr == 0) PG8_BAR;
    PG8_BAR;
#undef PG8_SA
#undef PG8_SB
#undef PG8_STAGE
#undef PG8_LDA
#undef PG8_LDB
#undef PG8_MMA
#undef PG8_WAIT_V
#undef PG8_WAIT_L
#undef PG8_BAR
#undef PG8_SCHED
}

struct EpiIn {
    static constexpr bool PERM = true, KEEP = false;
    unsigned char* ws;
    DI void operator()(const f32x4 (&acc)[2][2][4][2], const Unit& u, int wr, int wc, int fr, int fq) const {
        const int pn = u.pn; bf16_t* base; int ldc, colt, mode;
        if (pn < 4) { base = (bf16_t*)(ws + WS_ZA); ldc = 1024; colt = pn * 256; mode = 0; }
        else if (pn < 8) { base = (bf16_t*)(ws + WS_ZU); ldc = 1024; colt = (pn - 4) * 256; mode = 1; }
        else if (pn < 12) { base = (bf16_t*)(ws + WS_ZV); ldc = 1024; colt = (pn - 8) * 256; mode = 1; }
        else if (pn < 16) { base = (bf16_t*)(ws + WS_ZQ); ldc = 1024; colt = (pn - 12) * 256; mode = 0; }
        else if (pn == 16) { base = (bf16_t*)(ws + WS_ZK); ldc = 256; colt = 0; mode = 0; }
        else if (pn == 17) { base = (bf16_t*)(ws + WS_ZVV); ldc = 256; colt = 0; mode = 0; }
        else { base = (bf16_t*)(ws + WS_ZG); ldc = 3072; colt = (pn - 18) * 256; mode = 2; }
        const int row0 = u.pm * BM + wr * 64 + fr, col0 = colt + wc * 32 + 8 * fq;
#pragma unroll
        for (int ai = 0; ai < 2; ++ai)
#pragma unroll
            for (int m = 0; m < 4; ++m) { bf16_t* rowp = base + (size_t)(row0 + ai * HALF + m * 16) * ldc + col0;
#pragma unroll
                for (int bj = 0; bj < 2; ++bj) { f32x4 v0 = acc[ai][bj][m][0], v1 = acc[ai][bj][m][1];
                    if (mode == 1) {
#pragma unroll
                        for (int j = 0; j < 4; ++j) { v0[j] = gelu_tanh(v0[j]); v1[j] = gelu_tanh(v1[j]); } }
                    else if (mode == 2) {
#pragma unroll
                        for (int j = 0; j < 4; ++j) { v0[j] = sigmoidf_(v0[j]); v1[j] = sigmoidf_(v1[j]); } }
                    u32x4 w; w.x = pk2(v0[0], v0[1]); w.y = pk2(v0[2], v0[3]); w.z = pk2(v1[0], v1[1]); w.w = pk2(v1[2], v1[3]);
                    *(u32x4*)(rowp + bj * HALF) = w; } }
    }
};
struct EpiMerge {
    static constexpr bool PERM = true, KEEP = true;
    bf16_t* Mg; const bf16_t* ZG;
    DI void operator()(f32x4 (&acc)[2][2][4][2], const Unit& u, int wr, int wc, int fr, int fq) const {
        const int row0 = u.pm * BM + wr * 64 + fr, col0 = u.pn * BM + wc * 32 + 8 * fq, seg = u.seg;
#pragma unroll
        for (int ai = 0; ai < 2; ++ai)
#pragma unroll
            for (int m = 0; m < 4; ++m) { const size_t r = (size_t)(row0 + ai * HALF + m * 16);
#pragma unroll
                for (int bj = 0; bj < 2; ++bj) {
                    const bf16_t* gp = ZG + r * 3072 + seg * 1024 + col0 + bj * HALF;
                    float g[8]; unpack8(*(const u32x4*)gp, g);
#pragma unroll
                    for (int j = 0; j < 8; ++j) g[j] = fmaxf(g[j], 1e-6f);
                    if (seg < 2) { float gn[8]; unpack8(*(const u32x4*)(gp + 1024), gn);
#pragma unroll
                        for (int j = 0; j < 8; ++j) g[j] *= frcp(fmaxf(gn[j], 1e-6f)); }
                    f32x4& v0 = acc[ai][bj][m][0]; f32x4& v1 = acc[ai][bj][m][1];
                    v0[0] *= g[0]; v0[1] *= g[1]; v0[2] *= g[2]; v0[3] *= g[3]; v1[0] *= g[4]; v1[1] *= g[5]; v1[2] *= g[6]; v1[3] *= g[7];
                    if (seg == 2) { u32x4 w; w.x = pk2(v0[0], v0[1]); w.y = pk2(v0[2], v0[3]); w.z = pk2(v1[0], v1[1]); w.w = pk2(v1[2], v1[3]);
                        *(u32x4*)(Mg + r * 1024 + col0 + bj * HALF) = w; } } }
    }
};
struct EpiRes {
    static constexpr bool PERM = false, KEEP = false;
    const float* src_c; const float* src_l; float* dst_c; float* dst_l; const float* gate;
    DI void operator()(const f32x4 (&acc)[2][2][4][2], const Unit& u, int wr, int wc, int fr, int fq) const {
        const int rowt = u.pm * BM; const int grp = rowt < TC ? 4 : ((rowt - TC) >> 12);
        const float* src = rowt < TC ? src_c + (size_t)rowt * D : src_l + (size_t)(rowt - TC) * D;
        float* dst = rowt < TC ? dst_c + (size_t)rowt * D : dst_l + (size_t)(rowt - TC) * D;
        const int row0 = wr * 64 + fr, col0 = u.pn * BM + wc * 32 + 4 * fq;
        const float* gp = gate + grp * 6144 + col0;
        f32x4 gv[2][2];
#pragma unroll
        for (int bj = 0; bj < 2; ++bj)
#pragma unroll
            for (int n = 0; n < 2; ++n) gv[bj][n] = *(const f32x4*)(gp + bj * HALF + n * 16);
#pragma unroll
        for (int ai = 0; ai < 2; ++ai)
#pragma unroll
            for (int m = 0; m < 4; ++m) { const size_t off = (size_t)(row0 + ai * HALF + m * 16) * D + col0;
#pragma unroll
                for (int bj = 0; bj < 2; ++bj)
#pragma unroll
                    for (int n = 0; n < 2; ++n) { const f32x4 xs = *(const f32x4*)(src + off + bj * HALF + n * 16);
                        *(f32x4*)(dst + off + bj * HALF + n * 16) = xs + gv[bj][n] * acc[ai][bj][m][n]; } }
    }
};
struct EpiMergeCtx {
    static constexpr bool PERM = true, KEEP = false;
    bf16_t* Pc; const bf16_t* ZG;
    DI void operator()(const f32x4 (&acc)[2][2][4][2], const Unit& u, int wr, int wc, int fr, int fq) const {
        const int row0 = u.pm * BM + wr * 64 + fr, col0 = u.pn * BM + wc * 32 + 8 * fq, seg = u.seg;
#pragma unroll
        for (int ai = 0; ai < 2; ++ai)
#pragma unroll
            for (int m = 0; m < 4; ++m) { const size_t r = (size_t)(row0 + ai * HALF + m * 16);
#pragma unroll
                for (int bj = 0; bj < 2; ++bj) {
                    const u32x4 gw = *(const u32x4*)(ZG + r * 3072 + seg * 1024 + col0 + bj * HALF);
                    float g[8]; unpack8(gw, g);
                    const f32x4 v0 = acc[ai][bj][m][0], v1 = acc[ai][bj][m][1];
                    u32x4 w; w.x = pk2(g[0] * v0[0], g[1] * v0[1]); w.y = pk2(g[2] * v0[2], g[3] * v0[3]); w.z = pk2(g[4] * v1[0], g[5] * v1[1]); w.w = pk2(g[6] * v1[2], g[7] * v1[3]);
                    *(u32x4*)(Pc + (size_t)seg * TC * D + r * 1024 + col0 + bj * HALF) = w; } }
    }
};
struct EpiPartial {
    static constexpr bool PERM = false, KEEP = false;
    float* PX; int nq;
    DI void operator()(const f32x4 (&acc)[2][2][4][2], const Unit& u, int wr, int wc, int fr, int fq) const {
        const int row0 = u.pm * BM + wr * 64 + fr, col0 = u.pn * BM + wc * 32 + 4 * fq;
        float* base = PX + (size_t)(u.seg * nq + u.q) * TC * D;
#pragma unroll
        for (int ai = 0; ai < 2; ++ai)
#pragma unroll
            for (int m = 0; m < 4; ++m) { float* rp = base + (size_t)(row0 + ai * HALF + m * 16) * D + col0;
#pragma unroll
                for (int bj = 0; bj < 2; ++bj)
#pragma unroll
                    for (int n = 0; n < 2; ++n) *(f32x4*)(rp + bj * HALF + n * 16) = acc[ai][bj][m][n]; }
    }
};
struct EpiFF1 {
    static constexpr bool PERM = true, KEEP = false;
    bf16_t* O;
    DI void operator()(const f32x4 (&acc)[2][2][4][2], const Unit& u, int wr, int wc, int fr, int fq) const {
        const int row0 = u.pm * BM + wr * 64 + fr, col0 = u.pn * BM + wc * 32 + 8 * fq;
#pragma unroll
        for (int ai = 0; ai < 2; ++ai)
#pragma unroll
            for (int m = 0; m < 4; ++m) { bf16_t* rowp = O + (size_t)(row0 + ai * HALF + m * 16) * DFF + col0;
#pragma unroll
                for (int bj = 0; bj < 2; ++bj) { f32x4 v0 = acc[ai][bj][m][0], v1 = acc[ai][bj][m][1];
#pragma unroll
                    for (int j = 0; j < 4; ++j) { const float a = fmaxf(v0[j], 0.f), b = fmaxf(v1[j], 0.f); v0[j] = a * a; v1[j] = b * b; }
                    u32x4 w; w.x = pk2(v0[0], v0[1]); w.y = pk2(v0[2], v0[3]); w.z = pk2(v1[0], v1[1]); w.w = pk2(v1[2], v1[3]);
                    *(u32x4*)(rowp + bj * HALF) = w; } }
    }
};
}

DI void phase_prep(const Args& a, LAS unsigned char* lds) {
    const int tid = tidx(), bid = bidx(), G = gridDim.x;
    if (bid == (1 % G)) {
        float* cosT = (float*)(wsp() + WS_ROPE); float* sinT = cosT + 1024;
        for (int i = tid; i < 1024; i += 512) { const int pos = i >> 4, f = i & 15; const float inv = powf(10000.0f, -(float)f / 16.0f); const float ang = (float)pos * inv;
            cosT[i] = cosf(ang); sinT[i] = sinf(ang); }
    }
    LAS float* cond = (LAS float*)lds;
    LAS float* red = (LAS float*)(lds + 20480);
    for (int i = tid; i < 5 * 1024; i += 512) { const int g = i >> 10, k = i & 1023; const float v = g < 4 ? inp<1>()[g * 1024 + k] : inp<3>()[k]; cond[i] = v * sigmoidf_(v); }
    __syncthreads();
    float* mod = (float*)(wsp() + WS_MOD);
    for (int it = bid; it < DEPTH * 96; it += G) {
        const int l = it / 96, cb = it % 96, c = tid & 63, kg = tid >> 6, col = cb * 64 + c;
        const float* w = inp<4>() + (size_t)l * D * 6144 + col;
        float acc[5] = {0.f, 0.f, 0.f, 0.f, 0.f};
#pragma unroll 8
        for (int k = kg * 128; k < kg * 128 + 128; ++k) { const float wv = w[(size_t)k * 6144];
#pragma unroll
            for (int g = 0; g < 5; ++g) acc[g] += cond[g * 1024 + k] * wv; }
#pragma unroll
        for (int g = 0; g < 5; ++g) red[(kg * 5 + g) * 64 + c] = acc[g];
        __syncthreads();
        if (tid < 320) { const int g = tid >> 6; float s = inp<5>()[l * 6144 + col];
#pragma unroll
            for (int k2 = 0; k2 < 8; ++k2) s += red[(k2 * 5 + g) * 64 + c];
            mod[(size_t)(l * 5 + g) * 6144 + col] = s; }
        __syncthreads();
    }
}

DI void transpose_item(const float* W, int K, int N, bf16_t* WT, LAS float* scr, int item, int lane) {
    const int nblk = N / 32, kb = item / nblk, nb = item % nblk, k0 = 64 * kb, n0 = 32 * nb;
#pragma unroll 8
    for (int i = 0; i < 32; ++i) { const int kk = 2 * i + (lane >> 5); scr[kk * 33 + (lane & 31)] = W[(size_t)(k0 + kk) * N + n0 + (lane & 31)]; }
    asm volatile("s_waitcnt lgkmcnt(0)" ::: "memory");
    const int c = lane & 7;
#pragma unroll
    for (int j = 0; j < 4; ++j) { const int n = (lane >> 3) + 8 * j; const LAS float* s = scr + (8 * c) * 33 + n;
        u32x4 o; o.x = pk2(s[0 * 33], s[1 * 33]); o.y = pk2(s[2 * 33], s[3 * 33]); o.z = pk2(s[4 * 33], s[5 * 33]); o.w = pk2(s[6 * 33], s[7 * 33]);
        *(u32x4*)(WT + (size_t)(n0 + n) * K + k0 + 8 * c) = o; }
    asm volatile("s_waitcnt lgkmcnt(0)" ::: "memory");
}


DI void transpose_tile(const float* W, int K, int N, bf16_t* WT, LAS float* scr, int item, int tid) {
    const int nblk = N / 256, kb = item / nblk, nb = item % nblk, k0 = 64 * kb, n0 = 256 * nb;
#pragma unroll
    for (int it = 0; it < 8; ++it) { const int idx = it * 512 + tid, kk = idx >> 6, c4 = idx & 63;
        const f32x4 v = *(const f32x4*)(W + (size_t)(k0 + kk) * N + n0 + c4 * 4);
        LAS float* d = scr + kk * 257 + c4 * 4; d[0] = v.x; d[1] = v.y; d[2] = v.z; d[3] = v.w; }
    __syncthreads();
#pragma unroll
    for (int it = 0; it < 4; ++it) { const int idx = it * 512 + tid, n = idx >> 3, c = idx & 7; const LAS float* sp = scr + (8 * c) * 257 + n;
        u32x4 o; o.x = pk2(sp[0], sp[257]); o.y = pk2(sp[2 * 257], sp[3 * 257]); o.z = pk2(sp[4 * 257], sp[5 * 257]); o.w = pk2(sp[6 * 257], sp[7 * 257]);
        *(u32x4*)(WT + (size_t)(n0 + n) * K + k0 + 8 * c) = o; }
    __syncthreads();
}

DI void convert_weights(int l, size_t wtoff, LAS unsigned char* lds, int rank, int nranks, int tid) {
    LAS float* scr = (LAS float*)lds;
    unsigned char* wb = wsp() + wtoff;
    constexpr int I_IN = 16 * (INW / 256), I_BR = 16 * 4, I_FF1 = 16 * (DFF / 256), I_FF2 = 64 * 4;
    constexpr int NIT = I_IN + 4 * I_BR + I_FF1 + I_FF2;
    for (int it = rank; it < NIT; it += nranks) {
        int r = it;
        if (r < I_IN) { transpose_tile(inp<7>() + (size_t)l * D * INW, D, INW, (bf16_t*)(wb + WS_WIN), scr, r, tid); continue; } r -= I_IN;
        if (r < 3 * I_BR) { const int sg = r / I_BR; transpose_tile(inp<22>() + ((size_t)l * 3 + sg) * D * D, D, D, (bf16_t*)(wb + WS_WBR) + (size_t)sg * D * D, scr, r % I_BR, tid); continue; } r -= 3 * I_BR;
        if (r < I_BR) { transpose_tile(inp<23>() + (size_t)l * D * D, D, D, (bf16_t*)(wb + WS_WOUT), scr, r, tid); continue; } r -= I_BR;
        if (r < I_FF1) { transpose_tile(inp<25>() + (size_t)l * D * DFF, D, DFF, (bf16_t*)(wb + WS_WFF1), scr, r, tid); continue; } r -= I_FF1;
        transpose_tile(inp<26>() + (size_t)l * DFF * D, DFF, D, (bf16_t*)(wb + WS_WFF2), scr, r, tid);
    }
}

DI void phase_norm(const Args& a, LAS unsigned char* lds, int l, int which) {
    const int tid = tidx(), lane = tid & 63, wave = tid >> 6, G = gridDim.x;
    const int gw = bidx() * 8 + wave, NGW = G * 8;
    if (which == 0 && l == 0) convert_weights(0, 0, lds, bidx(), G, tid);
    const bool from_in = (l == 0 && which == 0);
    const float* xc_src = from_in ? inp<2>() : (const float*)(wsp() + WS_XC);
    const float* xl_src = from_in ? inp<0>() : (const float*)outp();
    const float* gn = (which == 0 ? inp<6>() : inp<24>()) + l * D;
    const float* mod = (const float*)(wsp() + WS_MOD) + (size_t)l * 5 * 6144 + (which ? 3 * 1024 : 0);
    bf16_t* H = (bf16_t*)(wsp() + WS_H);
    const int rstart = (which == 1 && l == DEPTH - 1) ? TC : 0;
    const int npart = which == 1 ? 12 : (l > 0 ? 4 : 0);
    const float* pgate = (const float*)(wsp() + WS_MOD) + (size_t)((which == 1 ? l : l - 1) * 5 + 4) * 6144 + (which == 1 ? 2 : 5) * 1024;
    f32x4 vnx[4];
    {   const int r0 = rstart + gw;
        if (r0 < T) { const float* xr0 = r0 < TC ? xc_src + (size_t)r0 * D : xl_src + (size_t)(r0 - TC) * D;
#pragma unroll
            for (int j = 0; j < 4; ++j) vnx[j] = *((const f32x4*)xr0 + lane + 64 * j); } }
    for (int r = rstart + gw; r < T; r += NGW) {
        const int grp = r < TC ? 4 : ((r - TC) >> 12);
        const float* sh = mod + grp * 6144; const float* sc = sh + 1024;
        f32x4 v[4]; float ss = 0.f;
#pragma unroll
        for (int j = 0; j < 4; ++j) v[j] = vnx[j];
        {   const int rn = r + NGW;
            if (rn < T) { const float* xrn = rn < TC ? xc_src + (size_t)rn * D : xl_src + (size_t)(rn - TC) * D;
#pragma unroll
                for (int j = 0; j < 4; ++j) vnx[j] = *((const f32x4*)xrn + lane + 64 * j); } }
        if (r < TC && npart > 0) {
            const float* px = (const float*)(wsp() + WS_PX) + (size_t)r * D;
#pragma unroll
            for (int j = 0; j < 4; ++j) { f32x4 sum = *((const f32x4*)px + lane + 64 * j);
                for (int pi = 1; pi < npart; ++pi) sum += *((const f32x4*)(px + (size_t)pi * TC * D) + lane + 64 * j);
                v[j] += *((const f32x4*)pgate + lane + 64 * j) * sum;
                *((f32x4*)(wsp() + WS_XC + (size_t)r * D * 4) + lane + 64 * j) = v[j]; }
        }
#pragma unroll
        for (int j = 0; j < 4; ++j) ss += (v[j].x * v[j].x + v[j].y * v[j].y) + (v[j].z * v[j].z + v[j].w * v[j].w);
        const float rstd = 1.0f / sqrtf(wave_sum(ss) * (1.0f / D) + EPS);
        if (from_in && r < TC) {
#pragma unroll
            for (int j = 0; j < 4; ++j) *((f32x4*)(wsp() + WS_XC + (size_t)r * D * 4) + lane + 64 * j) = v[j]; }
#pragma unroll
        for (int j = 0; j < 4; ++j) { const int k = (lane + 64 * j) * 4; const f32x4 g = *(const f32x4*)(gn + k), s1 = *(const f32x4*)(sc + k), s0 = *(const f32x4*)(sh + k);
            const f32x4 y = (v[j] * rstd * g) * (s1 + 1.0f) + s0;
            u32x2 o; o.x = pk2(y.x, y.y); o.y = pk2(y.z, y.w);
            *(u32x2*)(H + (size_t)r * D + k) = o; }
    }
}

DI float neg_expm1(float x) {
    const float small = -x * (1.0f + x * (0.5f + x * (0.16666667f + x * 0.041666667f)));
    const float big = 1.0f - fexp2(x * LOG2E);
    return x > -0.1f ? small : big;
}
DI void scan_item(const Args& a, LAS unsigned char* lds, int l, int b, int cb, int hc) {
    const int tid = tidx(), half = tid >> 8, ht = tid & 255, lane = tid & 63, hw = (tid >> 6) & 3, l15 = lane & 15, l4 = lane >> 4;
    LAS unsigned char* hb = lds + half * 63488;
    LAS bf16_t* WaT = (LAS bf16_t*)hb;
    LAS bf16_t* WxT = (LAS bf16_t*)(hb + 4608);
    LAS bf16_t* xcb = (LAS bf16_t*)(hb + 9216);
    LAS float* As = (LAS float*)(hb + 27648);
    LAS float* Us = (LAS float*)(hb + 44032);
    LAS float* carry = (LAS float*)(hb + 60416);
    LAS float* segP = (LAS float*)(hb + 60672);
    LAS float* segH = (LAS float*)(hb + 61696);
    LAS float* prm = (LAS float*)(hb + 62720);
    const bf16_t* ZA = (const bf16_t*)(wsp() + WS_ZA); bf16_t* YA = (bf16_t*)(wsp() + WS_H);
    const int tokA = ht >> 2, c0A = (ht & 3) * 16;
    f32x2 cw2[4][8], cb2[8];
    {
        const size_t wofs = (((size_t)l * 2 + half) * 16 + cb) * 4096;
        const float* wa = inp<10>() + wofs; const float* wx = inp<12>() + wofs;
        for (int i = ht; i < 2048; i += 256) { const int ii = i >> 5, jj = i & 31; WaT[jj * 72 + ii] = f2bf(wa[ii * 64 + hc * 32 + jj]); WxT[jj * 72 + ii] = f2bf(wx[ii * 64 + hc * 32 + jj]); }
        if (ht < 32) { const int ch = cb * 64 + hc * 32 + ht; const size_t po = ((size_t)l * 2 + half) * D + ch;
            prm[ht] = inp<11>()[po]; prm[32 + ht] = inp<13>()[po];
            const float lam = inp<14>()[po]; prm[64 + ht] = 8.0f * log1pf(expf(-lam));
            carry[ht] = 0.f; }
        const float* cwp = inp<8>() + (size_t)l * 4 * D + cb * 64 + c0A; const float* cbp = inp<9>() + (size_t)l * D + cb * 64 + c0A;
#pragma unroll
        for (int j = 0; j < 8; ++j) { cb2[j] = (f32x2){cbp[2 * j], cbp[2 * j + 1]};
#pragma unroll
            for (int k = 0; k < 4; ++k) cw2[k][j] = (f32x2){cwp[(size_t)k * D + 2 * j], cwp[(size_t)k * D + 2 * j + 1]}; }
    }
    __syncthreads();
#define LBAR() do { asm volatile("s_waitcnt lgkmcnt(0)" ::: "memory"); __builtin_amdgcn_s_barrier(); asm volatile("" ::: "memory"); } while (0)
#define SCAN_GID(st_) ((half == 0) ? (st_) : ((st_) < 2 ? 1 - (st_) : 35 - (st_)))
#define SCAN_LOAD(st_) do { const int gid_ = SCAN_GID(st_); const bool ic_ = gid_ < 2; const int ck_ = ic_ ? gid_ : gid_ - 2; const int L_ = ic_ ? CTX : SEQ; const int rb_ = ic_ ? b * CTX : TC + b * SEQ; \
        _Pragma("unroll") for (int t2 = 0; t2 < 2; ++t2) _Pragma("unroll") for (int k = 0; k < 4; ++k) { const int ts = ck_ * 128 + tokA + 64 * t2 + k - 2; tp[t2][k][0] = (u32x4){0u, 0u, 0u, 0u}; tp[t2][k][1] = (u32x4){0u, 0u, 0u, 0u}; \
            if (ts >= 0 && ts < L_) { const bf16_t* p = ZA + (size_t)(rb_ + ts) * D + cb * 64 + c0A; tp[t2][k][0] = *(const u32x4*)p; tp[t2][k][1] = *(const u32x4*)(p + 8); } } } while (0)
    u32x4 tp[2][4][2];
    SCAN_LOAD(0);
    const int tokE = ht >> 1, c0E = (ht & 1) * 16;
    for (int step = 0; step < 34; ++step) {
        const int gid = SCAN_GID(step); const bool isctx = gid < 2; const int chunk = isctx ? gid : gid - 2; const int rowbase = isctx ? b * CTX : TC + b * SEQ;
        const bool fwd_first = isctx ? (gid == 0) : (gid <= 17);
        const bool second = (half == 0) ? !fwd_first : fwd_first;
#pragma unroll
        for (int t2 = 0; t2 < 2; ++t2) {
            f32x2 ac[8];
#pragma unroll
            for (int j = 0; j < 8; ++j) ac[j] = cb2[j];
#pragma unroll
            for (int k = 0; k < 4; ++k) { const u32x4 w0 = tp[t2][k][0], w1 = tp[t2][k][1];
                const unsigned ww[8] = {w0.x, w0.y, w0.z, w0.w, w1.x, w1.y, w1.z, w1.w};
#pragma unroll
                for (int j = 0; j < 8; ++j) { const f32x2 xv = {bflo(ww[j]), bfhi(ww[j])}; ac[j] = cw2[k][j] * xv + ac[j]; } }
            u32x4 o0, o1; o0.x = pk2(ac[0].x, ac[0].y); o0.y = pk2(ac[1].x, ac[1].y); o0.z = pk2(ac[2].x, ac[2].y); o0.w = pk2(ac[3].x, ac[3].y);
            o1.x = pk2(ac[4].x, ac[4].y); o1.y = pk2(ac[5].x, ac[5].y); o1.z = pk2(ac[6].x, ac[6].y); o1.w = pk2(ac[7].x, ac[7].y);
            *(LAS u32x4*)(xcb + (tokA + 64 * t2) * 72 + c0A) = o0; *(LAS u32x4*)(xcb + (tokA + 64 * t2) * 72 + c0A + 8) = o1;
        }
        LBAR();
#pragma unroll
        for (int mt = 0; mt < 2; ++mt) {
            f32x4 ar[2], ai[2];
#pragma unroll
            for (int nt = 0; nt < 2; ++nt) { ar[nt] = (f32x4){0.f, 0.f, 0.f, 0.f}; ai[nt] = (f32x4){0.f, 0.f, 0.f, 0.f}; }
#pragma unroll
            for (int s = 0; s < 2; ++s) { const bf16x8 xa = *(const LAS bf16x8*)(xcb + (32 * hw + 16 * mt + l15) * 72 + 32 * s + 8 * l4);
#pragma unroll
                for (int nt = 0; nt < 2; ++nt) { const bf16x8 wa = *(const LAS bf16x8*)(WaT + (16 * nt + l15) * 72 + 32 * s + 8 * l4), wx = *(const LAS bf16x8*)(WxT + (16 * nt + l15) * 72 + 32 * s + 8 * l4);
                    ar[nt] = __builtin_amdgcn_mfma_f32_16x16x32_bf16(xa, wa, ar[nt], 0, 0, 0); ai[nt] = __builtin_amdgcn_mfma_f32_16x16x32_bf16(xa, wx, ai[nt], 0, 0, 0); } }
#pragma unroll
            for (int nt = 0; nt < 2; ++nt) { const int j = 16 * nt + l15; const float ba = prm[j], bx = prm[32 + j], sp8 = prm[64 + j];
#pragma unroll
                for (int i = 0; i < 4; i += 2) { const int tok = 32 * hw + 16 * mt + 4 * l4 + i;
                    const f32x2 zr = ((f32x2){ar[nt][i], ar[nt][i + 1]} + ba) * (-LOG2E), zi = ((f32x2){ai[nt][i], ai[nt][i + 1]} + bx) * (-LOG2E);
                    const f32x2 dr = (f32x2){fexp2(zr.x), fexp2(zr.y)} + 1.0f, di = (f32x2){fexp2(zi.x), fexp2(zi.y)} + 1.0f;
                    const f32x2 r = {frcp(dr.x), frcp(dr.y)}, ig = {frcp(di.x), frcp(di.y)};
                    const f32x2 la = r * (-sp8), le = la * LOG2E;
                    const f32x2 av = {fexp2(le.x), fexp2(le.y)};
                    const f32x2 x2 = la * 2.0f;
                    const f32x2 sm = -x2 * (x2 * (x2 * (x2 * 0.041666667f + 0.16666667f) + 0.5f) + 1.0f), bg = 1.0f - av * av;
                    const f32x2 m2 = {x2.x > -0.1f ? sm.x : bg.x, x2.y > -0.1f ? sm.y : bg.y};
                    const f32x2 mult = {__builtin_amdgcn_sqrtf(fmaxf(m2.x, 0.f)), __builtin_amdgcn_sqrtf(fmaxf(m2.y, 0.f))};
                    const f32x2 xv = {bf1(xcb[tok * 72 + hc * 32 + j]), bf1(xcb[(tok + 1) * 72 + hc * 32 + j])};
                    const f32x2 uv = xv * ig * mult;
                    As[tok * 32 + j] = av.x; As[(tok + 1) * 32 + j] = av.y; Us[tok * 32 + j] = uv.x; Us[(tok + 1) * 32 + j] = uv.y; } }
        }
        asm volatile("s_waitcnt vmcnt(0)" ::: "memory");
        LBAR();
        bf16_t* outp_ = YA + (size_t)(rowbase + chunk * 128 + tokE) * D + cb * 64 + hc * 32 + c0E;
        unsigned long long q0 = 0, q1 = 0, q2 = 0, q3 = 0;
        if (second) { const unsigned long long* pq = (const unsigned long long*)outp_;
            q0 = __hip_atomic_load(pq, __ATOMIC_RELAXED, __HIP_MEMORY_SCOPE_AGENT); q1 = __hip_atomic_load(pq + 1, __ATOMIC_RELAXED, __HIP_MEMORY_SCOPE_AGENT);
            q2 = __hip_atomic_load(pq + 2, __ATOMIC_RELAXED, __HIP_MEMORY_SCOPE_AGENT); q3 = __hip_atomic_load(pq + 3, __ATOMIC_RELAXED, __HIP_MEMORY_SCOPE_AGENT); }
        if (step + 1 < 34) SCAN_LOAD(step + 1);
        const int c = ht & 31, seg = ht >> 5;
        {
            float h = 0.f, P = 1.f;
#pragma unroll 8
            for (int p = seg * 16; p < seg * 16 + 16; ++p) { const int tok = half ? 127 - p : p; const float av = As[tok * 32 + c], uv = Us[tok * 32 + c];
                h = av * h + uv; P *= av; }
            segH[seg * 32 + c] = h; segP[seg * 32 + c] = P;
        }
        LBAR();
        {
            float cin = carry[(step & 1) * 32 + c];
            float sp_[7], sh_[7];
#pragma unroll
            for (int s2 = 0; s2 < 7; ++s2) { sp_[s2] = segP[s2 * 32 + c]; sh_[s2] = segH[s2 * 32 + c]; }
#pragma unroll
            for (int s2 = 0; s2 < 7; ++s2) cin = s2 < seg ? sp_[s2] * cin + sh_[s2] : cin;
            float hl = cin;
#pragma unroll 8
            for (int p = seg * 16; p < seg * 16 + 16; ++p) { const int tok = half ? 127 - p : p; hl = As[tok * 32 + c] * hl + Us[tok * 32 + c]; Us[tok * 32 + c] = hl; }
            if (seg == 7) carry[((step + 1) & 1) * 32 + c] = hl;
        }
        LBAR();
        {
            float o0[8], o1[8];
#pragma unroll
            for (int j = 0; j < 8; ++j) { o0[j] = Us[tokE * 32 + c0E + j]; o1[j] = Us[tokE * 32 + c0E + 8 + j]; }
            if (second) { float e0[8], e1[8]; u32x4 wA, wB; wA.x = (unsigned)q0; wA.y = (unsigned)(q0 >> 32); wA.z = (unsigned)q1; wA.w = (unsigned)(q1 >> 32); wB.x = (unsigned)q2; wB.y = (unsigned)(q2 >> 32); wB.z = (unsigned)q3; wB.w = (unsigned)(q3 >> 32);
                unpack8(wA, e0); unpack8(wB, e1);
#pragma unroll
                for (int j = 0; j < 8; ++j) { o0[j] += e0[j]; o1[j] += e1[j]; } }
            *(u32x4*)outp_ = pack8(o0); *(u32x4*)(outp_ + 8) = pack8(o1);
        }
    }
    asm volatile("s_waitcnt vmcnt(0)" ::: "memory");
#undef SCAN_GID
#undef SCAN_LOAD
}

DI void sgu_item(const Args& a, LAS unsigned char* lds, int l, int tc) {
    const int tid = tidx(), lane = tid & 63, w = tid >> 6, hh = lane >> 5, r32 = lane & 31;
    const int row0 = tc < 8 ? (tc >> 1) * CTX + (tc & 1) * 128 : TC + ((tc - 8) >> 5) * SEQ + ((tc - 8) & 31) * 128;
    LAS bf16_t* Wl = (LAS bf16_t*)lds;
    LAS bf16_t* Vn = (LAS bf16_t*)(lds + 34816);
    LAS float* st = (LAS float*)(lds + 75776);
    const bf16_t* ZV = (const bf16_t*)(wsp() + WS_ZV); bf16_t* ZU = (bf16_t*)(wsp() + WS_ZU);
    for (int t = w * 16; t < w * 16 + 16; ++t) {
        const bf16_t* p = ZV + (size_t)(row0 + t) * D + lane * 16;
        float x0[8], x1[8]; unpack8(*(const u32x4*)p, x0); unpack8(*(const u32x4*)(p + 8), x1);
        float s = 0.f;
#pragma unroll
        for (int j = 0; j < 8; ++j) s += x0[j] + x1[j];
        const float mean = wave_sum(s) * (1.0f / D); float q = 0.f;
#pragma unroll
        for (int j = 0; j < 8; ++j) { const float d0 = x0[j] - mean, d1 = x1[j] - mean; q += d0 * d0 + d1 * d1; }
        const float var = wave_sum(q) * (1.0f / D);
        if (lane == 0) { st[t * 2] = mean; st[t * 2 + 1] = 1.0f / sqrtf(var + EPS); }
    }
    __syncthreads();
    const int tokS = tid >> 2, cS = (tid & 3) * 32;
    const float meanS = st[tokS * 2], rstdS = st[tokS * 2 + 1];
    f32x4 wreg[8]; u32x4 vreg[4], ureg[4];
#define SGU_LOAD(g_) do { const float* ws_ = inp<17>() + ((size_t)l * 8 + (g_)) * 16384; \
        _Pragma("unroll") for (int it = 0; it < 8; ++it) wreg[it] = *(const f32x4*)(ws_ + (it * 512 + tid) * 4); \
        const bf16_t* vp_ = ZV + (size_t)(row0 + tokS) * D + (g_) * 128 + cS; const bf16_t* up_ = ZU + (size_t)(row0 + tokS) * D + (g_) * 128 + cS; \
        _Pragma("unroll") for (int q4 = 0; q4 < 4; ++q4) { vreg[q4] = *(const u32x4*)(vp_ + q4 * 8); ureg[q4] = *(const u32x4*)(up_ + q4 * 8); } } while (0)
    SGU_LOAD(0);
    for (int g = 0; g < 8; ++g) {
        u32x4 ucur[4];
        {
#pragma unroll
            for (int it = 0; it < 8; ++it) { const int idx = (it * 512 + tid) * 4; const f32x4 v = wreg[it]; const int p = idx >> 7, q = idx & 127;
                u32x2 o; o.x = pk2(v.x, v.y); o.y = pk2(v.z, v.w); *(LAS u32x2*)(Wl + p * 136 + q) = o; }
            const float* lg = inp<15>() + (size_t)l * D + g * 128 + cS; const float* lb = inp<16>() + (size_t)l * D + g * 128 + cS;
#pragma unroll
            for (int q4 = 0; q4 < 4; ++q4) { float x[8]; unpack8(vreg[q4], x);
                const f32x4 g0 = *(const f32x4*)(lg + q4 * 8), g1 = *(const f32x4*)(lg + q4 * 8 + 4), b0 = *(const f32x4*)(lb + q4 * 8), b1 = *(const f32x4*)(lb + q4 * 8 + 4);
#pragma unroll
                for (int j = 0; j < 8; ++j) { const float gg = j < 4 ? g0[j & 3] : g1[j & 3], bb = j < 4 ? b0[j & 3] : b1[j & 3]; x[j] = (x[j] - meanS) * rstdS * gg + bb; }
                *(LAS u32x4*)(Vn + tokS * 160 + cS + q4 * 8) = pack8(x); ucur[q4] = ureg[q4]; }
        }
        if (g + 1 < 8) SGU_LOAD(g + 1);
        LBAR();
        {
            const int pt = w >> 1, ch = w & 1;
            f32x16 acc[2];
#pragma unroll
            for (int i = 0; i < 16; ++i) { acc[0][i] = 0.f; acc[1][i] = 0.f; }
#pragma unroll
            for (int s = 0; s < 8; ++s) { const bf16x8 af = *(const LAS bf16x8*)(Wl + (32 * pt + r32) * 136 + 16 * s + 8 * hh);
#pragma unroll
                for (int nt = 0; nt < 2; ++nt) { const LAS bf16_t* bp = Vn + (16 * s + 8 * hh + ((lane & 15) >> 2)) * 160 + 64 * ch + 32 * nt + 16 * ((lane >> 4) & 1) + 4 * (lane & 3);
                    const bf16x8 bfr = tr_read2(bp, bp + 4 * 160); acc[nt] = MFMA32(af, bfr, acc[nt]); } }
            const float* sb = inp<18>() + ((size_t)l * 8 + g) * 128 + 32 * pt + 4 * hh;
            f32x4 sbv[4];
#pragma unroll
            for (int i4 = 0; i4 < 4; ++i4) sbv[i4] = *(const f32x4*)(sb + 8 * i4);
            LBAR();
            LAS bf16_t* Mx = Wl;
#pragma unroll
            for (int nt = 0; nt < 2; ++nt)
#pragma unroll
                for (int i = 0; i < 16; ++i) { const int pp = 32 * pt + (i & 3) + 8 * (i >> 2) + 4 * hh, c = 64 * ch + 32 * nt + r32;
                    Mx[pp * 136 + c] = f2bf(acc[nt][i] + sbv[i >> 2][i & 3]); }
            LBAR();
            bf16_t* up = ZU + (size_t)(row0 + tokS) * D + g * 128 + cS;
#pragma unroll
            for (int q4 = 0; q4 < 4; ++q4) { float uu[8], mm[8]; unpack8(ucur[q4], uu); unpack8(*(const LAS u32x4*)(Mx + tokS * 136 + cS + q4 * 8), mm);
#pragma unroll
                for (int j = 0; j < 8; ++j) uu[j] *= mm[j];
                *(u32x4*)(up + q4 * 8) = pack8(uu); }
        }
        LBAR();
    }
#undef SGU_LOAD
}

DI void attn_tile(const LAS bf16_t* Ks, const LAS bf16_t* Vt, int kb, const bf16x8 (&qf)[2][4], float (&m)[2], float (&ls)[2], f32x16 (&o)[2][2],
                  int r32, int hh, bool masked, int qloc0, int kv_lo, int kv_hi) {
    bf16x8 kf[4];
#pragma unroll
    for (int s = 0; s < 4; ++s) kf[s] = *(const LAS bf16x8*)(Ks + (kb + r32) * 72 + 16 * s + 8 * hh);
    bf16x8 pf[2][2];
#pragma unroll
    for (int qt = 0; qt < 2; ++qt) {
        f32x16 sc;
#pragma unroll
        for (int i = 0; i < 16; ++i) sc[i] = 0.f;
#pragma unroll
        for (int s = 0; s < 4; ++s) sc = MFMA32(kf[s], qf[qt][s], sc);
        if (masked) { const int ql = qloc0 + 32 * qt + r32;
#pragma unroll
            for (int i = 0; i < 16; ++i) { const int key = kb + (i & 3) + 8 * (i >> 2) + 4 * hh; const int df = key - 128 - ql;
                const bool ok = (df >= -128) && (df <= 128) && (key >= kv_lo) && (key < kv_hi); sc[i] = ok ? sc[i] : -1e30f; } }
        float mx = sc[0];
#pragma unroll
        for (int i = 1; i < 16; ++i) mx = fmaxf(mx, sc[i]);
        mx = fmaxf(mx, __shfl_xor(mx, 32));
        const float mn = fmaxf(m[qt], mx); const float alpha = fexp2(m[qt] - mn); m[qt] = mn;
        float p[16]; float rs = 0.f;
#pragma unroll
        for (int i = 0; i < 16; ++i) { p[i] = fexp2(sc[i] - mn); rs += p[i]; }
        ls[qt] = ls[qt] * alpha + rs;
        if (__any(alpha != 1.0f)) {
#pragma unroll
            for (int i = 0; i < 16; ++i) { o[qt][0][i] *= alpha; o[qt][1][i] *= alpha; } }
#pragma unroll
        for (int ks = 0; ks < 2; ++ks) { u32x4 w; w.x = pk2(p[8 * ks], p[8 * ks + 1]); w.y = pk2(p[8 * ks + 2], p[8 * ks + 3]); w.z = pk2(p[8 * ks + 4], p[8 * ks + 5]); w.w = pk2(p[8 * ks + 6], p[8 * ks + 7]);
            pf[qt][ks] = __builtin_bit_cast(bf16x8, w); }
    }
#pragma unroll
    for (int dt = 0; dt < 2; ++dt)
#pragma unroll
        for (int ks = 0; ks < 2; ++ks) { const LAS bf16_t* vp = Vt + (kb + 16 * ks + 4 * hh + ((r32 & 15) >> 2)) * 72 + 32 * dt + 16 * (r32 >> 4) + 4 * (r32 & 3);
            const bf16x8 vf = tr_read2(vp, vp + 8 * 72);
#pragma unroll
            for (int qt = 0; qt < 2; ++qt) o[qt][dt] = MFMA32(vf, pf[qt][ks], o[qt][dt]); }
}

template <bool ctxstage> DI void attn_stage(const Args& a, LAS bf16_t* Ks, LAS bf16_t* Vt, int l, int b, int n, int kvh) {
    const int tid = tidx(), e = tid & 7;
    const bf16_t* ZK = (const bf16_t*)(wsp() + WS_ZK); const bf16_t* ZVV = (const bf16_t*)(wsp() + WS_ZVV);
    const float* cosT = (const float*)(wsp() + WS_ROPE); const float* sinT = cosT + 1024;
    const float* kg = inp<20>() + l * 64 + e * 8;
    float kgv[8];
#pragma unroll
    for (int j = 0; j < 8; ++j) kgv[j] = kg[j];
    constexpr int NP = 2;
    for (int pg = 0; pg < (ctxstage ? 2 : 3); ++pg) {
    u32x4 kwa[NP], vwa[NP];
#pragma unroll
    for (int ps = 0; ps < NP; ++ps) {
        const int key = (pg * NP + ps) * 64 + (tid >> 3);
        int kt = 0, row; bool valid = true;
        if (ctxstage) row = b * CTX + key; else { kt = n * 128 - 128 + key; valid = (kt >= 0) && (kt < SEQ); kt = kt < 0 ? 0 : (kt >= SEQ ? SEQ - 1 : kt); row = TC + b * SEQ + kt; }
        kwa[ps] = (u32x4){0u, 0u, 0u, 0u}; vwa[ps] = (u32x4){0u, 0u, 0u, 0u};
        if (valid) { kwa[ps] = *(const u32x4*)(ZK + (size_t)row * 256 + kvh * 64 + e * 8); vwa[ps] = *(const u32x4*)(ZVV + (size_t)row * 256 + kvh * 64 + e * 8); }
    }
#pragma unroll
    for (int ps = 0; ps < NP; ++ps) {
        const int key = (pg * NP + ps) * 64 + (tid >> 3);
        int kt = 0;
        if (!ctxstage) { kt = n * 128 - 128 + key; kt = kt < 0 ? 0 : (kt >= SEQ ? SEQ - 1 : kt); }
        const u32x4 kw = kwa[ps], vw = vwa[ps];
        float x[8]; unpack8(kw, x);
        float ss = 0.f;
#pragma unroll
        for (int j = 0; j < 8; ++j) ss += x[j] * x[j];
        ss += __shfl_xor(ss, 1); ss += __shfl_xor(ss, 2); ss += __shfl_xor(ss, 4);
        const float rstd = 1.0f / sqrtf(ss * (1.0f / 64.0f) + EPS);
#pragma unroll
        for (int j = 0; j < 8; ++j) x[j] = x[j] * rstd * kgv[j];
        if (!ctxstage) {
            const int pos = (e >> 2) ? (kt & 63) : (kt >> 6); const bool second = (e >> 1) & 1; const int f0 = 8 * (e & 1);
#pragma unroll
            for (int j = 0; j < 8; ++j) { const float pr = __shfl_xor(x[j], 2); const float cs = cosT[pos * 16 + f0 + j], sn = sinT[pos * 16 + f0 + j];
                x[j] = second ? (x[j] * cs + pr * sn) : (x[j] * cs - pr * sn); }
        }
        *(LAS u32x4*)(Ks + key * 72 + e * 8) = pack8(x);
        *(LAS u32x4*)(Vt + key * 72 + e * 8) = vw;
    }
    }
}

DI void attn_item(const Args& a, LAS unsigned char* lds, int l, int kind, int b, int n, int kvh) {
    const int tid = tidx(), lane = tid & 63, w = tid >> 6, hh = lane >> 5, r32 = lane & 31;
    const int g = w >> 1, qhalf = w & 1, h = kvh * 4 + g, qloc0 = qhalf * 64;
    LAS bf16_t* Ks = (LAS bf16_t*)lds;
    LAS bf16_t* Vt = (LAS bf16_t*)(lds + 55296);
    bf16_t* ZQ = (bf16_t*)(wsp() + WS_ZQ);
    const float* cosT = (const float*)(wsp() + WS_ROPE); const float* sinT = cosT + 1024;
    const float* qg = inp<19>() + l * 64;
    const float SCL = 0.125f * LOG2E;
    bf16x8 qf[2][4];
#pragma unroll
    for (int qt = 0; qt < 2; ++qt) {
        const int qtok = n * 128 + qloc0 + 32 * qt + r32; const int row = kind ? b * CTX + qtok : TC + b * SEQ + qtok;
        const bf16_t* qp = ZQ + (size_t)row * D + h * 64 + 8 * hh;
        float v[4][8]; float ss = 0.f;
#pragma unroll
        for (int s = 0; s < 4; ++s) { unpack8(*(const u32x4*)(qp + 16 * s), v[s]);
#pragma unroll
            for (int j = 0; j < 8; ++j) ss += v[s][j] * v[s][j]; }
        ss += __shfl_xor(ss, 32);
        const float rstd = 1.0f / sqrtf(ss * (1.0f / 64.0f) + EPS);
#pragma unroll
        for (int s = 0; s < 4; ++s)
#pragma unroll
            for (int j = 0; j < 8; ++j) v[s][j] = v[s][j] * rstd * qg[16 * s + 8 * hh + j];
        if (!kind) { const int prow = qtok >> 6, pcol = qtok & 63;
#pragma unroll
            for (int j = 0; j < 8; ++j) { const int f = 8 * hh + j;
                const float c0 = cosT[prow * 16 + f], s0 = sinT[prow * 16 + f], c1 = cosT[pcol * 16 + f], s1 = sinT[pcol * 16 + f];
                const float t1 = v[0][j], t2 = v[1][j]; v[0][j] = t1 * c0 - t2 * s0; v[1][j] = t2 * c0 + t1 * s0;
                const float t3 = v[2][j], t4 = v[3][j]; v[2][j] = t3 * c1 - t4 * s1; v[3][j] = t4 * c1 + t3 * s1; } }
#pragma unroll
        for (int s = 0; s < 4; ++s) {
#pragma unroll
            for (int j = 0; j < 8; ++j) v[s][j] *= SCL;
            qf[qt][s] = __builtin_bit_cast(bf16x8, pack8(v[s])); }
    }
    const float sk = inp<21>()[l * 16 + h] * LOG2E;
    float m[2] = {sk, sk}; float ls[2]; ls[0] = ls[1] = (hh == 0) ? 1.0f : 0.0f;
    f32x16 o[2][2];
#pragma unroll
    for (int i = 0; i < 16; ++i) { o[0][0][i] = 0.f; o[0][1][i] = 0.f; o[1][0][i] = 0.f; o[1][1][i] = 0.f; }
    if (!kind) {
        attn_stage<false>(a, Ks, Vt, l, b, n, kvh);
        __syncthreads();
        const int kv_lo = 128 - n * 128 > 0 ? 128 - n * 128 : 0; const int kv_hi = (SEQ - n * 128 + 128) < 384 ? (SEQ - n * 128 + 128) : 384;
        int t_lo = qhalf ? 2 : 0, t_hi = qhalf ? 12 : 10;
        if (t_lo < (kv_lo >> 5)) t_lo = kv_lo >> 5;
        if (t_hi > (kv_hi >> 5)) t_hi = kv_hi >> 5;
        for (int t = t_lo; t < t_hi; ++t) { const int kb = 32 * t; const bool interior = (kb >= qloc0 + 63) && (kb <= qloc0 + 225) && (kb >= kv_lo) && (kb + 32 <= kv_hi);
            attn_tile(Ks, Vt, kb, qf, m, ls, o, r32, hh, !interior, qloc0, kv_lo, kv_hi); }
        __syncthreads();
    }
    attn_stage<true>(a, Ks, Vt, l, b, n, kvh);
    __syncthreads();
    for (int t = 0; t < 8; ++t) attn_tile(Ks, Vt, 32 * t, qf, m, ls, o, r32, hh, false, qloc0, 0, 256);
#pragma unroll
    for (int qt = 0; qt < 2; ++qt) {
        const float lt = ls[qt] + __shfl_xor(ls[qt], 32); const float inv = 1.0f / lt;
        const int qtok = n * 128 + qloc0 + 32 * qt + r32; const int row = kind ? b * CTX + qtok : TC + b * SEQ + qtok;
        bf16_t* op = ZQ + (size_t)row * D + h * 64 + 4 * hh;
#pragma unroll
        for (int dt = 0; dt < 2; ++dt)
#pragma unroll
            for (int q4 = 0; q4 < 4; ++q4) { u32x2 wv; wv.x = pk2(o[qt][dt][4 * q4] * inv, o[qt][dt][4 * q4 + 1] * inv); wv.y = pk2(o[qt][dt][4 * q4 + 2] * inv, o[qt][dt][4 * q4 + 3] * inv);
                *(u32x2*)(op + 32 * dt + 8 * q4) = wv; }
    }
}

DI void phase_mix(const Args& a, LAS unsigned char* lds, int l) {
    const int tid = tidx();
    const bool last = (l == DEPTH - 1);
    unsigned* ctr = (unsigned*)(wsp() + WS_CTL) + l;
    LAS int* slot = (LAS int*)(lds + LDS_MISC);
    const int n_scan = 128, n_attl = 512, n_attc = last ? 0 : 32, n_sgu = last ? 128 : 136;
    const int total = n_scan + n_attl + n_attc + n_sgu;
    for (;;) {
        __syncthreads();
        if (tid == 0) *slot = (int)atomicAdd(ctr, 1u);
        __syncthreads();
        int it = *slot;
        if (it >= total) break;
#ifndef NO_SCAN
#ifdef PROBE_K
        const unsigned long long pt0 = __builtin_amdgcn_s_memrealtime();
#define PT_END(k, mx) do { if (tid == 0) { const unsigned dt = (unsigned)(__builtin_amdgcn_s_memrealtime() - pt0); if (mx) atomicMax((unsigned*)(wsp() + WS_CTL) + 128 + (k), dt); else atomicAdd((unsigned*)(wsp() + WS_CTL) + 128 + (k), dt); } } while (0)
#else
#define PT_END(k, mx) do {} while (0)
#endif
        if (it < n_scan) { scan_item(a, lds, l, it >> 5, (it >> 1) & 15, it & 1); PT_END(0, 1); continue; }
#endif
        it -= n_scan;
#ifndef NO_ATT
        if (it < n_attl) { attn_item(a, lds, l, 0, it >> 7, (it >> 2) & 31, it & 3); PT_END(1, 0); continue; }
#endif
        it -= n_attl;
#ifndef NO_ATT
        if (it < n_attc) { attn_item(a, lds, l, 1, it >> 3, (it >> 2) & 1, it & 3); PT_END(3, 0); continue; }
#endif
        it -= n_attc;
#ifndef NO_SGU
        sgu_item(a, lds, l, last ? it + 8 : it);
#endif
        PT_END(2, 0);
    }
}


#define XB_TMO      128
#define XB_XCNT(j)  (256  + 64 * (j))
#define XB_XSUB(j)  (1280 + 64 * (j))
#define XB_XGEN(j)  (2304 + 64 * (j))
#define XB_TOP      3328
#define XB_TOPGEN   3392
#define XCD_BAR_WORDS 3456
#define XB_SPIN_CAP (1u << 18)

__device__ __forceinline__ unsigned xb_ld(unsigned* p)              { return __hip_atomic_load(p, __ATOMIC_RELAXED, __HIP_MEMORY_SCOPE_AGENT); }
__device__ __forceinline__ unsigned xb_add(unsigned* p, unsigned v) { return __hip_atomic_fetch_add(p, v, __ATOMIC_RELAXED, __HIP_MEMORY_SCOPE_AGENT); }
__device__ __forceinline__ unsigned xb_xcc_id() { return (unsigned)__builtin_amdgcn_s_getreg((3 << 11) | 20) & 0xFu; }
#define XB_SPIN(cond, bar) do { unsigned _sp = 0; while (cond) { __builtin_amdgcn_s_sleep(1); \
    if ((++_sp & 255u) == 0u) { if (xb_ld(&(bar)[XB_TMO])) break; if (_sp > XB_SPIN_CAP) { atomicAdd(&(bar)[XB_TMO], 1u); break; } } } } while (0)

struct XcdBarrier {
    unsigned* bar; unsigned x;
    volatile LAS unsigned* st;
};

__device__ __forceinline__ XcdBarrier xcd_barrier_post(unsigned* bar, volatile LAS unsigned* st) {
    XcdBarrier b; b.bar = bar; b.x = xb_xcc_id(); b.st = st;
    if (threadIdx.x == 0) (void)xb_add(&bar[XB_XCNT(b.x)], 1u);
    return b;
}
__device__ __forceinline__ void xcd_barrier_complete(unsigned* bar, unsigned x, unsigned& nloc, unsigned& nx) {
    const unsigned G = gridDim.x * gridDim.y * gridDim.z;
    unsigned sum, cnt, mine, sp = 0u;
    for (;;) {
        sum = 0u; cnt = 0u; mine = 0u;
#pragma unroll
        for (unsigned j = 0; j < 16; ++j) { const unsigned c = xb_ld(&bar[XB_XCNT(j)]); sum += c; cnt += (c > 0u) ? 1u : 0u; mine = (j == x) ? c : mine; }
        if (sum == G) break;
        __builtin_amdgcn_s_sleep(1);
        if ((++sp & 255u) == 0u) { if (xb_ld(&bar[XB_TMO])) break; if (sp > XB_SPIN_CAP) { atomicAdd(&bar[XB_TMO], 1u); break; } }
    }
    nloc = mine > 0u ? mine : 1u; nx = cnt > 0u ? cnt : 1u;
}

__device__ __forceinline__ void xcd_barrier(const XcdBarrier& b) {
    asm volatile("s_waitcnt vmcnt(0)" ::: "memory");
    __syncthreads();
    if (threadIdx.x == 0) {
        unsigned* bar = b.bar;
        __builtin_amdgcn_s_waitcnt(0);
        unsigned nloc = b.st[0], nx = b.st[1];
        if (nloc == 0u) { xcd_barrier_complete(bar, b.x, nloc, nx); b.st[0] = nloc; b.st[1] = nx; }
        const unsigned old = xb_add(&bar[XB_XSUB(b.x)], 1u);
        const unsigned gen = old / nloc;
        if (old + 1u == (gen + 1u) * nloc) {
            __builtin_amdgcn_fence(__ATOMIC_RELEASE, "agent");
            asm volatile("s_waitcnt vmcnt(0)" ::: "memory");
            const unsigned og = xb_add(&bar[XB_TOP], 1u);
            const unsigned tg = og / nx;
            if (og + 1u == (tg + 1u) * nx) xb_add(&bar[XB_TOPGEN], 1u);
            else XB_SPIN(xb_ld(&bar[XB_TOPGEN]) == tg, bar);
            __builtin_amdgcn_fence(__ATOMIC_ACQUIRE, "agent");
            xb_add(&bar[XB_XGEN(b.x)], 1u);
            asm volatile("s_waitcnt vmcnt(0)" ::: "memory");
        } else {
            XB_SPIN(xb_ld(&bar[XB_XGEN(b.x)]) == gen, bar);
            __builtin_amdgcn_fence(__ATOMIC_ACQUIRE, "agent");
            asm volatile("s_waitcnt vmcnt(0)" ::: "memory");
        }
    }
    __syncthreads();
}


DI void grid_barrier(unsigned* bar, unsigned target) {
    asm volatile("s_waitcnt vmcnt(0) lgkmcnt(0)" ::: "memory");
    __syncthreads();
    if (threadIdx.x == 0) {
        __builtin_amdgcn_fence(__ATOMIC_RELEASE, "agent");
        __hip_atomic_fetch_add(bar, 1u, __ATOMIC_RELAXED, __HIP_MEMORY_SCOPE_AGENT);
        while (__hip_atomic_load(bar, __ATOMIC_RELAXED, __HIP_MEMORY_SCOPE_AGENT) < target) __builtin_amdgcn_s_sleep(2);
        __builtin_amdgcn_fence(__ATOMIC_ACQUIRE, "agent");
    }
    __syncthreads();
}


#ifdef DBG_STOP
DI void dbg_dump(int which) {
    unsigned char* ws = wsp(); float* out = outp();
    const size_t n = (size_t)TL * D, stride = (size_t)gridDim.x * 512;
    const bf16_t* H = (const bf16_t*)(ws + WS_H); const bf16_t* MG = (const bf16_t*)(ws + WS_MG);
    const bf16_t* ZA = (const bf16_t*)(ws + WS_ZA); const bf16_t* ZU = (const bf16_t*)(ws + WS_ZU); const bf16_t* ZV = (const bf16_t*)(ws + WS_ZV); const bf16_t* ZQ = (const bf16_t*)(ws + WS_ZQ);
    const bf16_t* ZK = (const bf16_t*)(ws + WS_ZK); const bf16_t* ZVV = (const bf16_t*)(ws + WS_ZVV); const bf16_t* ZG = (const bf16_t*)(ws + WS_ZG);
    for (size_t i = (size_t)blockIdx.x * 512 + threadIdx.x; i < n; i += stride) {
        float v = 0.f;
        if (which == 1) v = bf1(H[i]) + bf1(H[i + (size_t)TC * D]);
        if (which == 2) v = bf1(ZA[i]) + bf1(ZU[i]) + bf1(ZV[i]) + bf1(ZQ[i]) + bf1(ZG[i]) + bf1(ZG[i + n]) + bf1(ZG[i + 2 * n]) + bf1(ZK[i % ((size_t)T * 256)]) + bf1(ZVV[i % ((size_t)T * 256)]) + bf1(ZA[i + (size_t)TC * D]);
        if (which == 3) v = bf1(H[i + (size_t)TC * D]);
        if (which == 4) v = bf1(ZU[i + (size_t)TC * D]);
        if (which == 5) v = bf1(ZQ[i + (size_t)TC * D]);
        if (which == 6) v = bf1(MG[i + (size_t)TC * D]);
        if (which == 7) v = bf1(H[i]) + bf1(ZU[i]) + bf1(ZQ[i]);
        out[i] = v;
    }
}
#endif

__global__ void __launch_bounds__(512, 2) fwd_megakernel(Args a) {
    extern __shared__ __attribute__((aligned(16))) unsigned char shm[];
    LAS unsigned char* lds = (LAS unsigned char*)shm;
    {   volatile LAS unsigned* stz = (volatile LAS unsigned*)(lds + LDS_MISC + 16);
        if (threadIdx.x < 2) stz[threadIdx.x] = 0u;
        __syncthreads(); }
    (void)xcd_barrier_post((unsigned*)(wsp() + WS_BAR), (volatile LAS unsigned*)(lds + LDS_MISC + 16));
#define GRID_SYNC() do { XcdBarrier xb_; xb_.bar = (unsigned*)(wsp() + WS_BAR); xb_.x = xb_xcc_id(); xb_.st = (volatile LAS unsigned*)(lds + LDS_MISC + 16); xcd_barrier(xb_); } while (0)
#ifdef PROBE_K
    unsigned long long pr_prev = __builtin_amdgcn_s_memrealtime(), pr_acc = 0;
#define PROBE(k) do { const unsigned long long now_ = __builtin_amdgcn_s_memrealtime(); if ((k) == PROBE_K || PROBE_K == 99) pr_acc += now_ - pr_prev; pr_prev = now_; } while (0)
#else
#define PROBE(k) do {} while (0)
#endif
    const int G = gridDim.x;
    unsigned char* ws = wsp();

#if !defined(ONLY) || ONLY == 0
    phase_prep(a, lds);
#endif
    GRID_SYNC();
    PROBE(0);
    for (int l = 0; l < DEPTH; ++l) {
        const bool last = (l == DEPTH - 1);
        const int pm0 = last ? 4 : 0, nM = last ? 64 : 68;
        const float* modl = (const float*)(ws + WS_MOD) + (size_t)l * 5 * 6144;
        const size_t wto = (size_t)(l & 1) * WT_BYTES;
#if !defined(ONLY) || ONLY == 1
        phase_norm(a, lds, l, 0);
#endif
        GRID_SYNC();
    PROBE(1);
#if defined(DBG_STOP) && DBG_STOP == 1
        dbg_dump(1); return;
#endif
        {
            pg8::Sched S; S.nM = 68; S.nN = INW / 256; S.nwg = S.nM * S.nN; S.G = G; S.c = bidx(); S.nseg = 1; S.pm0 = 0;
            S.A0 = (const char*)(ws + WS_H); S.d1 = 0; S.d2 = 0; S.B0 = (const char*)(ws + wto + WS_WIN); S.bseg = 0; S.tstep = (size_t)256 * D * 2;
            pg8::EpiIn E{ws};
            pg8::gemm_phase<pg8::EpiIn, pg8::Sched>(lds, D, D, S, E);
        }
        GRID_SYNC();
    PROBE(2);
#if defined(DBG_STOP) && DBG_STOP == 2
        dbg_dump(2); return;
#endif
        phase_mix(a, lds, l);
        GRID_SYNC();
    PROBE(3);
#if defined(DBG_STOP) && DBG_STOP >= 3 && DBG_STOP <= 5
        dbg_dump(DBG_STOP); return;
#endif
#if defined(DBG_STOP) && DBG_STOP == 7
        dbg_dump(7); return;
#endif
        {
            pg8::Sched S; S.nM = 64; S.nN = 4; S.nwg = S.nM * S.nN; S.G = G; S.c = bidx(); S.nseg = 3; S.pm0 = 4;
            S.A0 = (const char*)(ws + WS_H); S.d1 = 2 * SLOT; S.d2 = 2 * SLOT; S.B0 = (const char*)(ws + wto + WS_WBR); S.bseg = (size_t)D * D * 2; S.tstep = (size_t)256 * D * 2;
            pg8::EpiMerge E{(bf16_t*)(ws + WS_MG), (const bf16_t*)(ws + WS_ZG)};
            pg8::gemm_phase<pg8::EpiMerge, pg8::Sched>(lds, D, D, S, E);
        }
        if (!last) {
            pg8::SchedList S; S.n = 48; S.G = G; S.c = bidx(); S.nN = 4; S.nS = 3; S.nQ = 1;
            S.A0 = (const char*)(ws + WS_H); S.a_pm = (size_t)256 * D * 2; S.a_s = 2 * SLOT; S.a_q = 0;
            S.B0 = (const char*)(ws + wto + WS_WBR); S.b_pn = (size_t)256 * D * 2; S.b_s = (size_t)D * D * 2; S.b_q = 0;
            pg8::EpiMergeCtx E{(bf16_t*)(ws + WS_PC), (const bf16_t*)(ws + WS_ZG)};
            pg8::gemm_phase<pg8::EpiMergeCtx, pg8::SchedList>(lds, D, D, S, E);
        }
        GRID_SYNC();
    PROBE(4);
#if defined(DBG_STOP) && DBG_STOP == 6
        dbg_dump(6); return;
#endif
        {
            pg8::Sched S; S.nM = 64; S.nN = 4; S.nwg = S.nM * S.nN; S.G = G; S.c = bidx(); S.nseg = 1; S.pm0 = 4;
            S.A0 = (const char*)(ws + WS_MG); S.d1 = 0; S.d2 = 0; S.B0 = (const char*)(ws + wto + WS_WOUT); S.bseg = 0; S.tstep = (size_t)256 * D * 2;
            pg8::EpiRes E{(const float*)(ws + WS_XC), l == 0 ? inp<0>() : (const float*)outp(), (float*)(ws + WS_XC), outp(), modl + 2 * 1024};
            pg8::gemm_phase<pg8::EpiRes, pg8::Sched>(lds, D, D, S, E);
        }
        if (!last) {
            pg8::SchedList S; S.n = 192; S.G = G; S.c = bidx(); S.nN = 4; S.nS = 3; S.nQ = 4;
            S.A0 = (const char*)(ws + WS_PC); S.a_pm = (size_t)256 * D * 2; S.a_s = (size_t)TC * D * 2; S.a_q = 256 * 2;
            S.B0 = (const char*)(ws + wto + WS_WOUT); S.b_pn = (size_t)256 * D * 2; S.b_s = 0; S.b_q = 256 * 2;
            pg8::EpiPartial E{(float*)(ws + WS_PX), 4};
            pg8::gemm_phase<pg8::EpiPartial, pg8::SchedList>(lds, 256, D, S, E);
        }
        GRID_SYNC();
    PROBE(5);
        phase_norm(a, lds, l, 1);
        GRID_SYNC();
    PROBE(6);
        {
            pg8::Sched S; S.nM = nM; S.nN = DFF / 256; S.nwg = S.nM * S.nN; S.G = G; S.c = bidx(); S.nseg = 1; S.pm0 = pm0;
            S.A0 = (const char*)(ws + WS_H); S.d1 = 0; S.d2 = 0; S.B0 = (const char*)(ws + wto + WS_WFF1); S.bseg = 0; S.tstep = (size_t)256 * D * 2;
            pg8::EpiFF1 E{(bf16_t*)(ws + WS_HID)};
            pg8::gemm_phase<pg8::EpiFF1, pg8::Sched>(lds, D, D, S, E);
        }
        GRID_SYNC();
    PROBE(7);
        {
            pg8::Sched S; S.nM = 64; S.nN = 4; S.nwg = S.nM * S.nN; S.G = G; S.c = bidx(); S.nseg = 1; S.pm0 = 4;
            S.A0 = (const char*)(ws + WS_HID); S.d1 = 0; S.d2 = 0; S.B0 = (const char*)(ws + wto + WS_WFF2); S.bseg = 0; S.tstep = (size_t)256 * DFF * 2;
            pg8::EpiRes E{(const float*)(ws + WS_XC), (const float*)outp(), (float*)(ws + WS_XC), outp(), modl + 5 * 1024};
            pg8::gemm_phase<pg8::EpiRes, pg8::Sched>(lds, DFF, DFF, S, E);
        }
        if (!last) {
            pg8::SchedList S; S.n = 64; S.G = G; S.c = bidx(); S.nN = 4; S.nS = 1; S.nQ = 4;
            S.A0 = (const char*)(ws + WS_HID); S.a_pm = (size_t)256 * DFF * 2; S.a_s = 0; S.a_q = 1024 * 2;
            S.B0 = (const char*)(ws + wto + WS_WFF2); S.b_pn = (size_t)256 * DFF * 2; S.b_s = 0; S.b_q = 1024 * 2;
            pg8::EpiPartial E{(float*)(ws + WS_PX), 4};
            pg8::gemm_phase<pg8::EpiPartial, pg8::SchedList>(lds, 1024, DFF, S, E);
        }
        if (!last && G > 64) { const int bq = bidx(); if (bq >= 64) convert_weights(l + 1, (size_t)((l + 1) & 1) * WT_BYTES, lds, bq - 64, G - 64, tidx()); }
        else if (!last) convert_weights(l + 1, (size_t)((l + 1) & 1) * WT_BYTES, lds, bidx(), G, tidx());
#ifdef PROBE_K
        GRID_SYNC();
#else
        if (!last) GRID_SYNC();
#endif
    PROBE(8);
    }
#ifdef PROBE_K
    if (blockIdx.x == 0 && threadIdx.x == 0) { float pv = (float)pr_acc * 0.01f; if (PROBE_K >= 30 && PROBE_K < 40) pv = (float)(((unsigned*)(wsp() + WS_CTL))[128 + PROBE_K - 30]) * 0.01f; { const float sc_ = exp10f(floorf(log10f(fmaxf(pv, 1.0f))) - 1.0f); pv = floorf(pv / sc_ + 0.5f) * sc_; } outp()[0] += pv; }
#endif
}

extern "C" void kernel_launch(void* const* d_in, const int* in_sizes, int n_in, void* d_out, int out_size, void* d_ws, size_t ws_size, hipStream_t stream) {
    static int grid = 0;
    if (grid == 0) {
        if (n_in != 27 || out_size != TL * D || ws_size < WS_END) { fprintf(stderr, "kernel_launch: unexpected shapes (n_in %d out %d ws %zu need %zu)\n", n_in, out_size, ws_size, (size_t)WS_END); grid = -1; return; }
        int dev = 0, cus = 0, per_cu = 0;
        hipGetDevice(&dev);
        hipDeviceGetAttribute(&cus, hipDeviceAttributeMultiprocessorCount, dev);
        hipFuncSetAttribute((const void*)fwd_megakernel, hipFuncAttributeMaxDynamicSharedMemorySize, LDS_BYTES);
        hipOccupancyMaxActiveBlocksPerMultiprocessor(&per_cu, (const void*)fwd_megakernel, 512, LDS_BYTES);
        if (per_cu < 1) { fprintf(stderr, "kernel_launch: occupancy query says %d blocks/CU\n", per_cu); per_cu = 1; }
        (void)hipGetLastError();
        grid = cus;
    }
    if (grid < 0) return;
    if (hipMemsetAsync((char*)d_ws + WS_CTL, 0, 32768, stream) != hipSuccess) { fprintf(stderr, "memset failed\n"); return; }
    Args a{};
    for (int i = 0; i < 27; ++i) a.in[i] = (const float*)d_in[i];
    a.out = (float*)d_out; a.ws = (unsigned char*)d_ws;
    void* args[] = {&a};
    hipError_t e = hipLaunchCooperativeKernel((const void*)fwd_megakernel, dim3(grid), dim3(512), args, LDS_BYTES, stream);
    if (e != hipSuccess) fprintf(stderr, "cooperative launch failed: %s (grid %d)\n", hipGetErrorString(e), grid);
}
```

```cpp
#define DBG_NOADD 0
#include <hip/hip_runtime.h>
#include <hip/hip_cooperative_groups.h>
#include <cstdio>
#include <cstdint>
namespace cg = cooperative_groups;

#define LAS __attribute__((address_space(3)))
#define DI __device__ __forceinline__
typedef unsigned short bf16_t;
typedef short bf16x8 __attribute__((ext_vector_type(8)));
typedef short s16x4 __attribute__((ext_vector_type(4)));
typedef float f32x2 __attribute__((ext_vector_type(2)));
typedef float f32x4 __attribute__((ext_vector_type(4)));
typedef float f32x16 __attribute__((ext_vector_type(16)));
typedef unsigned u32x2 __attribute__((ext_vector_type(2)));
typedef unsigned u32x4 __attribute__((ext_vector_type(4)));
typedef __bf16 bf16x2_t __attribute__((ext_vector_type(2)));

constexpr int D = 1024, NB = 4, SEQ = 4096, CTX = 256, DEPTH = 4, DFF = 4096;
constexpr int TC = NB * CTX;
constexpr int TL = NB * SEQ;
constexpr int T = TC + TL;
constexpr int INW = 7680;
constexpr float EPS = 1e-6f;
constexpr float LOG2E = 1.4426950408889634f;

constexpr size_t WS_CTL = 0;
constexpr size_t WS_BAR = 16384;
constexpr size_t WS_ROPE = 4096;
constexpr size_t WS_MOD = 65536;
constexpr size_t WS_XC = 1u << 20;
constexpr size_t WS_WIN = 5u << 20;
constexpr size_t WS_WBR = WS_WIN + (size_t)INW * D * 2;
constexpr size_t WS_WOUT = WS_WBR + (size_t)3 * D * D * 2;
constexpr size_t WS_WFF1 = WS_WOUT + (size_t)D * D * 2;
constexpr size_t WS_WFF2 = WS_WFF1 + (size_t)DFF * D * 2;
constexpr size_t SLOT = (size_t)T * D * 2;
constexpr size_t WT_BYTES = WS_WFF2 + (size_t)DFF * D * 2 - WS_WIN;
constexpr size_t WS_H = WS_WIN + 2 * WT_BYTES;
constexpr size_t WS_ZV = WS_H + SLOT;
constexpr size_t WS_ZU = WS_H + 2 * SLOT;
constexpr size_t WS_ZA = WS_H + 3 * SLOT;
constexpr size_t WS_ZQ = WS_H + 4 * SLOT;
constexpr size_t WS_ZK = WS_H + 5 * SLOT;
constexpr size_t WS_ZVV = WS_ZK + (size_t)T * 256 * 2;
constexpr size_t WS_ZG = WS_ZVV + (size_t)T * 256 * 2;
constexpr size_t WS_MG = WS_ZG + (size_t)T * 3072 * 2;
constexpr size_t WS_PC = WS_MG + SLOT;
constexpr size_t WS_PX = WS_PC + (size_t)3 * TC * D * 2;
constexpr size_t WS_END = WS_PX + (size_t)12 * TC * D * 4;
constexpr size_t WS_HID = WS_ZV;

constexpr int LDS_BYTES = 147456;
constexpr int LDS_MISC = 143360;

struct Args { const float* in[27]; float* out; unsigned char* ws; };


template <int OFF> DI const void* kargp() { const unsigned long long k = (unsigned long long)__builtin_amdgcn_kernarg_segment_ptr(); const void* p;
    asm volatile("s_load_dwordx2 %0, %1, %2\n\ts_waitcnt lgkmcnt(0)" : "=s"(p) : "s"(k), "n"(OFF) : "memory"); return p; }
template <int I> DI const float* inp() { return (const float*)kargp<I * 8>(); }
DI float* outp() { return (float*)kargp<27 * 8>(); }
DI unsigned char* wsp() { return (unsigned char*)kargp<28 * 8>(); }
DI int tidx() { int t = threadIdx.x; asm volatile("" : "+v"(t)); return t; }
DI int bidx() { int b = blockIdx.x; asm volatile("" : "+s"(b)); return b; }

DI unsigned pk2(float lo, float hi) { f32x2 v = {lo, hi}; bf16x2_t b = __builtin_convertvector(v, bf16x2_t); return __builtin_bit_cast(unsigned, b); }
DI float bflo(unsigned w) { return __uint_as_float(w << 16); }
DI float bfhi(unsigned w) { return __uint_as_float(w & 0xffff0000u); }
DI float bf1(bf16_t h) { return __uint_as_float(((unsigned)h) << 16); }
DI bf16_t f2bf(float f) { return (bf16_t)(pk2(f, 0.f) & 0xffffu); }
DI float fexp2(float x) { return __builtin_amdgcn_exp2f(x); }
DI float frcp(float x) { return __builtin_amdgcn_rcpf(x); }
DI float sigmoidf_(float x) { return frcp(1.0f + fexp2(-x * LOG2E)); }
DI float gelu_tanh(float x) { const float u = x + 0.044715f * x * x * x; return x * frcp(1.0f + fexp2(-1.5957691216f * LOG2E * u)); }
DI float wave_sum(float v) {
#pragma unroll
    for (int o = 1; o < 64; o <<= 1) v += __shfl_xor(v, o);
    return v;
}
DI void unpack8(const u32x4 w, float (&v)[8]) { v[0] = bflo(w.x); v[1] = bfhi(w.x); v[2] = bflo(w.y); v[3] = bfhi(w.y); v[4] = bflo(w.z); v[5] = bfhi(w.z); v[6] = bflo(w.w); v[7] = bfhi(w.w); }
DI u32x4 pack8(const float (&v)[8]) { u32x4 w; w.x = pk2(v[0], v[1]); w.y = pk2(v[2], v[3]); w.z = pk2(v[4], v[5]); w.w = pk2(v[6], v[7]); return w; }
typedef short v4i16_t __attribute__((ext_vector_type(4)));
DI bf16x8 tr_read2(const LAS bf16_t* p0, const LAS bf16_t* p1) {
    const v4i16_t a = __builtin_amdgcn_ds_read_tr16_b64_v4i16((LAS v4i16_t*)p0), b = __builtin_amdgcn_ds_read_tr16_b64_v4i16((LAS v4i16_t*)p1);
    bf16x8 r; r[0] = a[0]; r[1] = a[1]; r[2] = a[2]; r[3] = a[3]; r[4] = b[0]; r[5] = b[1]; r[6] = b[2]; r[7] = b[3]; return r;
}
#define MFMA32(a, b, c) __builtin_amdgcn_mfma_f32_32x32x16_bf16((a), (b), (c), 0, 0, 0)

namespace pg8 {
constexpr int BM = 256, BK = 64, HALF = 128, HTB = HALF * BK * 2, STAGE_BYTES = 8 * HTB, NXCD = 8, WGM = 8;
DI int lds_byte(int r, int c) { const int st = (r >> 4) * 2 + (c >> 5), rr = r & 15, cc = c & 31, ob = rr * 64 + cc * 2; return st * 1024 + (ob ^ (((ob >> 9) & 1) << 5)); }
DI void stage_rc(int b, int& R, int& C) { const int st = b / 1024, sb = b % 1024, swz = sb ^ (((sb >> 9) & 1) << 5); R = (st >> 1) * 16 + swz / 64; C = (st & 1) * 32 + (swz % 64) / 2; }
DI int perm32(int rho) { const int n = rho >> 4, i = rho & 15; return 8 * (i >> 2) + 4 * n + (i & 3); }

struct Unit { int pm, pn, seg, q; const char* A; const char* B; };

struct Sched {
    int nM, nN, nwg, G, c, nseg, pm0;
    const char *A0, *B0; size_t d1, d2, bseg, tstep;
    DI bool next(int i, Unit& u) const {
        int ti = i, seg = 0;
        if (nseg == 3) { ti = i / 3; seg = i - 3 * ti; }
        const long L = (long)ti * G + c; if (L >= nwg) return false;
        int wgid = (int)L; { const int q = nwg / NXCD, r = nwg % NXCD, xcd = wgid % NXCD, off = wgid / NXCD; wgid = (xcd < r ? xcd * (q + 1) : r * (q + 1) + (xcd - r) * q) + off; }
        const int nig = WGM * nN, gid = wgid / nig, fm = gid * WGM, gsz = (nM - fm) < WGM ? (nM - fm) : WGM;
        u.pm = pm0 + fm + ((wgid % nig) % gsz); u.pn = (wgid % nig) / gsz; u.seg = seg; u.q = 0;
        const size_t ao = (seg >= 1 ? d1 : (size_t)0) + (seg >= 2 ? d2 : (size_t)0);
        u.A = A0 + ao + (size_t)u.pm * tstep; u.B = B0 + (size_t)seg * bseg + (size_t)u.pn * tstep;
        return true;
    }
};

struct SchedList {
    int n, G, c, nN, nS, nQ; const char *A0, *B0; size_t a_pm, a_s, a_q, b_pn, b_s, b_q;
    DI bool next(int i, Unit& u) const {
        const int idx = i * G + c; if (idx >= n) return false;
        const int q = idx % nQ; int t = idx / nQ; const int sg = t % nS; t /= nS; const int pn = t % nN, pm = t / nN;
        u.pm = pm; u.pn = pn; u.seg = sg; u.q = q;
        u.A = A0 + (size_t)pm * a_pm + (size_t)sg * a_s + (size_t)q * a_q; u.B = B0 + (size_t)pn * b_pn + (size_t)sg * b_s + (size_t)q * b_q;
        return true;
    }
};

template <class Epi, class SchedT, bool ALIGN_EPI = true, bool SP2 = true>
DI void gemm_phase(LAS unsigned char* lds, const int K, const int pitch, const SchedT& S, const Epi& E) {
    const int tid = tidx(), wid = __builtin_amdgcn_readfirstlane(tid >> 6), lane = tid & 63, wr = wid >> 2, wc = wid & 3, fr = lane & 15, fq = lane >> 4;
    const int nt = K / BK;
    unsigned voffA[2], voffB[2];
#pragma unroll
    for (int i = 0; i < 2; ++i) { int R, C; stage_rc(tid * 16 + i * 8192, R, C); const int Rb = Epi::PERM ? ((R & ~31) + perm32(R & 31)) : R;
        voffA[i] = (unsigned)(R * pitch + C) * 2u; voffB[i] = (unsigned)(Rb * pitch + C) * 2u; }
    const size_t kstep = (size_t)(BK * 2);
    const size_t hstep = (size_t)HALF * pitch * 2;
    const unsigned ldsw = (unsigned)wid * 1024u;
    const int aoff = lds_byte(wr * 64 + fr, fq * 8), boff = lds_byte(wc * 32 + fr, fq * 8);
#define PG8_SA(b, h) (((b) * 2 + (h)) * HTB)
#define PG8_SB(b, h) ((4 + (b) * 2 + (h)) * HTB)
#define PG8_STAGE(bufoff, gbase, voff) do { _Pragma("unroll") for (int _i = 0; _i < 2; ++_i) \
        __builtin_amdgcn_global_load_lds((const unsigned*)((const char*)(gbase) + (voff)[_i]), (LAS unsigned*)(lds + (bufoff) + ldsw + _i * 8192), 16, 0, 0); } while (0)
#define PG8_LDA(dst, b, h) do { _Pragma("unroll") for (int m = 0; m < 4; ++m) _Pragma("unroll") for (int k = 0; k < 2; ++k) dst[m][k] = *(const LAS bf16x8*)(lds + PG8_SA(b, h) + aoff + m * 2048 + k * 1024); } while (0)
#define PG8_LDB(dst, b, h) do { _Pragma("unroll") for (int n = 0; n < 2; ++n) _Pragma("unroll") for (int k = 0; k < 2; ++k) dst[n][k] = *(const LAS bf16x8*)(lds + PG8_SB(b, h) + boff + n * 2048 + k * 1024); } while (0)
#define PG8_MMA(ai, bj, At, Bt) do { __builtin_amdgcn_s_setprio(1); _Pragma("unroll") for (int m = 0; m < 4; ++m) _Pragma("unroll") for (int n = 0; n < 2; ++n) _Pragma("unroll") for (int k = 0; k < 2; ++k) \
        acc[ai][bj][m][n] = __builtin_amdgcn_mfma_f32_16x16x32_bf16(Bt[n][k], At[m][k], acc[ai][bj][m][n], 0, 0, 0); __builtin_amdgcn_s_setprio(0); } while (0)
#define PG8_WAIT_V(n) asm volatile("s_waitcnt vmcnt(" #n ")" ::: "memory")
#define PG8_WAIT_L(n) asm volatile("s_waitcnt lgkmcnt(" #n ")" ::: "memory")
#define PG8_BAR __builtin_amdgcn_s_barrier()
#define PG8_SCHED __builtin_amdgcn_sched_barrier(0)
    Unit cur, nxt; int ui = 0;
    if (!S.next(0, cur)) return;
    f32x4 acc[2][2][4][2];
#pragma unroll
    for (int a = 0; a < 2; ++a)
#pragma unroll
        for (int b = 0; b < 2; ++b)
#pragma unroll
            for (int m = 0; m < 4; ++m)
#pragma unroll
                for (int n = 0; n < 2; ++n) acc[a][b][m][n] = (f32x4){0.f, 0.f, 0.f, 0.f};
    bf16x8 At[4][2], B0[2][2], B1[2][2];
    const char* cA = cur.A; const char* cB = cur.B;
    if constexpr (SP2) {
        PG8_STAGE(PG8_SB(0, 0), cB, voffB); PG8_STAGE(PG8_SB(0, 1), cB + hstep, voffB); PG8_STAGE(PG8_SA(0, 0), cA, voffA); PG8_STAGE(PG8_SA(0, 1), cA + hstep, voffA);
        if (wr == 1) PG8_BAR;
        PG8_WAIT_V(2); PG8_BAR;
        PG8_STAGE(PG8_SB(1, 0), cB + kstep, voffB); PG8_STAGE(PG8_SA(1, 0), cA + kstep, voffA); PG8_STAGE(PG8_SB(1, 1), cB + hstep + kstep, voffB);
        PG8_WAIT_V(6); PG8_BAR;
    } else {
        PG8_STAGE(PG8_SB(0, 0), cB, voffB); PG8_STAGE(PG8_SA(0, 0), cA, voffA); PG8_STAGE(PG8_SB(0, 1), cB + hstep, voffB); PG8_STAGE(PG8_SA(0, 1), cA + hstep, voffA);
        if (wr == 1) PG8_BAR;
        PG8_WAIT_V(4); PG8_BAR;
        PG8_STAGE(PG8_SB(1, 0), cB + kstep, voffB); PG8_STAGE(PG8_SA(1, 0), cA + kstep, voffA); PG8_STAGE(PG8_SB(1, 1), cB + hstep + kstep, voffB);
        PG8_WAIT_V(6); PG8_BAR;
    }
    for (;;) {
        const bool has_next = S.next(ui + 1, nxt);
        const char* nA = has_next ? nxt.A : cA; const char* nB = has_next ? nxt.B : cB;
        for (int t = 0; t < nt; t += 2) {
            const bool last = (t == nt - 2);
            const char* a1 = cA + (size_t)(t + 1) * kstep;
            const char* a2 = last ? nA : cA + (size_t)(t + 2) * kstep; const char* b2 = last ? nB : cB + (size_t)(t + 2) * kstep;
            const char* a3 = a2 + kstep; const char* b3 = b2 + kstep;
            if constexpr (SP2) {
            PG8_LDB(B0, 0, 0); PG8_LDB(B1, 0, 1); PG8_SCHED; PG8_LDA(At, 0, 0); PG8_STAGE(PG8_SA(1, 1), a1 + hstep, voffA);
            PG8_WAIT_V(8); PG8_WAIT_L(0); PG8_BAR; PG8_MMA(0, 0, At, B0); PG8_MMA(0, 1, At, B1); PG8_BAR; PG8_SCHED;
            PG8_LDA(At, 0, 1); PG8_STAGE(PG8_SB(0, 0), b2, voffB); PG8_STAGE(PG8_SB(0, 1), b2 + hstep, voffB); PG8_STAGE(PG8_SA(0, 0), a2, voffA);
            PG8_WAIT_V(8); PG8_WAIT_L(0); PG8_BAR; PG8_MMA(1, 0, At, B0); PG8_MMA(1, 1, At, B1); PG8_BAR; PG8_SCHED;
            PG8_LDB(B0, 1, 0); PG8_LDB(B1, 1, 1); PG8_SCHED; PG8_LDA(At, 1, 0); PG8_STAGE(PG8_SA(0, 1), a2 + hstep, voffA);
            PG8_WAIT_V(8); PG8_WAIT_L(0); PG8_BAR; PG8_MMA(0, 0, At, B0); PG8_MMA(0, 1, At, B1); PG8_BAR; PG8_SCHED;
            PG8_LDA(At, 1, 1); PG8_STAGE(PG8_SB(1, 0), b3, voffB); PG8_STAGE(PG8_SB(1, 1), b3 + hstep, voffB); PG8_STAGE(PG8_SA(1, 0), a3, voffA);
            PG8_WAIT_V(8); PG8_WAIT_L(0); PG8_BAR; PG8_MMA(1, 0, At, B0); PG8_MMA(1, 1, At, B1); PG8_BAR; PG8_SCHED;
            } else {
            PG8_LDB(B0, 0, 0); PG8_SCHED; PG8_LDA(At, 0, 0); PG8_STAGE(PG8_SA(1, 1), a1 + hstep, voffA);
            PG8_WAIT_L(8); PG8_BAR; PG8_WAIT_L(0); PG8_MMA(0, 0, At, B0); PG8_BAR; PG8_SCHED;
            PG8_LDB(B1, 0, 1); PG8_STAGE(PG8_SB(0, 0), b2, voffB);
            PG8_BAR; PG8_WAIT_L(0); PG8_MMA(0, 1, At, B1); PG8_BAR;
            PG8_LDA(At, 0, 1); PG8_STAGE(PG8_SA(0, 0), a2, voffA);
            PG8_BAR; PG8_WAIT_L(0); PG8_MMA(1, 0, At, B0); PG8_BAR; PG8_SCHED;
            PG8_STAGE(PG8_SB(0, 1), b2 + hstep, voffB);
            PG8_WAIT_V(6); PG8_BAR; PG8_MMA(1, 1, At, B1); PG8_BAR;
            PG8_LDB(B0, 1, 0); PG8_SCHED; PG8_LDA(At, 1, 0); PG8_STAGE(PG8_SA(0, 1), a2 + hstep, voffA);
            PG8_WAIT_L(8); PG8_BAR; PG8_WAIT_L(0); PG8_MMA(0, 0, At, B0); PG8_BAR; PG8_SCHED;
            PG8_LDB(B1, 1, 1); PG8_STAGE(PG8_SB(1, 0), b3, voffB);
            PG8_BAR; PG8_WAIT_L(0); PG8_MMA(0, 1, At, B1); PG8_BAR;
            PG8_LDA(At, 1, 1); PG8_STAGE(PG8_SA(1, 0), a3, voffA);
            PG8_BAR; PG8_WAIT_L(0); PG8_MMA(1, 0, At, B0); PG8_BAR; PG8_SCHED;
            PG8_STAGE(PG8_SB(1, 1), b3 + hstep, voffB);
            PG8_WAIT_V(6); PG8_BAR; PG8_MMA(1, 1, At, B1); PG8_BAR;
            }
        }
        if constexpr (ALIGN_EPI) { if (wr == 0) PG8_BAR; }
        E(acc, cur, wr, wc, fr, fq);
        if (!has_next) break;
        if (!Epi::KEEP || nxt.seg == 0) {
#pragma unroll
        for (int a = 0; a < 2; ++a)
#pragma unroll
            for (int b = 0; b < 2; ++b)
#pragma unroll
                for (int m = 0; m < 4; ++m)
#pragma unroll
                    for (int n = 0; n < 2; ++n) acc[a][b][m][n] = (f32x4){0.f, 0.f, 0.f, 0.f};
        }
        cur = nxt; cA = nA; cB = nB; ++ui;
        if constexpr (ALIGN_EPI) { if (wr == 1) PG8_BAR; }
    }
    PG8_WAIT_V(0);
    if constexpr (!ALIGN_EPI) { if (wr == 0) PG8_BAR; }
    PG8_BAR;
#undef PG8_SA
#undef PG8_SB
#undef PG8_STAGE
#undef PG8_LDA
#undef PG8_LDB
#undef PG8_MMA
#undef PG8_WAIT_V
#undef PG8_WAIT_L
#undef PG8_BAR
#undef PG8_SCHED
}

struct EpiIn {
    static constexpr bool PERM = true, KEEP = false;
    unsigned char* ws;
    DI void operator()(const f32x4 (&acc)[2][2][4][2], const Unit& u, int wr, int wc, int fr, int fq) const {
        const int pn = u.pn; bf16_t* base; int ldc, colt, mode;
        if (pn < 4) { base = (bf16_t*)(ws + WS_ZA); ldc = 1024; colt = pn * 256; mode = 0; }
        else if (pn < 8) { base = (bf16_t*)(ws + WS_ZU); ldc = 1024; colt = (pn - 4) * 256; mode = 1; }
        else if (pn < 12) { base = (bf16_t*)(ws + WS_ZV); ldc = 1024; colt = (pn - 8) * 256; mode = 1; }
        else if (pn < 16) { base = (bf16_t*)(ws + WS_ZQ); ldc = 1024; colt = (pn - 12) * 256; mode = 0; }
        else if (pn == 16) { base = (bf16_t*)(ws + WS_ZK); ldc = 256; colt = 0; mode = 0; }
        else if (pn == 17) { base = (bf16_t*)(ws + WS_ZVV); ldc = 256; colt = 0; mode = 0; }
        else { base = (bf16_t*)(ws + WS_ZG); ldc = 3072; colt = (pn - 18) * 256; mode = 2; }
        const int row0 = u.pm * BM + wr * 64 + fr, col0 = colt + wc * 32 + 8 * fq;
#pragma unroll
        for (int ai = 0; ai < 2; ++ai)
#pragma unroll
            for (int m = 0; m < 4; ++m) { bf16_t* rowp = base + (size_t)(row0 + ai * HALF + m * 16) * ldc + col0;
#pragma unroll
                for (int bj = 0; bj < 2; ++bj) { f32x4 v0 = acc[ai][bj][m][0], v1 = acc[ai][bj][m][1];
                    if (mode == 1) {
#pragma unroll
                        for (int j = 0; j < 4; ++j) { v0[j] = gelu_tanh(v0[j]); v1[j] = gelu_tanh(v1[j]); } }
                    else if (mode == 2) {
#pragma unroll
                        for (int j = 0; j < 4; ++j) { v0[j] = sigmoidf_(v0[j]); v1[j] = sigmoidf_(v1[j]); } }
                    u32x4 w; w.x = pk2(v0[0], v0[1]); w.y = pk2(v0[2], v0[3]); w.z = pk2(v1[0], v1[1]); w.w = pk2(v1[2], v1[3]);
                    *(u32x4*)(rowp + bj * HALF) = w; } }
    }
};
struct EpiMerge {
    static constexpr bool PERM = true, KEEP = true;
    bf16_t* Mg; const bf16_t* ZG;
    DI void operator()(f32x4 (&acc)[2][2][4][2], const Unit& u, int wr, int wc, int fr, int fq) const {
        const int row0 = u.pm * BM + wr * 64 + fr, col0 = u.pn * BM + wc * 32 + 8 * fq, seg = u.seg;
#pragma unroll
        for (int ai = 0; ai < 2; ++ai)
#pragma unroll
            for (int m = 0; m < 4; ++m) { const size_t r = (size_t)(row0 + ai * HALF + m * 16);
#pragma unroll
                for (int bj = 0; bj < 2; ++bj) {
                    const bf16_t* gp = ZG + r * 3072 + seg * 1024 + col0 + bj * HALF;
                    float g[8]; unpack8(*(const u32x4*)gp, g);
#pragma unroll
                    for (int j = 0; j < 8; ++j) g[j] = fmaxf(g[j], 1e-6f);
                    if (seg < 2) { float gn[8]; unpack8(*(const u32x4*)(gp + 1024), gn);
#pragma unroll
                        for (int j = 0; j < 8; ++j) g[j] *= frcp(fmaxf(gn[j], 1e-6f)); }
                    f32x4& v0 = acc[ai][bj][m][0]; f32x4& v1 = acc[ai][bj][m][1];
                    v0[0] *= g[0]; v0[1] *= g[1]; v0[2] *= g[2]; v0[3] *= g[3]; v1[0] *= g[4]; v1[1] *= g[5]; v1[2] *= g[6]; v1[3] *= g[7];
                    if (seg == 2) { u32x4 w; w.x = pk2(v0[0], v0[1]); w.y = pk2(v0[2], v0[3]); w.z = pk2(v1[0], v1[1]); w.w = pk2(v1[2], v1[3]);
                        *(u32x4*)(Mg + r * 1024 + col0 + bj * HALF) = w; } } }
    }
};
struct EpiRes {
    static constexpr bool PERM = false, KEEP = false;
    const float* src_c; const float* src_l; float* dst_c; float* dst_l; const float* gate;
    DI void operator()(const f32x4 (&acc)[2][2][4][2], const Unit& u, int wr, int wc, int fr, int fq) const {
        const int rowt = u.pm * BM; const int grp = rowt < TC ? 4 : ((rowt - TC) >> 12);
        const float* src = rowt < TC ? src_c + (size_t)rowt * D : src_l + (size_t)(rowt - TC) * D;
        float* dst = rowt < TC ? dst_c + (size_t)rowt * D : dst_l + (size_t)(rowt - TC) * D;
        const int row0 = wr * 64 + fr, col0 = u.pn * BM + wc * 32 + 4 * fq;
        const float* gp = gate + grp * 6144 + col0;
        f32x4 gv[2][2];
#pragma unroll
        for (int bj = 0; bj < 2; ++bj)
#pragma unroll
            for (int n = 0; n < 2; ++n) gv[bj][n] = *(const f32x4*)(gp + bj * HALF + n * 16);
#pragma unroll
        for (int ai = 0; ai < 2; ++ai)
#pragma unroll
            for (int m = 0; m < 4; ++m) { const size_t off = (size_t)(row0 + ai * HALF + m * 16) * D + col0;
#pragma unroll
                for (int bj = 0; bj < 2; ++bj)
#pragma unroll
                    for (int n = 0; n < 2; ++n) { const f32x4 xs = *(const f32x4*)(src + off + bj * HALF + n * 16);
                        *(f32x4*)(dst + off + bj * HALF + n * 16) = xs + gv[bj][n] * acc[ai][bj][m][n]; } }
    }
};
struct EpiMergeCtx {
    static constexpr bool PERM = true, KEEP = false;
    bf16_t* Pc; const bf16_t* ZG;
    DI void operator()(const f32x4 (&acc)[2][2][4][2], const Unit& u, int wr, int wc, int fr, int fq) const {
        const int row0 = u.pm * BM + wr * 64 + fr, col0 = u.pn * BM + wc * 32 + 8 * fq, seg = u.seg;
#pragma unroll
        for (int ai = 0; ai < 2; ++ai)
#pragma unroll
            for (int m = 0; m < 4; ++m) { const size_t r = (size_t)(row0 + ai * HALF + m * 16);
#pragma unroll
                for (int bj = 0; bj < 2; ++bj) {
                    const u32x4 gw = *(const u32x4*)(ZG + r * 3072 + seg * 1024 + col0 + bj * HALF);
                    float g[8]; unpack8(gw, g);
                    const f32x4 v0 = acc[ai][bj][m][0], v1 = acc[ai][bj][m][1];
                    u32x4 w; w.x = pk2(g[0] * v0[0], g[1] * v0[1]); w.y = pk2(g[2] * v0[2], g[3] * v0[3]); w.z = pk2(g[4] * v1[0], g[5] * v1[1]); w.w = pk2(g[6] * v1[2], g[7] * v1[3]);
                    *(u32x4*)(Pc + (size_t)seg * TC * D + r * 1024 + col0 + bj * HALF) = w; } }
    }
};
struct EpiPartial {
    static constexpr bool PERM = false, KEEP = false;
    float* PX; int nq;
    DI void operator()(const f32x4 (&acc)[2][2][4][2], const Unit& u, int wr, int wc, int fr, int fq) const {
        const int row0 = u.pm * BM + wr * 64 + fr, col0 = u.pn * BM + wc * 32 + 4 * fq;
        float* base = PX + (size_t)(u.seg * nq + u.q) * TC * D;
#pragma unroll
        for (int ai = 0; ai < 2; ++ai)
#pragma unroll
            for (int m = 0; m < 4; ++m) { float* rp = base + (size_t)(row0 + ai * HALF + m * 16) * D + col0;
#pragma unroll
                for (int bj = 0; bj < 2; ++bj)
#pragma unroll
                    for (int n = 0; n < 2; ++n) *(f32x4*)(rp + bj * HALF + n * 16) = acc[ai][bj][m][n]; }
    }
};
struct EpiFF1 {
    static constexpr bool PERM = true, KEEP = false;
    bf16_t* O;
    DI void operator()(const f32x4 (&acc)[2][2][4][2], const Unit& u, int wr, int wc, int fr, int fq) const {
        const int row0 = u.pm * BM + wr * 64 + fr, col0 = u.pn * BM + wc * 32 + 8 * fq;
#pragma unroll
        for (int ai = 0; ai < 2; ++ai)
#pragma unroll
            for (int m = 0; m < 4; ++m) { bf16_t* rowp = O + (size_t)(row0 + ai * HALF + m * 16) * DFF + col0;
#pragma unroll
                for (int bj = 0; bj < 2; ++bj) { f32x4 v0 = acc[ai][bj][m][0], v1 = acc[ai][bj][m][1];
#pragma unroll
                    for (int j = 0; j < 4; ++j) { const float a = fmaxf(v0[j], 0.f), b = fmaxf(v1[j], 0.f); v0[j] = a * a; v1[j] = b * b; }
                    u32x4 w; w.x = pk2(v0[0], v0[1]); w.y = pk2(v0[2], v0[3]); w.z = pk2(v1[0], v1[1]); w.w = pk2(v1[2], v1[3]);
                    *(u32x4*)(rowp + bj * HALF) = w; } }
    }
};
}

DI void phase_prep(const Args& a, LAS unsigned char* lds) {
    const int tid = tidx(), bid = bidx(), G = gridDim.x;
    if (bid == (1 % G)) {
        float* cosT = (float*)(wsp() + WS_ROPE); float* sinT = cosT + 1024;
        for (int i = tid; i < 1024; i += 512) { const int pos = i >> 4, f = i & 15; const float inv = powf(10000.0f, -(float)f / 16.0f); const float ang = (float)pos * inv;
            cosT[i] = cosf(ang); sinT[i] = sinf(ang); }
    }
    LAS float* cond = (LAS float*)lds;
    LAS float* red = (LAS float*)(lds + 20480);
    for (int i = tid; i < 5 * 1024; i += 512) { const int g = i >> 10, k = i & 1023; const float v = g < 4 ? inp<1>()[g * 1024 + k] : inp<3>()[k]; cond[i] = v * sigmoidf_(v); }
    __syncthreads();
    float* mod = (float*)(wsp() + WS_MOD);
    for (int it = bid; it < DEPTH * 96; it += G) {
        const int l = it / 96, cb = it % 96, c = tid & 63, kg = tid >> 6, col = cb * 64 + c;
        const float* w = inp<4>() + (size_t)l * D * 6144 + col;
        float acc[5] = {0.f, 0.f, 0.f, 0.f, 0.f};
#pragma unroll 8
        for (int k = kg * 128; k < kg * 128 + 128; ++k) { const float wv = w[(size_t)k * 6144];
#pragma unroll
            for (int g = 0; g < 5; ++g) acc[g] += cond[g * 1024 + k] * wv; }
#pragma unroll
        for (int g = 0; g < 5; ++g) red[(kg * 5 + g) * 64 + c] = acc[g];
        __syncthreads();
        if (tid < 320) { const int g = tid >> 6; float s = inp<5>()[l * 6144 + col];
#pragma unroll
            for (int k2 = 0; k2 < 8; ++k2) s += red[(k2 * 5 + g) * 64 + c];
            mod[(size_t)(l * 5 + g) * 6144 + col] = s; }
        __syncthreads();
    }
}

DI void transpose_item(const float* W, int K, int N, bf16_t* WT, LAS float* scr, int item, int lane) {
    const int nblk = N / 32, kb = item / nblk, nb = item % nblk, k0 = 64 * kb, n0 = 32 * nb;
#pragma unroll 8
    for (int i = 0; i < 32; ++i) { const int kk = 2 * i + (lane >> 5); scr[kk * 33 + (lane & 31)] = W[(size_t)(k0 + kk) * N + n0 + (lane & 31)]; }
    asm volatile("s_waitcnt lgkmcnt(0)" ::: "memory");
    const int c = lane & 7;
#pragma unroll
    for (int j = 0; j < 4; ++j) { const int n = (lane >> 3) + 8 * j; const LAS float* s = scr + (8 * c) * 33 + n;
        u32x4 o; o.x = pk2(s[0 * 33], s[1 * 33]); o.y = pk2(s[2 * 33], s[3 * 33]); o.z = pk2(s[4 * 33], s[5 * 33]); o.w = pk2(s[6 * 33], s[7 * 33]);
        *(u32x4*)(WT + (size_t)(n0 + n) * K + k0 + 8 * c) = o; }
    asm volatile("s_waitcnt lgkmcnt(0)" ::: "memory");
}


DI void transpose_tile(const float* W, int K, int N, bf16_t* WT, LAS float* scr, int item, int tid) {
    const int nblk = N / 256, kb = item / nblk, nb = item % nblk, k0 = 64 * kb, n0 = 256 * nb;
#pragma unroll
    for (int it = 0; it < 8; ++it) { const int idx = it * 512 + tid, kk = idx >> 6, c4 = idx & 63;
        const f32x4 v = *(const f32x4*)(W + (size_t)(k0 + kk) * N + n0 + c4 * 4);
        LAS float* d = scr + kk * 257 + c4 * 4; d[0] = v.x; d[1] = v.y; d[2] = v.z; d[3] = v.w; }
    __syncthreads();
#pragma unroll
    for (int it = 0; it < 4; ++it) { const int idx = it * 512 + tid, n = idx >> 3, c = idx & 7; const LAS float* sp = scr + (8 * c) * 257 + n;
        u32x4 o; o.x = pk2(sp[0], sp[257]); o.y = pk2(sp[2 * 257], sp[3 * 257]); o.z = pk2(sp[4 * 257], sp[5 * 257]); o.w = pk2(sp[6 * 257], sp[7 * 257]);
        *(u32x4*)(WT + (size_t)(n0 + n) * K + k0 + 8 * c) = o; }
    __syncthreads();
}

DI void convert_weights(int l, size_t wtoff, LAS unsigned char* lds, int rank, int nranks, int tid) {
    LAS float* scr = (LAS float*)lds;
    unsigned char* wb = wsp() + wtoff;
    constexpr int I_IN = 16 * (INW / 256), I_BR = 16 * 4, I_FF1 = 16 * (DFF / 256), I_FF2 = 64 * 4;
    constexpr int NIT = I_IN + 4 * I_BR + I_FF1 + I_FF2;
    for (int it = rank; it < NIT; it += nranks) {
        int r = it;
        if (r < I_IN) { transpose_tile(inp<7>() + (size_t)l * D * INW, D, INW, (bf16_t*)(wb + WS_WIN), scr, r, tid); continue; } r -= I_IN;
        if (r < 3 * I_BR) { const int sg = r / I_BR; transpose_tile(inp<22>() + ((size_t)l * 3 + sg) * D * D, D, D, (bf16_t*)(wb + WS_WBR) + (size_t)sg * D * D, scr, r % I_BR, tid); continue; } r -= 3 * I_BR;
        if (r < I_BR) { transpose_tile(inp<23>() + (size_t)l * D * D, D, D, (bf16_t*)(wb + WS_WOUT), scr, r, tid); continue; } r -= I_BR;
        if (r < I_FF1) { transpose_tile(inp<25>() + (size_t)l * D * DFF, D, DFF, (bf16_t*)(wb + WS_WFF1), scr, r, tid); continue; } r -= I_FF1;
        transpose_tile(inp<26>() + (size_t)l * DFF * D, DFF, D, (bf16_t*)(wb + WS_WFF2), scr, r, tid);
    }
}

DI void phase_norm(const Args& a, LAS unsigned char* lds, int l, int which) {
    const int tid = tidx(), lane = tid & 63, wave = tid >> 6, G = gridDim.x;
    const int gw = bidx() * 8 + wave, NGW = G * 8;
    if (which == 0 && l == 0) convert_weights(0, 0, lds, bidx(), G, tid);
    const bool from_in = (l == 0 && which == 0);
    const float* xc_src = from_in ? inp<2>() : (const float*)(wsp() + WS_XC);
    const float* xl_src = from_in ? inp<0>() : (const float*)outp();
    const float* gn = (which == 0 ? inp<6>() : inp<24>()) + l * D;
    const float* mod = (const float*)(wsp() + WS_MOD) + (size_t)l * 5 * 6144 + (which ? 3 * 1024 : 0);
    bf16_t* H = (bf16_t*)(wsp() + WS_H);
    const int rstart = (which == 1 && l == DEPTH - 1) ? TC : 0;
    const int npart = which == 1 ? 12 : (l > 0 ? 4 : 0);
    const float* pgate = (const float*)(wsp() + WS_MOD) + (size_t)((which == 1 ? l : l - 1) * 5 + 4) * 6144 + (which == 1 ? 2 : 5) * 1024;
    f32x4 vnx[4];
    {   const int r0 = rstart + gw;
        if (r0 < T) { const float* xr0 = r0 < TC ? xc_src + (size_t)r0 * D : xl_src + (size_t)(r0 - TC) * D;
#pragma unroll
            for (int j = 0; j < 4; ++j) vnx[j] = *((const f32x4*)xr0 + lane + 64 * j); } }
    for (int r = rstart + gw; r < T; r += NGW) {
        const int grp = r < TC ? 4 : ((r - TC) >> 12);
        const float* sh = mod + grp * 6144; const float* sc = sh + 1024;
        f32x4 v[4]; float ss = 0.f;
#pragma unroll
        for (int j = 0; j < 4; ++j) v[j] = vnx[j];
        {   const int rn = r + NGW;
            if (rn < T) { const float* xrn = rn < TC ? xc_src + (size_t)rn * D : xl_src + (size_t)(rn - TC) * D;
#pragma unroll
                for (int j = 0; j < 4; ++j) vnx[j] = *((const f32x4*)xrn + lane + 64 * j); } }
        if (r < TC && npart > 0) {
            const float* px = (const float*)(wsp() + WS_PX) + (size_t)r * D;
#pragma unroll
            for (int j = 0; j < 4; ++j) { f32x4 sum = *((const f32x4*)px + lane + 64 * j);
                for (int pi = 1; pi < npart; ++pi) sum += *((const f32x4*)(px + (size_t)pi * TC * D) + lane + 64 * j);
                v[j] += *((const f32x4*)pgate + lane + 64 * j) * sum;
                *((f32x4*)(wsp() + WS_XC + (size_t)r * D * 4) + lane + 64 * j) = v[j]; }
        }
#pragma unroll
        for (int j = 0; j < 4; ++j) ss += (v[j].x * v[j].x + v[j].y * v[j].y) + (v[j].z * v[j].z + v[j].w * v[j].w);
        const float rstd = 1.0f / sqrtf(wave_sum(ss) * (1.0f / D) + EPS);
        if (from_in && r < TC) {
#pragma unroll
            for (int j = 0; j < 4; ++j) *((f32x4*)(wsp() + WS_XC + (size_t)r * D * 4) + lane + 64 * j) = v[j]; }
#pragma unroll
        for (int j = 0; j < 4; ++j) { const int k = (lane + 64 * j) * 4; const f32x4 g = *(const f32x4*)(gn + k), s1 = *(const f32x4*)(sc + k), s0 = *(const f32x4*)(sh + k);
            const f32x4 y = (v[j] * rstd * g) * (s1 + 1.0f) + s0;
            u32x2 o; o.x = pk2(y.x, y.y); o.y = pk2(y.z, y.w);
            *(u32x2*)(H + (size_t)r * D + k) = o; }
    }
}

DI float neg_expm1(float x) {
    const float small = -x * (1.0f + x * (0.5f + x * (0.16666667f + x * 0.041666667f)));
    const float big = 1.0f - fexp2(x * LOG2E);
    return x > -0.1f ? small : big;
}
DI void scan_item(const Args& a, LAS unsigned char* lds, int l, int b, int cb, int hc) {
    const int tid = tidx(), half = tid >> 8, ht = tid & 255, lane = tid & 63, hw = (tid >> 6) & 3, l15 = lane & 15, l4 = lane >> 4;
    LAS unsigned char* hb = lds + half * 63488;
    LAS bf16_t* WaT = (LAS bf16_t*)hb;
    LAS bf16_t* WxT = (LAS bf16_t*)(hb + 4608);
    LAS bf16_t* xcb = (LAS bf16_t*)(hb + 9216);
    LAS float* As = (LAS float*)(hb + 27648);
    LAS float* Us = (LAS float*)(hb + 44032);
    LAS float* carry = (LAS float*)(hb + 60416);
    LAS float* segP = (LAS float*)(hb + 60672);
    LAS float* segH = (LAS float*)(hb + 61696);
    LAS float* prm = (LAS float*)(hb + 62720);
    const bf16_t* ZA = (const bf16_t*)(wsp() + WS_ZA); bf16_t* YA = (bf16_t*)(wsp() + WS_H);
    const int tokA = ht >> 2, c0A = (ht & 3) * 16;
    f32x2 cw2[4][8], cb2[8];
    {
        const size_t wofs = (((size_t)l * 2 + half) * 16 + cb) * 4096;
        const float* wa = inp<10>() + wofs; const float* wx = inp<12>() + wofs;
        for (int i = ht; i < 2048; i += 256) { const int ii = i >> 5, jj = i & 31; WaT[jj * 72 + ii] = f2bf(wa[ii * 64 + hc * 32 + jj]); WxT[jj * 72 + ii] = f2bf(wx[ii * 64 + hc * 32 + jj]); }
        if (ht < 32) { const int ch = cb * 64 + hc * 32 + ht; const size_t po = ((size_t)l * 2 + half) * D + ch;
            prm[ht] = inp<11>()[po]; prm[32 + ht] = inp<13>()[po];
            const float lam = inp<14>()[po]; prm[64 + ht] = 8.0f * log1pf(expf(-lam));
            carry[ht] = 0.f; }
        const float* cwp = inp<8>() + (size_t)l * 4 * D + cb * 64 + c0A; const float* cbp = inp<9>() + (size_t)l * D + cb * 64 + c0A;
#pragma unroll
        for (int j = 0; j < 8; ++j) { cb2[j] = (f32x2){cbp[2 * j], cbp[2 * j + 1]};
#pragma unroll
            for (int k = 0; k < 4; ++k) cw2[k][j] = (f32x2){cwp[(size_t)k * D + 2 * j], cwp[(size_t)k * D + 2 * j + 1]}; }
    }
    __syncthreads();
#define LBAR() do { asm volatile("s_waitcnt lgkmcnt(0)" ::: "memory"); __builtin_amdgcn_s_barrier(); asm volatile("" ::: "memory"); } while (0)
#define SCAN_GID(st_) ((half == 0) ? (st_) : ((st_) < 2 ? 1 - (st_) : 35 - (st_)))
#define SCAN_LOAD(st_) do { const int gid_ = SCAN_GID(st_); const bool ic_ = gid_ < 2; const int ck_ = ic_ ? gid_ : gid_ - 2; const int L_ = ic_ ? CTX : SEQ; const int rb_ = ic_ ? b * CTX : TC + b * SEQ; \
        _Pragma("unroll") for (int t2 = 0; t2 < 2; ++t2) _Pragma("unroll") for (int k = 0; k < 4; ++k) { const int ts = ck_ * 128 + tokA + 64 * t2 + k - 2; tp[t2][k][0] = (u32x4){0u, 0u, 0u, 0u}; tp[t2][k][1] = (u32x4){0u, 0u, 0u, 0u}; \
            if (ts >= 0 && ts < L_) { const bf16_t* p = ZA + (size_t)(rb_ + ts) * D + cb * 64 + c0A; tp[t2][k][0] = *(const u32x4*)p; tp[t2][k][1] = *(const u32x4*)(p + 8); } } } while (0)
    u32x4 tp[2][4][2];
    SCAN_LOAD(0);
    const int tokE = ht >> 1, c0E = (ht & 1) * 16;
    for (int step = 0; step < 34; ++step) {
        const int gid = SCAN_GID(step); const bool isctx = gid < 2; const int chunk = isctx ? gid : gid - 2; const int rowbase = isctx ? b * CTX : TC + b * SEQ;
        const bool fwd_first = isctx ? (gid == 0) : (gid <= 17);
        const bool second = (half == 0) ? !fwd_first : fwd_first;
#pragma unroll
        for (int t2 = 0; t2 < 2; ++t2) {
            f32x2 ac[8];
#pragma unroll
            for (int j = 0; j < 8; ++j) ac[j] = cb2[j];
#pragma unroll
            for (int k = 0; k < 4; ++k) { const u32x4 w0 = tp[t2][k][0], w1 = tp[t2][k][1];
                const unsigned ww[8] = {w0.x, w0.y, w0.z, w0.w, w1.x, w1.y, w1.z, w1.w};
#pragma unroll
                for (int j = 0; j < 8; ++j) { const f32x2 xv = {bflo(ww[j]), bfhi(ww[j])}; ac[j] = cw2[k][j] * xv + ac[j]; } }
            u32x4 o0, o1; o0.x = pk2(ac[0].x, ac[0].y); o0.y = pk2(ac[1].x, ac[1].y); o0.z = pk2(ac[2].x, ac[2].y); o0.w = pk2(ac[3].x, ac[3].y);
            o1.x = pk2(ac[4].x, ac[4].y); o1.y = pk2(ac[5].x, ac[5].y); o1.z = pk2(ac[6].x, ac[6].y); o1.w = pk2(ac[7].x, ac[7].y);
            *(LAS u32x4*)(xcb + (tokA + 64 * t2) * 72 + c0A) = o0; *(LAS u32x4*)(xcb + (tokA + 64 * t2) * 72 + c0A + 8) = o1;
        }
        LBAR();
#pragma unroll
        for (int mt = 0; mt < 2; ++mt) {
            f32x4 ar[2], ai[2];
#pragma unroll
            for (int nt = 0; nt < 2; ++nt) { ar[nt] = (f32x4){0.f, 0.f, 0.f, 0.f}; ai[nt] = (f32x4){0.f, 0.f, 0.f, 0.f}; }
#pragma unroll
            for (int s = 0; s < 2; ++s) { const bf16x8 xa = *(const LAS bf16x8*)(xcb + (32 * hw + 16 * mt + l15) * 72 + 32 * s + 8 * l4);
#pragma unroll
                for (int nt = 0; nt < 2; ++nt) { const bf16x8 wa = *(const LAS bf16x8*)(WaT + (16 * nt + l15) * 72 + 32 * s + 8 * l4), wx = *(const LAS bf16x8*)(WxT + (16 * nt + l15) * 72 + 32 * s + 8 * l4);
                    ar[nt] = __builtin_amdgcn_mfma_f32_16x16x32_bf16(xa, wa, ar[nt], 0, 0, 0); ai[nt] = __builtin_amdgcn_mfma_f32_16x16x32_bf16(xa, wx, ai[nt], 0, 0, 0); } }
#pragma unroll
            for (int nt = 0; nt < 2; ++nt) { const int j = 16 * nt + l15; const float ba = prm[j], bx = prm[32 + j], sp8 = prm[64 + j];
#pragma unroll
                for (int i = 0; i < 4; i += 2) { const int tok = 32 * hw + 16 * mt + 4 * l4 + i;
                    const f32x2 zr = ((f32x2){ar[nt][i], ar[nt][i + 1]} + ba) * (-LOG2E), zi = ((f32x2){ai[nt][i], ai[nt][i + 1]} + bx) * (-LOG2E);
                    const f32x2 dr = (f32x2){fexp2(zr.x), fexp2(zr.y)} + 1.0f, di = (f32x2){fexp2(zi.x), fexp2(zi.y)} + 1.0f;
                    const f32x2 r = {frcp(dr.x), frcp(dr.y)}, ig = {frcp(di.x), frcp(di.y)};
                    const f32x2 la = r * (-sp8), le = la * LOG2E;
                    const f32x2 av = {fexp2(le.x), fexp2(le.y)};
                    const f32x2 x2 = la * 2.0f;
                    const f32x2 sm = -x2 * (x2 * (x2 * (x2 * 0.041666667f + 0.16666667f) + 0.5f) + 1.0f), bg = 1.0f - av * av;
                    const f32x2 m2 = {x2.x > -0.1f ? sm.x : bg.x, x2.y > -0.1f ? sm.y : bg.y};
                    const f32x2 mult = {__builtin_amdgcn_sqrtf(fmaxf(m2.x, 0.f)), __builtin_amdgcn_sqrtf(fmaxf(m2.y, 0.f))};
                    const f32x2 xv = {bf1(xcb[tok * 72 + hc * 32 + j]), bf1(xcb[(tok + 1) * 72 + hc * 32 + j])};
                    const f32x2 uv = xv * ig * mult;
                    As[tok * 32 + j] = av.x; As[(tok + 1) * 32 + j] = av.y; Us[tok * 32 + j] = uv.x; Us[(tok + 1) * 32 + j] = uv.y; } }
        }
        asm volatile("s_waitcnt vmcnt(0)" ::: "memory");
        LBAR();
        bf16_t* outp_ = YA + (size_t)(rowbase + chunk * 128 + tokE) * D + cb * 64 + hc * 32 + c0E;
        unsigned long long q0 = 0, q1 = 0, q2 = 0, q3 = 0;
        if (second) { const unsigned long long* pq = (const unsigned long long*)outp_;
            q0 = __hip_atomic_load(pq, __ATOMIC_RELAXED, __HIP_MEMORY_SCOPE_AGENT); q1 = __hip_atomic_load(pq + 1, __ATOMIC_RELAXED, __HIP_MEMORY_SCOPE_AGENT);
            q2 = __hip_atomic_load(pq + 2, __ATOMIC_RELAXED, __HIP_MEMORY_SCOPE_AGENT); q3 = __hip_atomic_load(pq + 3, __ATOMIC_RELAXED, __HIP_MEMORY_SCOPE_AGENT); }
        if (step + 1 < 34) SCAN_LOAD(step + 1);
        const int c = ht & 31, seg = ht >> 5;
        {
            float h = 0.f, P = 1.f;
#pragma unroll 8
            for (int p = seg * 16; p < seg * 16 + 16; ++p) { const int tok = half ? 127 - p : p; const float av = As[tok * 32 + c], uv = Us[tok * 32 + c];
                h = av * h + uv; P *= av; }
            segH[seg * 32 + c] = h; segP[seg * 32 + c] = P;
        }
        LBAR();
        {
            float cin = carry[(step & 1) * 32 + c];
            float sp_[7], sh_[7];
#pragma unroll
            for (int s2 = 0; s2 < 7; ++s2) { sp_[s2] = segP[s2 * 32 + c]; sh_[s2] = segH[s2 * 32 + c]; }
#pragma unroll
            for (int s2 = 0; s2 < 7; ++s2) cin = s2 < seg ? sp_[s2] * cin + sh_[s2] : cin;
            float hl = cin;
#pragma unroll 8
            for (int p = seg * 16; p < seg * 16 + 16; ++p) { const int tok = half ? 127 - p : p; hl = As[tok * 32 + c] * hl + Us[tok * 32 + c]; Us[tok * 32 + c] = hl; }
            if (seg == 7) carry[((step + 1) & 1) * 32 + c] = hl;
        }
        LBAR();
        {
            float o0[8], o1[8];
#pragma unroll
            for (int j = 0; j < 8; ++j) { o0[j] = Us[tokE * 32 + c0E + j]; o1[j] = Us[tokE * 32 + c0E + 8 + j]; }
            if (second) { float e0[8], e1[8]; u32x4 wA, wB; wA.x = (unsigned)q0; wA.y = (unsigned)(q0 >> 32); wA.z = (unsigned)q1; wA.w = (unsigned)(q1 >> 32); wB.x = (unsigned)q2; wB.y = (unsigned)(q2 >> 32); wB.z = (unsigned)q3; wB.w = (unsigned)(q3 >> 32);
                unpack8(wA, e0); unpack8(wB, e1);
#pragma unroll
                for (int j = 0; j < 8; ++j) { o0[j] += e0[j]; o1[j] += e1[j]; } }
            *(u32x4*)outp_ = pack8(o0); *(u32x4*)(outp_ + 8) = pack8(o1);
        }
    }
    asm volatile("s_waitcnt vmcnt(0)" ::: "memory");
#undef SCAN_GID
#undef SCAN_LOAD
}

DI void sgu_item(const Args& a, LAS unsigned char* lds, int l, int tc) {
    const int tid = tidx(), lane = tid & 63, w = tid >> 6, hh = lane >> 5, r32 = lane & 31;
    const int row0 = tc < 8 ? (tc >> 1) * CTX + (tc & 1) * 128 : TC + ((tc - 8) >> 5) * SEQ + ((tc - 8) & 31) * 128;
    LAS bf16_t* Wl = (LAS bf16_t*)lds;
    LAS bf16_t* Vn = (LAS bf16_t*)(lds + 34816);
    LAS float* st = (LAS float*)(lds + 75776);
    const bf16_t* ZV = (const bf16_t*)(wsp() + WS_ZV); bf16_t* ZU = (bf16_t*)(wsp() + WS_ZU);
    for (int t = w * 16; t < w * 16 + 16; ++t) {
        const bf16_t* p = ZV + (size_t)(row0 + t) * D + lane * 16;
        float x0[8], x1[8]; unpack8(*(const u32x4*)p, x0); unpack8(*(const u32x4*)(p + 8), x1);
        float s = 0.f;
#pragma unroll
        for (int j = 0; j < 8; ++j) s += x0[j] + x1[j];
        const float mean = wave_sum(s) * (1.0f / D); float q = 0.f;
#pragma unroll
        for (int j = 0; j < 8; ++j) { const float d0 = x0[j] - mean, d1 = x1[j] - mean; q += d0 * d0 + d1 * d1; }
        const float var = wave_sum(q) * (1.0f / D);
        if (lane == 0) { st[t * 2] = mean; st[t * 2 + 1] = 1.0f / sqrtf(var + EPS); }
    }
    __syncthreads();
    const int tokS = tid >> 2, cS = (tid & 3) * 32;
    const float meanS = st[tokS * 2], rstdS = st[tokS * 2 + 1];
    f32x4 wreg[8]; u32x4 vreg[4], ureg[4];
#define SGU_LOAD(g_) do { const float* ws_ = inp<17>() + ((size_t)l * 8 + (g_)) * 16384; \
        _Pragma("unroll") for (int it = 0; it < 8; ++it) wreg[it] = *(const f32x4*)(ws_ + (it * 512 + tid) * 4); \
        const bf16_t* vp_ = ZV + (size_t)(row0 + tokS) * D + (g_) * 128 + cS; const bf16_t* up_ = ZU + (size_t)(row0 + tokS) * D + (g_) * 128 + cS; \
        _Pragma("unroll") for (int q4 = 0; q4 < 4; ++q4) { vreg[q4] = *(const u32x4*)(vp_ + q4 * 8); ureg[q4] = *(const u32x4*)(up_ + q4 * 8); } } while (0)
    SGU_LOAD(0);
    for (int g = 0; g < 8; ++g) {
        u32x4 ucur[4];
        {
#pragma unroll
            for (int it = 0; it < 8; ++it) { const int idx = (it * 512 + tid) * 4; const f32x4 v = wreg[it]; const int p = idx >> 7, q = idx & 127;
                u32x2 o; o.x = pk2(v.x, v.y); o.y = pk2(v.z, v.w); *(LAS u32x2*)(Wl + p * 136 + q) = o; }
            const float* lg = inp<15>() + (size_t)l * D + g * 128 + cS; const float* lb = inp<16>() + (size_t)l * D + g * 128 + cS;
#pragma unroll
            for (int q4 = 0; q4 < 4; ++q4) { float x[8]; unpack8(vreg[q4], x);
                const f32x4 g0 = *(const f32x4*)(lg + q4 * 8), g1 = *(const f32x4*)(lg + q4 * 8 + 4), b0 = *(const f32x4*)(lb + q4 * 8), b1 = *(const f32x4*)(lb + q4 * 8 + 4);
#pragma unroll
                for (int j = 0; j < 8; ++j) { const float gg = j < 4 ? g0[j & 3] : g1[j & 3], bb = j < 4 ? b0[j & 3] : b1[j & 3]; x[j] = (x[j] - meanS) * rstdS * gg + bb; }
                *(LAS u32x4*)(Vn + tokS * 160 + cS + q4 * 8) = pack8(x); ucur[q4] = ureg[q4]; }
        }
        if (g + 1 < 8) SGU_LOAD(g + 1);
        LBAR();
        {
            const int pt = w >> 1, ch = w & 1;
            f32x16 acc[2];
#pragma unroll
            for (int i = 0; i < 16; ++i) { acc[0][i] = 0.f; acc[1][i] = 0.f; }
#pragma unroll
            for (int s = 0; s < 8; ++s) { const bf16x8 af = *(const LAS bf16x8*)(Wl + (32 * pt + r32) * 136 + 16 * s + 8 * hh);
#pragma unroll
                for (int nt = 0; nt < 2; ++nt) { const LAS bf16_t* bp = Vn + (16 * s + 8 * hh + ((lane & 15) >> 2)) * 160 + 64 * ch + 32 * nt + 16 * ((lane >> 4) & 1) + 4 * (lane & 3);
                    const bf16x8 bfr = tr_read2(bp, bp + 4 * 160); acc[nt] = MFMA32(af, bfr, acc[nt]); } }
            const float* sb = inp<18>() + ((size_t)l * 8 + g) * 128 + 32 * pt + 4 * hh;
            f32x4 sbv[4];
#pragma unroll
            for (int i4 = 0; i4 < 4; ++i4) sbv[i4] = *(const f32x4*)(sb + 8 * i4);
            LBAR();
            LAS bf16_t* Mx = Wl;
#pragma unroll
            for (int nt = 0; nt < 2; ++nt)
#pragma unroll
                for (int i = 0; i < 16; ++i) { const int pp = 32 * pt + (i & 3) + 8 * (i >> 2) + 4 * hh, c = 64 * ch + 32 * nt + r32;
                    Mx[pp * 136 + c] = f2bf(acc[nt][i] + sbv[i >> 2][i & 3]); }
            LBAR();
            bf16_t* up = ZU + (size_t)(row0 + tokS) * D + g * 128 + cS;
#pragma unroll
            for (int q4 = 0; q4 < 4; ++q4) { float uu[8], mm[8]; unpack8(ucur[q4], uu); unpack8(*(const LAS u32x4*)(Mx + tokS * 136 + cS + q4 * 8), mm);
#pragma unroll
                for (int j = 0; j < 8; ++j) uu[j] *= mm[j];
                *(u32x4*)(up + q4 * 8) = pack8(uu); }
        }
        LBAR();
    }
#undef SGU_LOAD
}

DI void attn_tile(const LAS bf16_t* Ks, const LAS bf16_t* Vt, int kb, const bf16x8 (&qf)[2][4], float (&m)[2], float (&ls)[2], f32x16 (&o)[2][2],
                  int r32, int hh, bool masked, int qloc0, int kv_lo, int kv_hi) {
    bf16x8 kf[4];
#pragma unroll
    for (int s = 0; s < 4; ++s) kf[s] = *(const LAS bf16x8*)(Ks + (kb + r32) * 72 + 16 * s + 8 * hh);
    bf16x8 pf[2][2];
#pragma unroll
    for (int qt = 0; qt < 2; ++qt) {
        f32x16 sc;
#pragma unroll
        for (int i = 0; i < 16; ++i) sc[i] = 0.f;
#pragma unroll
        for (int s = 0; s < 4; ++s) sc = MFMA32(kf[s], qf[qt][s], sc);
        if (masked) { const int ql = qloc0 + 32 * qt + r32;
#pragma unroll
            for (int i = 0; i < 16; ++i) { const int key = kb + (i & 3) + 8 * (i >> 2) + 4 * hh; const int df = key - 128 - ql;
                const bool ok = (df >= -128) && (df <= 128) && (key >= kv_lo) && (key < kv_hi); sc[i] = ok ? sc[i] : -1e30f; } }
        float mx = sc[0];
#pragma unroll
        for (int i = 1; i < 16; ++i) mx = fmaxf(mx, sc[i]);
        mx = fmaxf(mx, __shfl_xor(mx, 32));
        const float mn = fmaxf(m[qt], mx); const float alpha = fexp2(m[qt] - mn); m[qt] = mn;
        float p[16]; float rs = 0.f;
#pragma unroll
        for (int i = 0; i < 16; ++i) { p[i] = fexp2(sc[i] - mn); rs += p[i]; }
        ls[qt] = ls[qt] * alpha + rs;
        if (__any(alpha != 1.0f)) {
#pragma unroll
            for (int i = 0; i < 16; ++i) { o[qt][0][i] *= alpha; o[qt][1][i] *= alpha; } }
#pragma unroll
        for (int ks = 0; ks < 2; ++ks) { u32x4 w; w.x = pk2(p[8 * ks], p[8 * ks + 1]); w.y = pk2(p[8 * ks + 2], p[8 * ks + 3]); w.z = pk2(p[8 * ks + 4], p[8 * ks + 5]); w.w = pk2(p[8 * ks + 6], p[8 * ks + 7]);
            pf[qt][ks] = __builtin_bit_cast(bf16x8, w); }
    }
#pragma unroll
    for (int dt = 0; dt < 2; ++dt)
#pragma unroll
        for (int ks = 0; ks < 2; ++ks) { const LAS bf16_t* vp = Vt + (kb + 16 * ks + 4 * hh + ((r32 & 15) >> 2)) * 72 + 32 * dt + 16 * (r32 >> 4) + 4 * (r32 & 3);
            const bf16x8 vf = tr_read2(vp, vp + 8 * 72);
#pragma unroll
            for (int qt = 0; qt < 2; ++qt) o[qt][dt] = MFMA32(vf, pf[qt][ks], o[qt][dt]); }
}

template <bool ctxstage> DI void attn_stage(const Args& a, LAS bf16_t* Ks, LAS bf16_t* Vt, int l, int b, int n, int kvh) {
    const int tid = tidx(), e = tid & 7;
    const bf16_t* ZK = (const bf16_t*)(wsp() + WS_ZK); const bf16_t* ZVV = (const bf16_t*)(wsp() + WS_ZVV);
    const float* cosT = (const float*)(wsp() + WS_ROPE); const float* sinT = cosT + 1024;
    const float* kg = inp<20>() + l * 64 + e * 8;
    float kgv[8];
#pragma unroll
    for (int j = 0; j < 8; ++j) kgv[j] = kg[j];
    constexpr int NP = 2;
    for (int pg = 0; pg < (ctxstage ? 2 : 3); ++pg) {
    u32x4 kwa[NP], vwa[NP];
#pragma unroll
    for (int ps = 0; ps < NP; ++ps) {
        const int key = (pg * NP + ps) * 64 + (tid >> 3);
        int kt = 0, row; bool valid = true;
        if (ctxstage) row = b * CTX + key; else { kt = n * 128 - 128 + key; valid = (kt >= 0) && (kt < SEQ); kt = kt < 0 ? 0 : (kt >= SEQ ? SEQ - 1 : kt); row = TC + b * SEQ + kt; }
        kwa[ps] = (u32x4){0u, 0u, 0u, 0u}; vwa[ps] = (u32x4){0u, 0u, 0u, 0u};
        if (valid) { kwa[ps] = *(const u32x4*)(ZK + (size_t)row * 256 + kvh * 64 + e * 8); vwa[ps] = *(const u32x4*)(ZVV + (size_t)row * 256 + kvh * 64 + e * 8); }
    }
#pragma unroll
    for (int ps = 0; ps < NP; ++ps) {
        const int key = (pg * NP + ps) * 64 + (tid >> 3);
        int kt = 0;
        if (!ctxstage) { kt = n * 128 - 128 + key; kt = kt < 0 ? 0 : (kt >= SEQ ? SEQ - 1 : kt); }
        const u32x4 kw = kwa[ps], vw = vwa[ps];
        float x[8]; unpack8(kw, x);
        float ss = 0.f;
#pragma unroll
        for (int j = 0; j < 8; ++j) ss += x[j] * x[j];
        ss += __shfl_xor(ss, 1); ss += __shfl_xor(ss, 2); ss += __shfl_xor(ss, 4);
        const float rstd = 1.0f / sqrtf(ss * (1.0f / 64.0f) + EPS);
#pragma unroll
        for (int j = 0; j < 8; ++j) x[j] = x[j] * rstd * kgv[j];
        if (!ctxstage) {
            const int pos = (e >> 2) ? (kt & 63) : (kt >> 6); const bool second = (e >> 1) & 1; const int f0 = 8 * (e & 1);
#pragma unroll
            for (int j = 0; j < 8; ++j) { const float pr = __shfl_xor(x[j], 2); const float cs = cosT[pos * 16 + f0 + j], sn = sinT[pos * 16 + f0 + j];
                x[j] = second ? (x[j] * cs + pr * sn) : (x[j] * cs - pr * sn); }
        }
        *(LAS u32x4*)(Ks + key * 72 + e * 8) = pack8(x);
        *(LAS u32x4*)(Vt + key * 72 + e * 8) = vw;
    }
    }
}

DI void attn_item(const Args& a, LAS unsigned char* lds, int l, int kind, int b, int n, int kvh) {
    const int tid = tidx(), lane = tid & 63, w = tid >> 6, hh = lane >> 5, r32 = lane & 31;
    const int g = w >> 1, qhalf = w & 1, h = kvh * 4 + g, qloc0 = qhalf * 64;
    LAS bf16_t* Ks = (LAS bf16_t*)lds;
    LAS bf16_t* Vt = (LAS bf16_t*)(lds + 55296);
    bf16_t* ZQ = (bf16_t*)(wsp() + WS_ZQ);
    const float* cosT = (const float*)(wsp() + WS_ROPE); const float* sinT = cosT + 1024;
    const float* qg = inp<19>() + l * 64;
    const float SCL = 0.125f * LOG2E;
    bf16x8 qf[2][4];
#pragma unroll
    for (int qt = 0; qt < 2; ++qt) {
        const int qtok = n * 128 + qloc0 + 32 * qt + r32; const int row = kind ? b * CTX + qtok : TC + b * SEQ + qtok;
        const bf16_t* qp = ZQ + (size_t)row * D + h * 64 + 8 * hh;
        float v[4][8]; float ss = 0.f;
#pragma unroll
        for (int s = 0; s < 4; ++s) { unpack8(*(const u32x4*)(qp + 16 * s), v[s]);
#pragma unroll
            for (int j = 0; j < 8; ++j) ss += v[s][j] * v[s][j]; }
        ss += __shfl_xor(ss, 32);
        const float rstd = 1.0f / sqrtf(ss * (1.0f / 64.0f) + EPS);
#pragma unroll
        for (int s = 0; s < 4; ++s)
#pragma unroll
            for (int j = 0; j < 8; ++j) v[s][j] = v[s][j] * rstd * qg[16 * s + 8 * hh + j];
        if (!kind) { const int prow = qtok >> 6, pcol = qtok & 63;
#pragma unroll
            for (int j = 0; j < 8; ++j) { const int f = 8 * hh + j;
                const float c0 = cosT[prow * 16 + f], s0 = sinT[prow * 16 + f], c1 = cosT[pcol * 16 + f], s1 = sinT[pcol * 16 + f];
                const float t1 = v[0][j], t2 = v[1][j]; v[0][j] = t1 * c0 - t2 * s0; v[1][j] = t2 * c0 + t1 * s0;
                const float t3 = v[2][j], t4 = v[3][j]; v[2][j] = t3 * c1 - t4 * s1; v[3][j] = t4 * c1 + t3 * s1; } }
#pragma unroll
        for (int s = 0; s < 4; ++s) {
#pragma unroll
            for (int j = 0; j < 8; ++j) v[s][j] *= SCL;
            qf[qt][s] = __builtin_bit_cast(bf16x8, pack8(v[s])); }
    }
    const float sk = inp<21>()[l * 16 + h] * LOG2E;
    float m[2] = {sk, sk}; float ls[2]; ls[0] = ls[1] = (hh == 0) ? 1.0f : 0.0f;
    f32x16 o[2][2];
#pragma unroll
    for (int i = 0; i < 16; ++i) { o[0][0][i] = 0.f; o[0][1][i] = 0.f; o[1][0][i] = 0.f; o[1][1][i] = 0.f; }
    if (!kind) {
        attn_stage<false>(a, Ks, Vt, l, b, n, kvh);
        __syncthreads();
        const int kv_lo = 128 - n * 128 > 0 ? 128 - n * 128 : 0; const int kv_hi = (SEQ - n * 128 + 128) < 384 ? (SEQ - n * 128 + 128) : 384;
        int t_lo = qhalf ? 2 : 0, t_hi = qhalf ? 12 : 10;
        if (t_lo < (kv_lo >> 5)) t_lo = kv_lo >> 5;
        if (t_hi > (kv_hi >> 5)) t_hi = kv_hi >> 5;
        for (int t = t_lo; t < t_hi; ++t) { const int kb = 32 * t; const bool interior = (kb >= qloc0 + 63) && (kb <= qloc0 + 225) && (kb >= kv_lo) && (kb + 32 <= kv_hi);
            attn_tile(Ks, Vt, kb, qf, m, ls, o, r32, hh, !interior, qloc0, kv_lo, kv_hi); }
        __syncthreads();
    }
    attn_stage<true>(a, Ks, Vt, l, b, n, kvh);
    __syncthreads();
    for (int t = 0; t < 8; ++t) attn_tile(Ks, Vt, 32 * t, qf, m, ls, o, r32, hh, false, qloc0, 0, 256);
#pragma unroll
    for (int qt = 0; qt < 2; ++qt) {
        const float lt = ls[qt] + __shfl_xor(ls[qt], 32); const float inv = 1.0f / lt;
        const int qtok = n * 128 + qloc0 + 32 * qt + r32; const int row = kind ? b * CTX + qtok : TC + b * SEQ + qtok;
        bf16_t* op = ZQ + (size_t)row * D + h * 64 + 4 * hh;
#pragma unroll
        for (int dt = 0; dt < 2; ++dt)
#pragma unroll
            for (int q4 = 0; q4 < 4; ++q4) { u32x2 wv; wv.x = pk2(o[qt][dt][4 * q4] * inv, o[qt][dt][4 * q4 + 1] * inv); wv.y = pk2(o[qt][dt][4 * q4 + 2] * inv, o[qt][dt][4 * q4 + 3] * inv);
                *(u32x2*)(op + 32 * dt + 8 * q4) = wv; }
    }
}

DI void phase_mix(const Args& a, LAS unsigned char* lds, int l) {
    const int tid = tidx();
    const bool last = (l == DEPTH - 1);
    unsigned* ctr = (unsigned*)(wsp() + WS_CTL) + l;
    LAS int* slot = (LAS int*)(lds + LDS_MISC);
    const int n_scan = 128, n_attl = 512, n_attc = last ? 0 : 32, n_sgu = last ? 128 : 136;
    const int total = n_scan + n_attl + n_attc + n_sgu;
    for (;;) {
        __syncthreads();
        if (tid == 0) *slot = (int)atomicAdd(ctr, 1u);
        __syncthreads();
        int it = *slot;
        if (it >= total) break;
#ifndef NO_SCAN
#ifdef PROBE_K
        const unsigned long long pt0 = __builtin_amdgcn_s_memrealtime();
#define PT_END(k, mx) do { if (tid == 0) { const unsigned dt = (unsigned)(__builtin_amdgcn_s_memrealtime() - pt0); if (mx) atomicMax((unsigned*)(wsp() + WS_CTL) + 128 + (k), dt); else atomicAdd((unsigned*)(wsp() + WS_CTL) + 128 + (k), dt); } } while (0)
#else
#define PT_END(k, mx) do {} while (0)
#endif
        if (it < n_scan) { scan_item(a, lds, l, it >> 5, (it >> 1) & 15, it & 1); PT_END(0, 1); continue; }
#endif
        it -= n_scan;
#ifndef NO_ATT
        if (it < n_attl) { attn_item(a, lds, l, 0, it >> 7, (it >> 2) & 31, it & 3); PT_END(1, 0); continue; }
#endif
        it -= n_attl;
#ifndef NO_ATT
        if (it < n_attc) { attn_item(a, lds, l, 1, it >> 3, (it >> 2) & 1, it & 3); PT_END(3, 0); continue; }
#endif
        it -= n_attc;
#ifndef NO_SGU
        sgu_item(a, lds, l, last ? it + 8 : it);
#endif
        PT_END(2, 0);
    }
}


#define XB_TMO      128
#define XB_XCNT(j)  (256  + 64 * (j))
#define XB_XSUB(j)  (1280 + 64 * (j))
#define XB_XGEN(j)  (2304 + 64 * (j))
#define XB_TOP      3328
#define XB_TOPGEN   3392
#define XCD_BAR_WORDS 3456
#define XB_SPIN_CAP (1u << 18)

__device__ __forceinline__ unsigned xb_ld(unsigned* p)              { return __hip_atomic_load(p, __ATOMIC_RELAXED, __HIP_MEMORY_SCOPE_AGENT); }
__device__ __forceinline__ unsigned xb_add(unsigned* p, unsigned v) { return __hip_atomic_fetch_add(p, v, __ATOMIC_RELAXED, __HIP_MEMORY_SCOPE_AGENT); }
__device__ __forceinline__ unsigned xb_xcc_id() { return (unsigned)__builtin_amdgcn_s_getreg((3 << 11) | 20) & 0xFu; }
#define XB_SPIN(cond, bar) do { unsigned _sp = 0; while (cond) { __builtin_amdgcn_s_sleep(1); \
    if ((++_sp & 255u) == 0u) { if (xb_ld(&(bar)[XB_TMO])) break; if (_sp > XB_SPIN_CAP) { atomicAdd(&(bar)[XB_TMO], 1u); break; } } } } while (0)

struct XcdBarrier {
    unsigned* bar; unsigned x;
    volatile LAS unsigned* st;
};

__device__ __forceinline__ XcdBarrier xcd_barrier_post(unsigned* bar, volatile LAS unsigned* st) {
    XcdBarrier b; b.bar = bar; b.x = xb_xcc_id(); b.st = st;
    if (threadIdx.x == 0) (void)xb_add(&bar[XB_XCNT(b.x)], 1u);
    return b;
}
__device__ __forceinline__ void xcd_barrier_complete(unsigned* bar, unsigned x, unsigned& nloc, unsigned& nx) {
    const unsigned G = gridDim.x * gridDim.y * gridDim.z;
    unsigned sum, cnt, mine, sp = 0u;
    for (;;) {
        sum = 0u; cnt = 0u; mine = 0u;
#pragma unroll
        for (unsigned j = 0; j < 16; ++j) { const unsigned c = xb_ld(&bar[XB_XCNT(j)]); sum += c; cnt += (c > 0u) ? 1u : 0u; mine = (j == x) ? c : mine; }
        if (sum == G) break;
        __builtin_amdgcn_s_sleep(1);
        if ((++sp & 255u) == 0u) { if (xb_ld(&bar[XB_TMO])) break; if (sp > XB_SPIN_CAP) { atomicAdd(&bar[XB_TMO], 1u); break; } }
    }
    nloc = mine > 0u ? mine : 1u; nx = cnt > 0u ? cnt : 1u;
}

__device__ __forceinline__ void xcd_barrier(const XcdBarrier& b) {
    asm volatile("s_waitcnt vmcnt(0)" ::: "memory");
    __syncthreads();
    if (threadIdx.x == 0) {
        unsigned* bar = b.bar;
        __builtin_amdgcn_s_waitcnt(0);
        unsigned nloc = b.st[0], nx = b.st[1];
        if (nloc == 0u) { xcd_barrier_complete(bar, b.x, nloc, nx); b.st[0] = nloc; b.st[1] = nx; }
        const unsigned old = xb_add(&bar[XB_XSUB(b.x)], 1u);
        const unsigned gen = old / nloc;
        if (old + 1u == (gen + 1u) * nloc) {
            __builtin_amdgcn_fence(__ATOMIC_RELEASE, "agent");
            asm volatile("s_waitcnt vmcnt(0)" ::: "memory");
            const unsigned og = xb_add(&bar[XB_TOP], 1u);
            const unsigned tg = og / nx;
            if (og + 1u == (tg + 1u) * nx) xb_add(&bar[XB_TOPGEN], 1u);
            else XB_SPIN(xb_ld(&bar[XB_TOPGEN]) == tg, bar);
            __builtin_amdgcn_fence(__ATOMIC_ACQUIRE, "agent");
            xb_add(&bar[XB_XGEN(b.x)], 1u);
            asm volatile("s_waitcnt vmcnt(0)" ::: "memory");
        } else {
            XB_SPIN(xb_ld(&bar[XB_XGEN(b.x)]) == gen, bar);
            __builtin_amdgcn_fence(__ATOMIC_ACQUIRE, "agent");
            asm volatile("s_waitcnt vmcnt(0)" ::: "memory");
        }
    }
    __syncthreads();
}


DI void grid_barrier(unsigned* bar, unsigned target) {
    asm volatile("s_waitcnt vmcnt(0) lgkmcnt(0)" ::: "memory");
    __syncthreads();
    if (threadIdx.x == 0) {
        __builtin_amdgcn_fence(__ATOMIC_RELEASE, "agent");
        __hip_atomic_fetch_add(bar, 1u, __ATOMIC_RELAXED, __HIP_MEMORY_SCOPE_AGENT);
        while (__hip_atomic_load(bar, __ATOMIC_RELAXED, __HIP_MEMORY_SCOPE_AGENT) < target) __builtin_amdgcn_s_sleep(2);
        __builtin_amdgcn_fence(__ATOMIC_ACQUIRE, "agent");
    }
    __syncthreads();
}


#ifdef DBG_STOP
DI void dbg_dump(int which) {
    unsigned char* ws = wsp(); float* out = outp();
    const size_t n = (size_t)TL * D, stride = (size_t)gridDim.x * 512;
    const bf16_t* H = (const bf16_t*)(ws + WS_H); const bf16_t* MG = (const bf16_t*)(ws + WS_MG);
    const bf16_t* ZA = (const bf16_t*)(ws + WS_ZA); const bf16_t* ZU = (const bf16_t*)(ws + WS_ZU); const bf16_t* ZV = (const bf16_t*)(ws + WS_ZV); const bf16_t* ZQ = (const bf16_t*)(ws + WS_ZQ);
    const bf16_t* ZK = (const bf16_t*)(ws + WS_ZK); const bf16_t* ZVV = (const bf16_t*)(ws + WS_ZVV); const bf16_t* ZG = (const bf16_t*)(ws + WS_ZG);
    for (size_t i = (size_t)blockIdx.x * 512 + threadIdx.x; i < n; i += stride) {
        float v = 0.f;
        if (which == 1) v = bf1(H[i]) + bf1(H[i + (size_t)TC * D]);
        if (which == 2) v = bf1(ZA[i]) + bf1(ZU[i]) + bf1(ZV[i]) + bf1(ZQ[i]) + bf1(ZG[i]) + bf1(ZG[i + n]) + bf1(ZG[i + 2 * n]) + bf1(ZK[i % ((size_t)T * 256)]) + bf1(ZVV[i % ((size_t)T * 256)]) + bf1(ZA[i + (size_t)TC * D]);
        if (which == 3) v = bf1(H[i + (size_t)TC * D]);
        if (which == 4) v = bf1(ZU[i + (size_t)TC * D]);
        if (which == 5) v = bf1(ZQ[i + (size_t)TC * D]);
        if (which == 6) v = bf1(MG[i + (size_t)TC * D]);
        if (which == 7) v = bf1(H[i]) + bf1(ZU[i]) + bf1(ZQ[i]);
        out[i] = v;
    }
}
#endif

__global__ void __launch_bounds__(512, 2) fwd_megakernel(Args a) {
    extern __shared__ __attribute__((aligned(16))) unsigned char shm[];
    LAS unsigned char* lds = (LAS unsigned char*)shm;
    {   volatile LAS unsigned* stz = (volatile LAS unsigned*)(lds + LDS_MISC + 16);
        if (threadIdx.x < 2) stz[threadIdx.x] = 0u;
        __syncthreads(); }
    (void)xcd_barrier_post((unsigned*)(wsp() + WS_BAR), (volatile LAS unsigned*)(lds + LDS_MISC + 16));
#define GRID_SYNC() do { XcdBarrier xb_; xb_.bar = (unsigned*)(wsp() + WS_BAR); xb_.x = xb_xcc_id(); xb_.st = (volatile LAS unsigned*)(lds + LDS_MISC + 16); xcd_barrier(xb_); } while (0)
#ifdef PROBE_K
    unsigned long long pr_prev = __builtin_amdgcn_s_memrealtime(), pr_acc = 0;
#define PROBE(k) do { const unsigned long long now_ = __builtin_amdgcn_s_memrealtime(); if ((k) == PROBE_K || PROBE_K == 99) pr_acc += now_ - pr_prev; pr_prev = now_; } while (0)
#else
#define PROBE(k) do {} while (0)
#endif
    const int G = gridDim.x;
    unsigned char* ws = wsp();

#if !defined(ONLY) || ONLY == 0
    phase_prep(a, lds);
#endif
    GRID_SYNC();
    PROBE(0);
    for (int l = 0; l < DEPTH; ++l) {
        const bool last = (l == DEPTH - 1);
        const int pm0 = last ? 4 : 0, nM = last ? 64 : 68;
        const float* modl = (const float*)(ws + WS_MOD) + (size_t)l * 5 * 6144;
        const size_t wto = (size_t)(l & 1) * WT_BYTES;
#if !defined(ONLY) || ONLY == 1
        phase_norm(a, lds, l, 0);
#endif
        GRID_SYNC();
    PROBE(1);
#if defined(DBG_STOP) && DBG_STOP == 1
        dbg_dump(1); return;
#endif
        {
            pg8::Sched S; S.nM = 68; S.nN = INW / 256; S.nwg = S.nM * S.nN; S.G = G; S.c = bidx(); S.nseg = 1; S.pm0 = 0;
            S.A0 = (const char*)(ws + WS_H); S.d1 = 0; S.d2 = 0; S.B0 = (const char*)(ws + wto + WS_WIN); S.bseg = 0; S.tstep = (size_t)256 * D * 2;
            pg8::EpiIn E{ws};
            pg8::gemm_phase<pg8::EpiIn, pg8::Sched>(lds, D, D, S, E);
        }
        GRID_SYNC();
    PROBE(2);
#if defined(DBG_STOP) && DBG_STOP == 2
        dbg_dump(2); return;
#endif
        phase_mix(a, lds, l);
        GRID_SYNC();
    PROBE(3);
#if defined(DBG_STOP) && DBG_STOP >= 3 && DBG_STOP <= 5
        dbg_dump(DBG_STOP); return;
#endif
#if defined(DBG_STOP) && DBG_STOP == 7
        dbg_dump(7); return;
#endif
        {
            pg8::Sched S; S.nM = 64; S.nN = 4; S.nwg = S.nM * S.nN; S.G = G; S.c = bidx(); S.nseg = 3; S.pm0 = 4;
            S.A0 = (const char*)(ws + WS_H); S.d1 = 2 * SLOT; S.d2 = 2 * SLOT; S.B0 = (const char*)(ws + wto + WS_WBR); S.bseg = (size_t)D * D * 2; S.tstep = (size_t)256 * D * 2;
            pg8::EpiMerge E{(bf16_t*)(ws + WS_MG), (const bf16_t*)(ws + WS_ZG)};
            pg8::gemm_phase<pg8::EpiMerge, pg8::Sched>(lds, D, D, S, E);
        }
        if (!last) {
            pg8::SchedList S; S.n = 48; S.G = G; S.c = bidx(); S.nN = 4; S.nS = 3; S.nQ = 1;
            S.A0 = (const char*)(ws + WS_H); S.a_pm = (size_t)256 * D * 2; S.a_s = 2 * SLOT; S.a_q = 0;
            S.B0 = (const char*)(ws + wto + WS_WBR); S.b_pn = (size_t)256 * D * 2; S.b_s = (size_t)D * D * 2; S.b_q = 0;
            pg8::EpiMergeCtx E{(bf16_t*)(ws + WS_PC), (const bf16_t*)(ws + WS_ZG)};
            pg8::gemm_phase<pg8::EpiMergeCtx, pg8::SchedList>(lds, D, D, S, E);
        }
        GRID_SYNC();
    PROBE(4);
#if defined(DBG_STOP) && DBG_STOP == 6
        dbg_dump(6); return;
#endif
        {
            pg8::Sched S; S.nM = 64; S.nN = 4; S.nwg = S.nM * S.nN; S.G = G; S.c = bidx(); S.nseg = 1; S.pm0 = 4;
            S.A0 = (const char*)(ws + WS_MG); S.d1 = 0; S.d2 = 0; S.B0 = (const char*)(ws + wto + WS_WOUT); S.bseg = 0; S.tstep = (size_t)256 * D * 2;
            pg8::EpiRes E{(const float*)(ws + WS_XC), l == 0 ? inp<0>() : (const float*)outp(), (float*)(ws + WS_XC), outp(), modl + 2 * 1024};
            pg8::gemm_phase<pg8::EpiRes, pg8::Sched>(lds, D, D, S, E);
        }
        if (!last) {
            pg8::SchedList S; S.n = 192; S.G = G; S.c = bidx(); S.nN = 4; S.nS = 3; S.nQ = 4;
            S.A0 = (const char*)(ws + WS_PC); S.a_pm = (size_t)256 * D * 2; S.a_s = (size_t)TC * D * 2; S.a_q = 256 * 2;
            S.B0 = (const char*)(ws + wto + WS_WOUT); S.b_pn = (size_t)256 * D * 2; S.b_s = 0; S.b_q = 256 * 2;
            pg8::EpiPartial E{(float*)(ws + WS_PX), 4};
            pg8::gemm_phase<pg8::EpiPartial, pg8::SchedList>(lds, 256, D, S, E);
        }
        GRID_SYNC();
    PROBE(5);
        phase_norm(a, lds, l, 1);
        GRID_SYNC();
    PROBE(6);
        {
            pg8::Sched S; S.nM = nM; S.nN = DFF / 256; S.nwg = S.nM * S.nN; S.G = G; S.c = bidx(); S.nseg = 1; S.pm0 = pm0;
            S.A0 = (const char*)(ws + WS_H); S.d1 = 0; S.d2 = 0; S.B0 = (const char*)(ws + wto + WS_WFF1); S.bseg = 0; S.tstep = (size_t)256 * D * 2;
            pg8::EpiFF1 E{(bf16_t*)(ws + WS_HID)};
            pg8::gemm_phase<pg8::EpiFF1, pg8::Sched>(lds, D, D, S, E);
        }
        GRID_SYNC();
    PROBE(7);
        {
            pg8::Sched S; S.nM = 64; S.nN = 4; S.nwg = S.nM * S.nN; S.G = G; S.c = bidx(); S.nseg = 1; S.pm0 = 4;
            S.A0 = (const char*)(ws + WS_HID); S.d1 = 0; S.d2 = 0; S.B0 = (const char*)(ws + wto + WS_WFF2); S.bseg = 0; S.tstep = (size_t)256 * DFF * 2;
            pg8::EpiRes E{(const float*)(ws + WS_XC), (const float*)outp(), (float*)(ws + WS_XC), outp(), modl + 5 * 1024};
            pg8::gemm_phase<pg8::EpiRes, pg8::Sched>(lds, DFF, DFF, S, E);
        }
        if (!last) {
            pg8::SchedList S; S.n = 64; S.G = G; S.c = bidx(); S.nN = 4; S.nS = 1; S.nQ = 4;
            S.A0 = (const char*)(ws + WS_HID); S.a_pm = (size_t)256 * DFF * 2; S.a_s = 0; S.a_q = 1024 * 2;
            S.B0 = (const char*)(ws + wto + WS_WFF2); S.b_pn = (size_t)256 * DFF * 2; S.b_s = 0; S.b_q = 1024 * 2;
            pg8::EpiPartial E{(float*)(ws + WS_PX), 4};
            pg8::gemm_phase<pg8::EpiPartial, pg8::SchedList>(lds, 1024, DFF, S, E);
        }
        if (!last && G > 64) { const int bq = bidx(); if (bq >= 64) convert_weights(l + 1, (size_t)((l + 1) & 1) * WT_BYTES, lds, bq - 64, G - 64, tidx()); }
        else if (!last) convert_weights(l + 1, (size_t)((l + 1) & 1) * WT_BYTES, lds, bidx(), G, tidx());
#ifdef PROBE_K
        GRID_SYNC();
#else
        if (!last) GRID_SYNC();
#endif
    PROBE(8);
    }
#ifdef PROBE_K
    if (blockIdx.x == 0 && threadIdx.x == 0) { float pv = (float)pr_acc * 0.01f; if (PROBE_K >= 30 && PROBE_K < 40) pv = (float)(((unsigned*)(wsp() + WS_CTL))[128 + PROBE_K - 30]) * 0.01f; { const float sc_ = exp10f(floorf(log10f(fmaxf(pv, 1.0f))) - 1.0f); pv = floorf(pv / sc_ + 0.5f) * sc_; } outp()[0] += pv; }
#endif
}

extern "C" void kernel_launch(void* const* d_in, const int* in_sizes, int n_in, void* d_out, int out_size, void* d_ws, size_t ws_size, hipStream_t stream) {
    static int grid = 0;
    if (grid == 0) {
        if (n_in != 27 || out_size != TL * D || ws_size < WS_END) { fprintf(stderr, "kernel_launch: unexpected shapes (n_in %d out %d ws %zu need %zu)\n", n_in, out_size, ws_size, (size_t)WS_END); grid = -1; return; }
        int dev = 0, cus = 0, per_cu = 0;
        hipGetDevice(&dev);
        hipDeviceGetAttribute(&cus, hipDeviceAttributeMultiprocessorCount, dev);
        hipFuncSetAttribute((const void*)fwd_megakernel, hipFuncAttributeMaxDynamicSharedMemorySize, LDS_BYTES);
        hipOccupancyMaxActiveBlocksPerMultiprocessor(&per_cu, (const void*)fwd_megakernel, 512, LDS_BYTES);
        if (per_cu < 1) { fprintf(stderr, "kernel_launch: occupancy query says %d blocks/CU\n", per_cu); per_cu = 1; }
        (void)hipGetLastError();
        grid = cus;
    }
    if (grid < 0) return;
    if (hipMemsetAsync((char*)d_ws + WS_CTL, 0, 32768, stream) != hipSuccess) { fprintf(stderr, "memset failed\n"); return; }
    Args a{};
    for (int i = 0; i < 27; ++i) a.in[i] = (const float*)d_in[i];
    a.out = (float*)d_out; a.ws = (unsigned char*)d_ws;
    void* args[] = {&a};
    hipError_t e = hipLaunchCooperativeKernel((const void*)fwd_megakernel, dim3(grid), dim3(512), args, LDS_BYTES, stream);
    if (e != hipSuccess) fprintf(stderr, "cooperative launch failed: %s (grid %d)\n", hipGetErrorString(e), grid);
}
```
